# Optimizing an MI355X kernel written in HIP

```python
import math
import jax
import jax.numpy as jnp
from jax import lax
import numpy as np


D_MODEL = 2048
BATCH = 4
SEQ = 2048
DEPTH = 1

CHUNK = 64
MIX_WIDTH = D_MODEL
GLA_HEADS = 4
GLA_DV = MIX_WIDTH // 2 // GLA_HEADS
GLA_DK = GLA_DV // 2
GLA_GATE_RANK = 16
GLA_TAU = 16.0
RET_HEADS = 4
RET_DV = MIX_WIDTH // 2 // RET_HEADS
RET_DK = RET_DV
ROPE_BASE = 10000.0
PEER_HEADS = 8
PEER_NKEYS = 128
PEER_N = PEER_NKEYS * PEER_NKEYS
PEER_QDIM = 256
PEER_TOPK = 16
PEER_TOKEN_BLOCK = 128
LN_EPS = 1e-5
DEEPNORM_ALPHA = (2 * DEPTH) ** 0.25
DEEPNORM_BETA = (8 * DEPTH) ** -0.25
PROJ_SIZES = (GLA_HEADS * GLA_DK, GLA_HEADS * GLA_DK, GLA_HEADS * GLA_DV, GLA_HEADS * GLA_DV, GLA_GATE_RANK,
              RET_HEADS * RET_DK, RET_HEADS * RET_DK, RET_HEADS * RET_DV, RET_HEADS * RET_DV)
PROJ_COLS = sum(PROJ_SIZES)
VALUE_SLOTS = (2, 7)

kernel_name = "hybrid_gla_retention_peer_block"


def _layer_norm(x, g, b):
    xf = x.astype(jnp.float32)
    mu = jnp.mean(xf, -1, keepdims=True)
    var = jnp.mean(jnp.square(xf - mu), -1, keepdims=True)
    return ((xf - mu) * lax.rsqrt(var + LN_EPS) * g + b).astype(x.dtype)


def _head_norm(o, gain, center):
    of = o.astype(jnp.float32)
    if center:
        of = of - jnp.mean(of, -1, keepdims=True)
    y = of * lax.rsqrt(jnp.mean(jnp.square(of), -1, keepdims=True) + LN_EPS)
    return y.reshape(o.shape[0], o.shape[1], -1) * gain


def _to_chunks(t):
    b, s, h, d = t.shape
    return t.reshape(b, s // CHUNK, CHUNK, h, d).transpose(1, 0, 3, 2, 4)


def _from_chunks(t):
    nc, b, h, c, d = t.shape
    return t.transpose(1, 0, 3, 2, 4).reshape(b, nc * c, h, d)


def _scan_states(decay, u):
    def step(s, inp):
        d_i, u_i = inp
        return d_i * s + u_i, s
    _, s_prev = lax.scan(step, jnp.zeros(u.shape[1:], u.dtype), (decay, u))
    return s_prev


def _rotary(t, pos):
    half = t.shape[-1] // 2
    inv = ROPE_BASE ** (-jnp.arange(half, dtype=jnp.float32) / half)
    ang = pos.astype(jnp.float32)[:, None] * inv[None, :]
    cos = jnp.cos(ang)[None, :, None, :]
    sin = jnp.sin(ang)[None, :, None, :]
    t1, t2 = t[..., :half], t[..., half:]
    return jnp.concatenate([t1 * cos - t2 * sin, t1 * sin + t2 * cos], -1).astype(t.dtype)


def _gla_chunk_causal(q, k, v, log_a):
    dk = q.shape[-1]
    qc = _to_chunks(q * dk ** -0.5)
    kc = _to_chunks(k)
    vc = _to_chunks(v)
    bc = jnp.cumsum(_to_chunks(log_a), axis=3)
    b_last = bc[:, :, :, -1:, :]
    u = jnp.einsum('nbhcd,nbhce->nbhde', kc * jnp.exp(b_last - bc), vc).astype(jnp.float32)
    s_prev = _scan_states(jnp.exp(b_last[:, :, :, 0, :])[..., None], u)
    o_inter = jnp.einsum('nbhcd,nbhde->nbhce', qc * jnp.exp(bc), s_prev)

    def intra(args):
        q_i, k_i, v_i, b_i = args
        dec = jnp.exp(-jnp.abs(b_i[:, :, :, None, :] - b_i[:, :, None, :, :]))
        a = jnp.einsum('bhnd,bhmd,bhnmd->bhnm', q_i, k_i, dec)
        return jnp.einsum('bhnm,bhme->bhne', a, v_i)

    o_intra = lax.map(intra, (qc, kc, vc, bc))
    return _from_chunks(o_inter + o_intra)


def _retention_chunk_causal(q, k, v):
    dk = q.shape[-1]
    h = q.shape[2]
    log_gamma = jnp.log(1.0 - 2.0 ** (-5.0 - jnp.arange(h, dtype=jnp.float32)))
    idx = jnp.arange(CHUNK, dtype=jnp.float32)
    qc = _to_chunks(q)
    kc = _to_chunks(k * dk ** -0.5)
    vc = _to_chunks(v)
    k_dec = jnp.exp(log_gamma[:, None] * (CHUNK - 1.0 - idx)[None, :])[None, None, :, :, None]
    q_dec = jnp.exp(log_gamma[:, None] * (idx + 1.0)[None, :])[None, None, :, :, None]
    d_intra = jnp.exp(log_gamma[:, None, None] * jnp.abs(idx[:, None] - idx[None, :]))
    u = jnp.einsum('nbhcd,nbhce->nbhde', kc * k_dec, vc).astype(jnp.float32)
    nc = qc.shape[0]
    chunk_decay = jnp.broadcast_to(jnp.exp(log_gamma * CHUNK)[None, None, :, None, None], (nc, 1, h, 1, 1))
    s_prev = _scan_states(chunk_decay, u)
    o_inter = jnp.einsum('nbhcd,nbhde->nbhce', qc, s_prev) * q_dec
    a = jnp.einsum('nbhcd,nbhmd->nbhcm', qc, kc) * d_intra
    o_intra = jnp.einsum('nbhcm,nbhme->nbhce', a, vc)
    return _from_chunks(o_inter + o_intra)


def _hybrid_mixer(h, w_in, w_gate_up, b_gate, gla_g, ret_g, w_out):
    b, s, _ = h.shape
    proj = jnp.einsum('bsd,dn->bsn', h, w_in)
    splits = np.cumsum(PROJ_SIZES)[:-1].tolist()
    gq, gk, gv, gr, glr, rq, rk, rv, rr = jnp.split(proj, splits, axis=-1)
    log_a = jax.nn.log_sigmoid((glr @ w_gate_up + b_gate).astype(jnp.float32)) / GLA_TAU
    o_gla = _gla_chunk_causal(gq.reshape(b, s, GLA_HEADS, GLA_DK), gk.reshape(b, s, GLA_HEADS, GLA_DK),
                              gv.reshape(b, s, GLA_HEADS, GLA_DV), log_a.reshape(b, s, GLA_HEADS, GLA_DK))
    o_gla = _head_norm(o_gla, gla_g, False) * jax.nn.silu(gr)
    pos = jnp.arange(s)
    o_ret = _retention_chunk_causal(_rotary(rq.reshape(b, s, RET_HEADS, RET_DK), pos),
                                    _rotary(rk.reshape(b, s, RET_HEADS, RET_DK), pos),
                                    rv.reshape(b, s, RET_HEADS, RET_DV))
    o_ret = _head_norm(o_ret, ret_g, True) * jax.nn.silu(rr)
    out = jnp.concatenate([o_gla, o_ret], axis=-1) @ w_out
    return out.astype(h.dtype)


def _peer(h, w_q, subkeys, u_tab, v_tab):
    b, s, d = h.shape
    t = b * s
    tb = PEER_TOKEN_BLOCK
    xt = h.reshape(t, d)
    q = (xt @ w_q).reshape(t, PEER_HEADS, 2, PEER_QDIM // 2)
    scores = jnp.einsum('thpd,hpkd->thpk', q, subkeys).astype(jnp.float32)
    vals, idx = lax.top_k(scores, PEER_TOPK)
    cand_s = (vals[:, :, 0, :, None] + vals[:, :, 1, None, :]).reshape(t, PEER_HEADS, -1)
    cand_i = (idx[:, :, 0, :, None] * PEER_NKEYS + idx[:, :, 1, None, :]).reshape(t, PEER_HEADS, -1)
    top_s, sel = lax.top_k(cand_s, PEER_TOPK)
    experts = jnp.take_along_axis(cand_i, sel, axis=-1).reshape(t // tb, tb, -1)
    gates = jax.nn.softmax(top_s, axis=-1).reshape(t // tb, tb, -1)

    def block(args):
        xb, eb, gb = args
        act = jax.nn.gelu(jnp.einsum('tkd,td->tk', u_tab[eb], xb).astype(jnp.float32), approximate=False)
        return jnp.einsum('tk,tkd->td', (gb * act).astype(xb.dtype), v_tab[eb])

    out = lax.map(block, (xt.reshape(t // tb, tb, d), experts, gates))
    return out.reshape(b, s, d).astype(h.dtype)


def setup_inputs(seed: int = 0) -> dict:
    key = jax.random.key(seed)
    ks = jax.random.split(key, 16)
    f32 = jnp.float32

    def nrm(k, shape, scale):
        return jax.random.normal(k, shape, f32) * scale

    col_scale = jnp.concatenate([jnp.full((n,), DEEPNORM_BETA if i in VALUE_SLOTS else 1.0, f32)
                                 for i, n in enumerate(PROJ_SIZES)])
    return {
        "x": nrm(ks[0], (BATCH, SEQ, D_MODEL), 1.0),
        "w_in": nrm(ks[1], (DEPTH, D_MODEL, PROJ_COLS), D_MODEL ** -0.5) * col_scale,
        "w_gla_gate_up": nrm(ks[2], (DEPTH, GLA_GATE_RANK, GLA_HEADS * GLA_DK), GLA_GATE_RANK ** -0.5),
        "b_gla_gate": nrm(ks[3], (DEPTH, GLA_HEADS * GLA_DK), 0.1),
        "gla_norm_g": 1.0 + nrm(ks[4], (DEPTH, GLA_HEADS * GLA_DV), 0.02),
        "ret_norm_g": 1.0 + nrm(ks[5], (DEPTH, RET_HEADS * RET_DV), 0.02),
        "w_out": nrm(ks[6], (DEPTH, MIX_WIDTH, D_MODEL), MIX_WIDTH ** -0.5 * DEEPNORM_BETA),
        "ln1_g": 1.0 + nrm(ks[7], (DEPTH, D_MODEL), 0.02),
        "ln1_b": nrm(ks[8], (DEPTH, D_MODEL), 0.02),
        "w_peer_q": nrm(ks[9], (DEPTH, D_MODEL, PEER_HEADS * PEER_QDIM), D_MODEL ** -0.5),
        "peer_subkeys": nrm(ks[10], (DEPTH, PEER_HEADS, 2, PEER_NKEYS, PEER_QDIM // 2), (PEER_QDIM // 2) ** -0.5),
        "peer_u": nrm(ks[11], (DEPTH, PEER_N, D_MODEL), D_MODEL ** -0.5),
        "peer_v": nrm(ks[12], (DEPTH, PEER_N, D_MODEL), DEEPNORM_BETA),
        "ln2_g": 1.0 + nrm(ks[13], (DEPTH, D_MODEL), 0.02),
        "ln2_b": nrm(ks[14], (DEPTH, D_MODEL), 0.02),
    }


def reference(x, w_in, w_gla_gate_up, b_gla_gate, gla_norm_g, ret_norm_g, w_out, ln1_g, ln1_b,
              w_peer_q, peer_subkeys, peer_u, peer_v, ln2_g, ln2_b):
    h = x
    for l in range(DEPTH):
        mix = _hybrid_mixer(h, w_in[l], w_gla_gate_up[l], b_gla_gate[l], gla_norm_g[l], ret_norm_g[l], w_out[l])
        h = _layer_norm(DEEPNORM_ALPHA * h + mix, ln1_g[l], ln1_b[l])
        ffn = _peer(h, w_peer_q[l], peer_subkeys[l], peer_u[l], peer_v[l])
        h = _layer_norm(DEEPNORM_ALPHA * h + ffn, ln2_g[l], ln2_b[l])
    return h
```

```cpp
#include <hip/hip_runtime.h>
#include <stdint.h>
#include <math.h>

typedef unsigned short bf16_t;
constexpr int D = 2048, BATCH = 4, SEQ = 2048, T = BATCH * SEQ;
constexpr int NPROJ = 7184, NP = 7424;
constexpr int C_GQ = 0, C_GK = 512, C_GV = 1024, C_GR = 2048, C_RQ = 3072, C_RK = 4096, C_RV = 5120, C_RR = 6144, C_GLR = 7168;
constexpr int NCH = 32, CH = 64;
constexpr float ALPHA = 1.189207115002721f;
constexpr float LN_EPS = 1e-5f;
constexpr size_t MiB = 1u << 20;
constexpr size_t WS_CTL = 0, WS_WIN = 1 * MiB, WS_WOUT = 31 * MiB, WS_WQ = 39 * MiB, WS_SKB = 47 * MiB, WS_ROPE = 48 * MiB,
                 WS_UB = 50 * MiB, WS_VB = 114 * MiB, WS_XB = 178 * MiB, WS_PROJ = 210 * MiB, WS_BC = 326 * MiB, WS_UT = 342 * MiB,
                 WS_O = 438 * MiB, WS_END = 470 * MiB;
constexpr size_t WS_Y = 210 * MiB, WS_H1B = 274 * MiB, WS_EXP = 306 * MiB, WS_GATE = 310 * MiB;
constexpr size_t WS_Q = 342 * MiB;
constexpr size_t UT_RET_OFF = (size_t)16 * 32 * 256 * 128;

__device__ __forceinline__ float bf2f(bf16_t v) { return __uint_as_float(((unsigned)v) << 16); }
__device__ __forceinline__ bf16_t f2bf(float f) { unsigned u = __float_as_uint(f); return (bf16_t)((u + 0x7fffu + ((u >> 16) & 1u)) >> 16); }
__device__ __forceinline__ float wave_sum(float v) {
#pragma unroll
    for (int o = 1; o < 64; o <<= 1) v += __shfl_xor(v, o);
    return v;
}
__device__ __forceinline__ float gamma_log(int h) { return logf(1.0f - exp2f(-5.0f - (float)h)); }

__global__ void k_cvt(const float* __restrict__ src, bf16_t* __restrict__ dst, size_t n) {
    size_t i = (size_t)blockIdx.x * blockDim.x + threadIdx.x, st = (size_t)gridDim.x * blockDim.x;
    for (; i < n; i += st) dst[i] = f2bf(src[i]);
}
__global__ void k_transpose_cvt(const float* __restrict__ W, int K, int N, bf16_t* __restrict__ WT, int NPAD, int mode) {
    __shared__ float tile[32][33];
    const int n0 = blockIdx.x * 32, k0 = blockIdx.y * 32, tx = threadIdx.x, ty = threadIdx.y;
    for (int j = ty; j < 32; j += 8) {
        const int n = n0 + tx; float v = 0.f;
        if (mode == 0) { if (n < N) v = W[(size_t)(k0 + j) * N + n]; }
        else if (n < NPROJ) {
            const int orig = (n < 3072) ? n : (n < 7168 ? n + 16 : n - 7168 + 3072);
            const float sc = (n < 512) ? 0.08838834764831845f : ((n >= C_RK && n < C_RV) ? 0.0625f : 1.f);
            v = W[(size_t)(k0 + j) * N + orig] * sc;
        }
        tile[j][tx] = v;
    }
    __syncthreads();
    for (int j = ty; j < 32; j += 8) { const int n = n0 + j; if (n < NPAD) WT[(size_t)n * K + k0 + tx] = f2bf(tile[tx][j]); }
}
__global__ void k_rope_table(float* __restrict__ rope) {
    const int idx = blockIdx.x * blockDim.x + threadIdx.x; if (idx >= SEQ * 128) return;
    const int pos = idx >> 7, i = idx & 127;
    const float inv = powf(10000.0f, -(float)i / 128.0f);
    const float ang = (float)pos * inv;
    const float n = rintf(ang * 0.15915494309189535f);
    float r = fmaf(-n, 6.28125f, ang); r = fmaf(-n, 0.0019353071795864769f, r);
    rope[2 * idx] = cosf(r); rope[2 * idx + 1] = sinf(r);
}

template <int MODE>
__global__ void __launch_bounds__(256) k_gemm(const bf16_t* __restrict__ A, const bf16_t* __restrict__ Bt, int M, int N, int K,
                                              bf16_t* __restrict__ Cb, float* __restrict__ Cf, const float* __restrict__ X, int ldc) {
    __shared__ float As[32][65], Bs[32][65];
    const int tid = threadIdx.x, tx = tid & 15, ty = tid >> 4;
    const int m0 = blockIdx.y * 64, n0 = blockIdx.x * 64;
    float acc[4][4] = {};
    for (int k0 = 0; k0 < K; k0 += 32) {
        for (int i = tid; i < 64 * 32; i += 256) { const int r = i >> 5, c = i & 31;
            As[c][r] = bf2f(A[(size_t)(m0 + r) * K + k0 + c]); Bs[c][r] = bf2f(Bt[(size_t)(n0 + r) * K + k0 + c]); }
        __syncthreads();
#pragma unroll 8
        for (int k = 0; k < 32; ++k) {
            float a[4], b[4];
#pragma unroll
            for (int i = 0; i < 4; ++i) { a[i] = As[k][ty * 4 + i]; b[i] = Bs[k][tx * 4 + i]; }
#pragma unroll
            for (int i = 0; i < 4; ++i)
#pragma unroll
                for (int j = 0; j < 4; ++j) acc[i][j] = fmaf(a[i], b[j], acc[i][j]);
        }
        __syncthreads();
    }
#pragma unroll
    for (int i = 0; i < 4; ++i)
#pragma unroll
        for (int j = 0; j < 4; ++j) { const size_t off = (size_t)(m0 + ty * 4 + i) * ldc + n0 + tx * 4 + j;
            if (MODE == 0) Cb[off] = f2bf(acc[i][j]); else Cf[off] = ALPHA * X[off] + acc[i][j]; }
}
__global__ void k_rotary(bf16_t* __restrict__ proj, const float* __restrict__ rope) {
    const size_t idx = (size_t)blockIdx.x * blockDim.x + threadIdx.x;
    if (idx >= (size_t)T * 1024) return;
    const int t = (int)(idx >> 10), r = (int)(idx & 1023), which = r >> 9, h = (r >> 7) & 3, i = r & 127;
    const int pos = t % SEQ;
    bf16_t* p = proj + (size_t)t * NP + (which ? C_RK : C_RQ) + h * 256 + i;
    const float c = rope[2 * (pos * 128 + i)], s = rope[2 * (pos * 128 + i) + 1];
    const float t1 = bf2f(p[0]), t2 = bf2f(p[128]);
    p[0] = f2bf(t1 * c - t2 * s); p[128] = f2bf(t1 * s + t2 * c);
}

__global__ void __launch_bounds__(256) k_chunk_u(const bf16_t* __restrict__ proj, const float* __restrict__ wg, const float* __restrict__ bg,
                                                float* __restrict__ bc, bf16_t* __restrict__ ut) {
    __shared__ float sb[64][128];
    __shared__ bf16_t kt[64][256];
    const int unit = blockIdx.x, head = unit & 7, bchunk = unit >> 3, b = bchunk / NCH, ch = bchunk % NCH;
    const int t0 = b * SEQ + ch * CH, tid = threadIdx.x;
    if (head < 4) {
        const int h = head;
        for (int idx = tid; idx < 64 * 128; idx += 256) {
            const int c = idx >> 7, d = idx & 127;
            float z = bg[h * 128 + d];
            for (int r = 0; r < 16; ++r) z = fmaf(bf2f(proj[(size_t)(t0 + c) * NP + C_GLR + r]), wg[r * 512 + h * 128 + d], z);
            const float ls = fminf(z, 0.f) - log1pf(expf(-fabsf(z)));
            sb[c][d] = ls * (1.0f / 16.0f);
        }
        __syncthreads();
        if (tid < 128) { float s = 0.f; for (int c = 0; c < 64; ++c) { s += sb[c][tid]; sb[c][tid] = s; bc[(size_t)(t0 + c) * 512 + h * 128 + tid] = s; } }
        __syncthreads();
        for (int idx = tid; idx < 64 * 128; idx += 256) { const int c = idx >> 7, d = idx & 127;
            kt[c][d] = f2bf(bf2f(proj[(size_t)(t0 + c) * NP + C_GK + h * 128 + d]) * expf(sb[63][d] - sb[c][d])); }
        __syncthreads();
        bf16_t* o = ut + ((size_t)(b * 4 + h) * NCH + ch) * 256 * 128;
        for (int idx = tid; idx < 256 * 128; idx += 256) { const int e = idx >> 7, d = idx & 127; float s = 0.f;
            for (int c = 0; c < 64; ++c) s = fmaf(bf2f(proj[(size_t)(t0 + c) * NP + C_GV + h * 256 + e]), bf2f(kt[c][d]), s);
            o[idx] = f2bf(s); }
    } else {
        const int h = head - 4; const float lg = gamma_log(h);
        for (int idx = tid; idx < 64 * 256; idx += 256) { const int c = idx >> 8, d = idx & 255;
            kt[c][d] = f2bf(bf2f(proj[(size_t)(t0 + c) * NP + C_RK + h * 256 + d]) * expf(lg * (float)(63 - c))); }
        __syncthreads();
        bf16_t* o = ut + UT_RET_OFF + ((size_t)(b * 4 + h) * NCH + ch) * 256 * 256;
        for (int idx = tid; idx < 256 * 256; idx += 256) { const int e = idx >> 8, d = idx & 255; float s = 0.f;
            for (int c = 0; c < 64; ++c) s = fmaf(bf2f(proj[(size_t)(t0 + c) * NP + C_RV + h * 256 + e]), bf2f(kt[c][d]), s);
            o[idx] = f2bf(s); }
    }
}
__global__ void k_scan(bf16_t* __restrict__ ut, const float* __restrict__ bc) {
    const size_t idx = (size_t)blockIdx.x * blockDim.x + threadIdx.x;
    const size_t NG = (size_t)16 * 256 * 128, NR = (size_t)16 * 256 * 256;
    if (idx < NG) {
        const int bh = (int)(idx >> 15), d = (int)(idx & 127), b = bh >> 2, h = bh & 3;
        bf16_t* p = ut + (size_t)bh * NCH * 32768 + (idx & 32767);
        float s = 0.f;
        for (int i = 0; i < NCH; ++i) { const float u = bf2f(p[(size_t)i * 32768]); p[(size_t)i * 32768] = f2bf(s);
            const float dec = expf(bc[(size_t)(b * SEQ + i * CH + 63) * 512 + h * 128 + d]); s = fmaf(dec, s, u); }
    } else if (idx < NG + NR) {
        const size_t j = idx - NG; const int bh = (int)(j >> 16), h = bh & 3;
        bf16_t* p = ut + UT_RET_OFF + (size_t)bh * NCH * 65536 + (j & 65535);
        const float dec = expf(gamma_log(h) * 64.0f); float s = 0.f;
        for (int i = 0; i < NCH; ++i) { const float u = bf2f(p[(size_t)i * 65536]); p[(size_t)i * 65536] = f2bf(s); s = fmaf(dec, s, u); }
    }
}
__device__ __forceinline__ float block_sum256(float v, float* red) {
    v = wave_sum(v);
    __syncthreads();
    if ((threadIdx.x & 63) == 0) red[threadIdx.x >> 6] = v;
    __syncthreads();
    return red[0] + red[1] + red[2] + red[3];
}
__global__ void __launch_bounds__(256) k_chunk_o(const bf16_t* __restrict__ proj, const float* __restrict__ bc, const bf16_t* __restrict__ st,
                                                const float* __restrict__ gla_g, const float* __restrict__ ret_g, bf16_t* __restrict__ O) {
    __shared__ float sb[64][128];
    __shared__ float sa[64][65];
    __shared__ float red[4];
    const int unit = blockIdx.x, head = unit & 7, bchunk = unit >> 3, b = bchunk / NCH, ch = bchunk % NCH;
    const int t0 = b * SEQ + ch * CH, tid = threadIdx.x;
    if (head < 4) {
        const int h = head;
        for (int idx = tid; idx < 64 * 128; idx += 256) { const int c = idx >> 7, d = idx & 127; sb[c][d] = bc[(size_t)(t0 + c) * 512 + h * 128 + d]; }
        __syncthreads();
        for (int idx = tid; idx < 64 * 64; idx += 256) { const int n = idx >> 6, m = idx & 63; float s = 0.f;
            const bf16_t* qp = proj + (size_t)(t0 + n) * NP + C_GQ + h * 128; const bf16_t* kp = proj + (size_t)(t0 + m) * NP + C_GK + h * 128;
            for (int d = 0; d < 128; ++d) s = fmaf(bf2f(qp[d]) * bf2f(kp[d]), expf(-fabsf(sb[n][d] - sb[m][d])), s);
            sa[n][m] = s; }
        __syncthreads();
        const int e = tid; const bf16_t* sp = st + ((size_t)(b * 4 + h) * NCH + ch) * 256 * 128 + (size_t)e * 128;
        const float g = gla_g[h * 256 + e];
        for (int n = 0; n < 64; ++n) {
            float o = 0.f;
            for (int m = 0; m < 64; ++m) o = fmaf(sa[n][m], bf2f(proj[(size_t)(t0 + m) * NP + C_GV + h * 256 + e]), o);
            const bf16_t* qp = proj + (size_t)(t0 + n) * NP + C_GQ + h * 128;
            for (int d = 0; d < 128; ++d) o = fmaf(bf2f(qp[d]) * expf(sb[n][d]), bf2f(sp[d]), o);
            const float ss = block_sum256(o * o, red);
            const float y = o * rsqrtf(ss * (1.0f / 256.0f) + LN_EPS) * g;
            const float gt = bf2f(proj[(size_t)(t0 + n) * NP + C_GR + h * 256 + e]);
            O[(size_t)(t0 + n) * D + h * 256 + e] = f2bf(y * gt / (1.0f + expf(-gt)));
        }
    } else {
        const int h = head - 4; const float lg = gamma_log(h);
        for (int idx = tid; idx < 64 * 64; idx += 256) { const int n = idx >> 6, m = idx & 63; float s = 0.f;
            const bf16_t* qp = proj + (size_t)(t0 + n) * NP + C_RQ + h * 256; const bf16_t* kp = proj + (size_t)(t0 + m) * NP + C_RK + h * 256;
            for (int d = 0; d < 256; ++d) s = fmaf(bf2f(qp[d]), bf2f(kp[d]), s);
            sa[n][m] = s * expf(lg * fabsf((float)(n - m))); }
        __syncthreads();
        const int e = tid; const bf16_t* sp = st + UT_RET_OFF + ((size_t)(b * 4 + h) * NCH + ch) * 256 * 256 + (size_t)e * 256;
        const float g = ret_g[h * 256 + e];
        for (int n = 0; n < 64; ++n) {
            float o = 0.f, oi = 0.f;
            for (int m = 0; m < 64; ++m) o = fmaf(sa[n][m], bf2f(proj[(size_t)(t0 + m) * NP + C_RV + h * 256 + e]), o);
            const bf16_t* qp = proj + (size_t)(t0 + n) * NP + C_RQ + h * 256;
            for (int d = 0; d < 256; ++d) oi = fmaf(bf2f(qp[d]), bf2f(sp[d]), oi);
            o += oi * expf(lg * (float)(n + 1));
            const float mu = block_sum256(o, red) * (1.0f / 256.0f);
            const float oc = o - mu;
            const float ss = block_sum256(oc * oc, red);
            const float y = oc * rsqrtf(ss * (1.0f / 256.0f) + LN_EPS) * g;
            const float gt = bf2f(proj[(size_t)(t0 + n) * NP + C_RR + h * 256 + e]);
            O[(size_t)(t0 + n) * D + 1024 + h * 256 + e] = f2bf(y * gt / (1.0f + expf(-gt)));
        }
    }
}
__global__ void __launch_bounds__(256) k_ln_rows(float* __restrict__ Y, const float* __restrict__ g, const float* __restrict__ bta, bf16_t* __restrict__ Hb) {
    const int row = blockIdx.x * 4 + (threadIdx.x >> 6), lane = threadIdx.x & 63;
    float* y = Y + (size_t)row * D; float v[32]; float s = 0.f;
#pragma unroll
    for (int j = 0; j < 32; ++j) { v[j] = y[j * 64 + lane]; s += v[j]; }
    const float mu = wave_sum(s) * (1.0f / D); float q = 0.f;
#pragma unroll
    for (int j = 0; j < 32; ++j) { v[j] -= mu; q += v[j] * v[j]; }
    const float rstd = rsqrtf(wave_sum(q) * (1.0f / D) + LN_EPS);
#pragma unroll
    for (int j = 0; j < 32; ++j) { const int c = j * 64 + lane; const float o = v[j] * rstd * g[c] + bta[c]; y[c] = o; Hb[(size_t)row * D + c] = f2bf(o); }
}
__global__ void __launch_bounds__(32) k_peer_topk(const bf16_t* __restrict__ Q, const bf16_t* __restrict__ skb, int* __restrict__ ex, float* __restrict__ gate) {
    __shared__ float sc[32][129];
    __shared__ float tv[32][2][16];
    __shared__ int ti[32][2][16];
    __shared__ float cand[32][257];
    const int lt = threadIdx.x, gidx = blockIdx.x * 32 + lt, t = gidx >> 3, h = gidx & 7;
    for (int p = 0; p < 2; ++p) {
        const bf16_t* q = Q + (size_t)t * D + h * 256 + p * 128;
        const bf16_t* sk = skb + (size_t)(h * 2 + p) * 128 * 128;
        for (int k = 0; k < 128; ++k) { float s = 0.f; for (int d = 0; d < 128; ++d) s = fmaf(bf2f(q[d]), bf2f(sk[k * 128 + d]), s); sc[lt][k] = s; }
        for (int r = 0; r < 16; ++r) { float best = -INFINITY; int bi = 0;
            for (int k = 0; k < 128; ++k) { const float v = sc[lt][k]; if (v > best) { best = v; bi = k; } }
            tv[lt][p][r] = best; ti[lt][p][r] = bi; sc[lt][bi] = -INFINITY; }
    }
    for (int i = 0; i < 16; ++i) for (int j = 0; j < 16; ++j) cand[lt][i * 16 + j] = tv[lt][0][i] + tv[lt][1][j];
    float mx = 0.f, sum = 0.f;
    for (int r = 0; r < 16; ++r) { float best = -INFINITY; int bi = 0;
        for (int k = 0; k < 256; ++k) { const float v = cand[lt][k]; if (v > best) { best = v; bi = k; } }
        cand[lt][bi] = -INFINITY;
        if (r == 0) mx = best;
        const float e = expf(best - mx); sum += e;
        ex[(size_t)t * 128 + h * 16 + r] = ti[lt][0][bi >> 4] * 128 + ti[lt][1][bi & 15];
        gate[(size_t)t * 128 + h * 16 + r] = e; }
    const float inv = 1.0f / sum;
    for (int r = 0; r < 16; ++r) gate[(size_t)t * 128 + h * 16 + r] *= inv;
}
__global__ void __launch_bounds__(256) k_peer_gather(const float* __restrict__ H1, const bf16_t* __restrict__ ub, const bf16_t* __restrict__ vb,
                                                    const int* __restrict__ ex, const float* __restrict__ gate,
                                                    const float* __restrict__ g2, const float* __restrict__ b2, float* __restrict__ out) {
    const int t = blockIdx.x * 4 + (threadIdx.x >> 6), lane = threadIdx.x & 63;
    const float* hrow = H1 + (size_t)t * D;
    float x[32], acc[32];
#pragma unroll
    for (int j = 0; j < 32; ++j) { x[j] = hrow[j * 64 + lane]; acc[j] = 0.f; }
    for (int k = 0; k < 128; ++k) {
        const int e = ex[(size_t)t * 128 + k]; const float gt = gate[(size_t)t * 128 + k];
        const bf16_t* ur = ub + (size_t)e * D; const bf16_t* vr = vb + (size_t)e * D;
        float s = 0.f;
#pragma unroll
        for (int j = 0; j < 32; ++j) s = fmaf(bf2f(ur[j * 64 + lane]), x[j], s);
        s = wave_sum(s);
        const float w = gt * 0.5f * s * (1.0f + erff(s * 0.7071067811865476f));
#pragma unroll
        for (int j = 0; j < 32; ++j) acc[j] = fmaf(w, bf2f(vr[j * 64 + lane]), acc[j]);
    }
    float s = 0.f;
#pragma unroll
    for (int j = 0; j < 32; ++j) { acc[j] = ALPHA * x[j] + acc[j]; s += acc[j]; }
    const float mu = wave_sum(s) * (1.0f / D); float q = 0.f;
#pragma unroll
    for (int j = 0; j < 32; ++j) { acc[j] -= mu; q += acc[j] * acc[j]; }
    const float rstd = rsqrtf(wave_sum(q) * (1.0f / D) + LN_EPS);
#pragma unroll
    for (int j = 0; j < 32; ++j) { const int c = j * 64 + lane; out[(size_t)t * D + c] = acc[j] * rstd * g2[c] + b2[c]; }
}

extern "C" void kernel_launch(void* const* d_in, const int* in_sizes, int n_in, void* d_out, int out_size, void* d_ws, size_t ws_size, hipStream_t stream) {
    if (n_in != 15 || ws_size < WS_END) return;
    const float* x = (const float*)d_in[0]; const float* w_in = (const float*)d_in[1]; const float* wg = (const float*)d_in[2]; const float* bg = (const float*)d_in[3];
    const float* gla_g = (const float*)d_in[4]; const float* ret_g = (const float*)d_in[5]; const float* w_out = (const float*)d_in[6];
    const float* ln1_g = (const float*)d_in[7]; const float* ln1_b = (const float*)d_in[8]; const float* w_q = (const float*)d_in[9];
    const float* subkeys = (const float*)d_in[10]; const float* peer_u = (const float*)d_in[11]; const float* peer_v = (const float*)d_in[12];
    const float* ln2_g = (const float*)d_in[13]; const float* ln2_b = (const float*)d_in[14];
    unsigned char* ws = (unsigned char*)d_ws;
    bf16_t* WIN = (bf16_t*)(ws + WS_WIN); bf16_t* WOUT = (bf16_t*)(ws + WS_WOUT); bf16_t* WQ = (bf16_t*)(ws + WS_WQ); bf16_t* SKB = (bf16_t*)(ws + WS_SKB);
    float* ROPE = (float*)(ws + WS_ROPE); bf16_t* UB = (bf16_t*)(ws + WS_UB); bf16_t* VB = (bf16_t*)(ws + WS_VB); bf16_t* XB = (bf16_t*)(ws + WS_XB);
    bf16_t* PROJ = (bf16_t*)(ws + WS_PROJ); float* BC = (float*)(ws + WS_BC); bf16_t* UT = (bf16_t*)(ws + WS_UT); bf16_t* O = (bf16_t*)(ws + WS_O);
    float* Y = (float*)(ws + WS_Y); bf16_t* H1B = (bf16_t*)(ws + WS_H1B); int* EXP = (int*)(ws + WS_EXP); float* GATE = (float*)(ws + WS_GATE); bf16_t* Q = (bf16_t*)(ws + WS_Q);
    float* out = (float*)d_out;

    k_cvt<<<2048, 256, 0, stream>>>(x, XB, (size_t)T * D);
    k_cvt<<<2048, 256, 0, stream>>>(peer_u, UB, (size_t)16384 * D);
    k_cvt<<<2048, 256, 0, stream>>>(peer_v, VB, (size_t)16384 * D);
    k_cvt<<<256, 256, 0, stream>>>(subkeys, SKB, (size_t)8 * 2 * 128 * 128);
    k_transpose_cvt<<<dim3(NP / 32, D / 32), dim3(32, 8), 0, stream>>>(w_in, D, NPROJ, WIN, NP, 1);
    k_transpose_cvt<<<dim3(D / 32, D / 32), dim3(32, 8), 0, stream>>>(w_out, D, D, WOUT, D, 0);
    k_transpose_cvt<<<dim3(D / 32, D / 32), dim3(32, 8), 0, stream>>>(w_q, D, D, WQ, D, 0);
    k_rope_table<<<SEQ * 128 / 256, 256, 0, stream>>>(ROPE);
    k_gemm<0><<<dim3(NP / 64, T / 64), 256, 0, stream>>>(XB, WIN, T, NP, D, PROJ, nullptr, nullptr, NP);
    k_rotary<<<T * 1024 / 256, 256, 0, stream>>>(PROJ, ROPE);
    k_chunk_u<<<BATCH * NCH * 8, 256, 0, stream>>>(PROJ, wg, bg, BC, UT);
    k_scan<<<(16 * 256 * 128 + 16 * 256 * 256) / 256, 256, 0, stream>>>(UT, BC);
    k_chunk_o<<<BATCH * NCH * 8, 256, 0, stream>>>(PROJ, BC, UT, gla_g, ret_g, O);
    k_gemm<1><<<dim3(D / 64, T / 64), 256, 0, stream>>>(O, WOUT, T, D, D, nullptr, Y, x, D);
    k_ln_rows<<<T / 4, 256, 0, stream>>>(Y, ln1_g, ln1_b, H1B);
    k_gemm<0><<<dim3(D / 64, T / 64), 256, 0, stream>>>(H1B, WQ, T, D, D, Q, nullptr, nullptr, D);
    k_peer_topk<<<T * 8 / 32, 32, 0, stream>>>(Q, SKB, EXP, GATE);
    k_peer_gather<<<T / 4, 256, 0, stream>>>(Y, UB, VB, EXP, GATE, ln2_g, ln2_b, out);
}
```

```cpp
#include <hip/hip_runtime.h>
#include <stdint.h>
#include <math.h>
#include <cstdio>
#include <utility>

namespace pg8 {
#define PG8_LAS __attribute__((address_space(3)))
typedef unsigned short bf16_t;
typedef short bf16x8 __attribute__((ext_vector_type(8)));
typedef float f32x4 __attribute__((ext_vector_type(4)));
typedef unsigned u32x4 __attribute__((ext_vector_type(4)));
constexpr int BM = 256, BK = 64, HALF = 128, HTB = HALF * BK * 2  , STAGE_BYTES = 8 * HTB, NXCD = 8, WGM = 8;

__host__ __device__ __forceinline__ int lds_byte(int r, int c) { const int st = (r >> 4) * 2 + (c >> 5), rr = r & 15, cc = c & 31, ob = rr * 64 + cc * 2; return st * 1024 + (ob ^ (((ob >> 9) & 1) << 5)); }
__host__ __device__ __forceinline__ void stage_rc(int b, int& R, int& C) { const int st = b / 1024, sb = b % 1024, swz = sb ^ (((sb >> 9) & 1) << 5); R = (st >> 1) * 16 + swz / 64; C = (st & 1) * 32 + (swz % 64) / 2; }
__host__ __device__ __forceinline__ int perm32(int rho) { const int n = rho >> 4, i = rho & 15; return 8 * (i >> 2) + 4 * n + (i & 3); }

struct Unit { int pm, pn; };
struct Gemm { const bf16_t* A; const bf16_t* Bt; int M, N, K; };

struct StaticOrder {
    int nM, nN, nwg, G, c;
    __host__ __device__ void init(int M, int N, int G_, int c_) { nM = M / BM; nN = N / BM; nwg = nM * nN; G = G_; c = c_; }
    __host__ __device__ bool next(int i, Unit& u) const {
        const long L = (long)i * G + c; if (L >= nwg) return false;
        int wgid = (int)L; { const int q = nwg / NXCD, r = nwg % NXCD, xcd = wgid % NXCD, off = wgid / NXCD; wgid = (xcd < r ? xcd * (q + 1) : r * (q + 1) + (xcd - r) * q) + off; }
        const int nig = WGM * nN, gid = wgid / nig, fm = gid * WGM, gsz = (nM - fm) < WGM ? (nM - fm) : WGM;
        u.pm = fm + ((wgid % nig) % gsz); u.pn = (wgid % nig) / gsz; return true;
    }
    __device__ __forceinline__ void a_ready(const Unit&) const {}
    __device__ __forceinline__ void done(const Unit&) const {}
};

typedef unsigned u32x4 __attribute__((ext_vector_type(4)));
__device__ __forceinline__ unsigned cvt_pk_bf16(float lo, float hi) { unsigned r; asm volatile("v_cvt_pk_bf16_f32 %0, %1, %2" : "=v"(r) : "v"(lo), "v"(hi)); return r; }
struct EpiBf16 {
    static constexpr bool PERM = true, AFTER_DRAIN = false;
    bf16_t* O; int ldc; const float* rope; int rot_lo, rot_hi;
    __device__ __forceinline__ void operator()(const f32x4 (&acc)[2][2][4][2], const Unit& u, int wr, int wc, int fr, int fq) const {
        const int row0 = u.pm * BM + wr * 64 + fr, colw = wc * 32 + 8 * fq;
        const bool rot = (u.pn >= rot_lo && u.pn < rot_hi);
#pragma unroll
        for (int ai = 0; ai < 2; ++ai)
#pragma unroll
            for (int m = 0; m < 4; ++m) {
                const int row = row0 + ai * HALF + m * 16;
                f32x4 a0 = acc[ai][0][m][0], a1 = acc[ai][0][m][1], b0 = acc[ai][1][m][0], b1 = acc[ai][1][m][1];
                if (rot) {
                    const f32x4* rp = (const f32x4*)(rope + (size_t)((row & 2047) * 128 + colw) * 2);
                    const f32x4 r0 = rp[0], r1 = rp[1], r2 = rp[2], r3 = rp[3];
                    f32x4 x0, x1, y0, y1;
                    x0[0] = a0[0] * r0[0] - b0[0] * r0[1]; y0[0] = a0[0] * r0[1] + b0[0] * r0[0];
                    x0[1] = a0[1] * r0[2] - b0[1] * r0[3]; y0[1] = a0[1] * r0[3] + b0[1] * r0[2];
                    x0[2] = a0[2] * r1[0] - b0[2] * r1[1]; y0[2] = a0[2] * r1[1] + b0[2] * r1[0];
                    x0[3] = a0[3] * r1[2] - b0[3] * r1[3]; y0[3] = a0[3] * r1[3] + b0[3] * r1[2];
                    x1[0] = a1[0] * r2[0] - b1[0] * r2[1]; y1[0] = a1[0] * r2[1] + b1[0] * r2[0];
                    x1[1] = a1[1] * r2[2] - b1[1] * r2[3]; y1[1] = a1[1] * r2[3] + b1[1] * r2[2];
                    x1[2] = a1[2] * r3[0] - b1[2] * r3[1]; y1[2] = a1[2] * r3[1] + b1[2] * r3[0];
                    x1[3] = a1[3] * r3[2] - b1[3] * r3[3]; y1[3] = a1[3] * r3[3] + b1[3] * r3[2];
                    a0 = x0; a1 = x1; b0 = y0; b1 = y1;
                }
                bf16_t* rowp = O + (size_t)row * ldc + u.pn * BM + colw;
                u32x4 w; w.x = cvt_pk_bf16(a0[0], a0[1]); w.y = cvt_pk_bf16(a0[2], a0[3]); w.z = cvt_pk_bf16(a1[0], a1[1]); w.w = cvt_pk_bf16(a1[2], a1[3]);
                *(u32x4*)(rowp) = w;
                w.x = cvt_pk_bf16(b0[0], b0[1]); w.y = cvt_pk_bf16(b0[2], b0[3]); w.z = cvt_pk_bf16(b1[0], b1[1]); w.w = cvt_pk_bf16(b1[2], b1[3]);
                *(u32x4*)(rowp + HALF) = w;
            }
    }
};
struct EpiResF32 {
    static constexpr bool PERM = false, AFTER_DRAIN = false;
    float* Y; const float* X; int ldc; float alpha;
    __device__ __forceinline__ void operator()(const f32x4 (&acc)[2][2][4][2], const Unit& u, int wr, int wc, int fr, int fq) const {
        const int row0 = u.pm * BM + wr * 64 + fr, col0 = u.pn * BM + wc * 32 + 4 * fq;
#pragma unroll
        for (int ai = 0; ai < 2; ++ai)
#pragma unroll
            for (int m = 0; m < 4; ++m) { const size_t off = (size_t)(row0 + ai * HALF + m * 16) * ldc + col0;
#pragma unroll
                for (int bj = 0; bj < 2; ++bj)
#pragma unroll
                    for (int n = 0; n < 2; ++n) { const size_t o2 = off + bj * HALF + n * 16; const f32x4 xv = *(const f32x4*)(X + o2); *(f32x4*)(Y + o2) = xv * alpha + acc[ai][bj][m][n]; } }
    }
};
template <class Epi, class Sched, bool ALIGN_EPI = false, bool SP2 = false>
__device__ __forceinline__ void gemm_phase(PG8_LAS unsigned char* lds, const Gemm g, const Sched& S, const Epi& E) {
    const int tid = threadIdx.x, wid = __builtin_amdgcn_readfirstlane(tid >> 6), lane = tid & 63, wr = wid >> 2, wc = wid & 3, fr = lane & 15, fq = lane >> 4;
    const int K = g.K, nt = K / BK;
    unsigned voffA[2], voffB[2];
#pragma unroll
    for (int i = 0; i < 2; ++i) { int R, C; stage_rc(tid * 16 + i * 8192, R, C); const int Rb = Epi::PERM ? ((R & ~31) + perm32(R & 31)) : R;
        voffA[i] = (unsigned)(R * K + C) * 2u; voffB[i] = (unsigned)(Rb * K + C) * 2u; }
    const size_t kstep = (size_t)(BK * 2);
    const size_t hstep = (size_t)HALF * K * 2;
    const size_t tstep = 2 * hstep;
    const unsigned ldsw = (unsigned)wid * 1024u;
    const int aoff = lds_byte(wr * 64 + fr, fq * 8), boff = lds_byte(wc * 32 + fr, fq * 8);
#define PG8_SA(b, h) (((b) * 2 + (h)) * HTB)
#define PG8_SB(b, h) ((4 + (b) * 2 + (h)) * HTB)
#define PG8_STAGE(bufoff, gbase, voff) do { _Pragma("unroll") for (int _i = 0; _i < 2; ++_i) \
        __builtin_amdgcn_global_load_lds((const unsigned*)((const char*)(gbase) + (voff)[_i]), (PG8_LAS unsigned*)(lds + (bufoff) + ldsw + _i * 8192), 16, 0, 0); } while (0)
#define PG8_LDA(dst, b, h) do { _Pragma("unroll") for (int m = 0; m < 4; ++m) _Pragma("unroll") for (int k = 0; k < 2; ++k) dst[m][k] = *(const PG8_LAS bf16x8*)(lds + PG8_SA(b, h) + aoff + m * 2048 + k * 1024); } while (0)
#define PG8_LDB(dst, b, h) do { _Pragma("unroll") for (int n = 0; n < 2; ++n) _Pragma("unroll") for (int k = 0; k < 2; ++k) dst[n][k] = *(const PG8_LAS bf16x8*)(lds + PG8_SB(b, h) + boff + n * 2048 + k * 1024); } while (0)
#define PG8_MMA(ai, bj, At, Bt) do { __builtin_amdgcn_s_setprio(1); _Pragma("unroll") for (int m = 0; m < 4; ++m) _Pragma("unroll") for (int n = 0; n < 2; ++n) _Pragma("unroll") for (int k = 0; k < 2; ++k) \
        acc[ai][bj][m][n] = __builtin_amdgcn_mfma_f32_16x16x32_bf16(Bt[n][k], At[m][k], acc[ai][bj][m][n], 0, 0, 0); __builtin_amdgcn_s_setprio(0); } while (0)
#define PG8_WAIT_V(n) asm volatile("s_waitcnt vmcnt(" #n ")" ::: "memory")
#define PG8_WAIT_L(n) asm volatile("s_waitcnt lgkmcnt(" #n ")" ::: "memory")
#define PG8_BAR __builtin_amdgcn_s_barrier()
#define PG8_SCHED __builtin_amdgcn_sched_barrier(0)
    Unit cur, nxt; int ui = 0;
    if (!S.next(0, cur)) return;
    f32x4 acc[2][2][4][2];
#pragma unroll
    for (int a = 0; a < 2; ++a)
#pragma unroll
        for (int b = 0; b < 2; ++b)
#pragma unroll
            for (int m = 0; m < 4; ++m)
#pragma unroll
                for (int n = 0; n < 2; ++n) acc[a][b][m][n] = (f32x4){0.f, 0.f, 0.f, 0.f};
    bf16x8 At[4][2], B0[2][2], B1[2][2];
    const char* cA = (const char*)g.A + (size_t)cur.pm * tstep; const char* cB = (const char*)g.Bt + (size_t)cur.pn * tstep;
    S.a_ready(cur);
    if constexpr (SP2) {
        PG8_STAGE(PG8_SB(0, 0), cB, voffB); PG8_STAGE(PG8_SB(0, 1), cB + hstep, voffB); PG8_STAGE(PG8_SA(0, 0), cA, voffA); PG8_STAGE(PG8_SA(0, 1), cA + hstep, voffA);
        if (wr == 1) PG8_BAR;
        PG8_WAIT_V(2); PG8_BAR;
        PG8_STAGE(PG8_SB(1, 0), cB + kstep, voffB); PG8_STAGE(PG8_SA(1, 0), cA + kstep, voffA); PG8_STAGE(PG8_SB(1, 1), cB + hstep + kstep, voffB);
        PG8_WAIT_V(6); PG8_BAR;
    } else {
        PG8_STAGE(PG8_SB(0, 0), cB, voffB); PG8_STAGE(PG8_SA(0, 0), cA, voffA); PG8_STAGE(PG8_SB(0, 1), cB + hstep, voffB); PG8_STAGE(PG8_SA(0, 1), cA + hstep, voffA);
        if (wr == 1) PG8_BAR;
        PG8_WAIT_V(4); PG8_BAR;
        PG8_STAGE(PG8_SB(1, 0), cB + kstep, voffB); PG8_STAGE(PG8_SA(1, 0), cA + kstep, voffA); PG8_STAGE(PG8_SB(1, 1), cB + hstep + kstep, voffB);
        PG8_WAIT_V(6); PG8_BAR;
    }
    for (;;) {
        const bool has_next = S.next(ui + 1, nxt);
        const char* nA = has_next ? (const char*)g.A + (size_t)nxt.pm * tstep : cA; const char* nB = has_next ? (const char*)g.Bt + (size_t)nxt.pn * tstep : cB;
        for (int t = 0; t < nt; t += 2) {
            const bool last = (t == nt - 2);
            const char* a1 = cA + (size_t)(t + 1) * kstep;
            const char* a2 = last ? nA : cA + (size_t)(t + 2) * kstep; const char* b2 = last ? nB : cB + (size_t)(t + 2) * kstep;
            const char* a3 = a2 + kstep; const char* b3 = b2 + kstep;
            if (last && has_next) S.a_ready(nxt);
            if constexpr (SP2) {
            PG8_LDB(B0, 0, 0); PG8_LDB(B1, 0, 1); PG8_SCHED; PG8_LDA(At, 0, 0); PG8_STAGE(PG8_SA(1, 1), a1 + hstep, voffA);
            PG8_WAIT_V(8); PG8_WAIT_L(0); PG8_BAR; PG8_MMA(0, 0, At, B0); PG8_MMA(0, 1, At, B1); PG8_BAR; PG8_SCHED;
            PG8_LDA(At, 0, 1); PG8_STAGE(PG8_SB(0, 0), b2, voffB); PG8_STAGE(PG8_SB(0, 1), b2 + hstep, voffB); PG8_STAGE(PG8_SA(0, 0), a2, voffA);
            PG8_WAIT_V(8); PG8_WAIT_L(0); PG8_BAR; PG8_MMA(1, 0, At, B0); PG8_MMA(1, 1, At, B1); PG8_BAR; PG8_SCHED;
            PG8_LDB(B0, 1, 0); PG8_LDB(B1, 1, 1); PG8_SCHED; PG8_LDA(At, 1, 0); PG8_STAGE(PG8_SA(0, 1), a2 + hstep, voffA);
            PG8_WAIT_V(8); PG8_WAIT_L(0); PG8_BAR; PG8_MMA(0, 0, At, B0); PG8_MMA(0, 1, At, B1); PG8_BAR; PG8_SCHED;
            PG8_LDA(At, 1, 1); PG8_STAGE(PG8_SB(1, 0), b3, voffB); PG8_STAGE(PG8_SB(1, 1), b3 + hstep, voffB); PG8_STAGE(PG8_SA(1, 0), a3, voffA);
            PG8_WAIT_V(8); PG8_WAIT_L(0); PG8_BAR; PG8_MMA(1, 0, At, B0); PG8_MMA(1, 1, At, B1); PG8_BAR; PG8_SCHED;
            } else {
            PG8_LDB(B0, 0, 0); PG8_SCHED; PG8_LDA(At, 0, 0); PG8_STAGE(PG8_SA(1, 1), a1 + hstep, voffA);
            PG8_WAIT_L(8); PG8_BAR; PG8_WAIT_L(0); PG8_MMA(0, 0, At, B0); PG8_BAR; PG8_SCHED;
            PG8_LDB(B1, 0, 1); PG8_STAGE(PG8_SB(0, 0), b2, voffB);
            PG8_BAR; PG8_WAIT_L(0); PG8_MMA(0, 1, At, B1); PG8_BAR;
            PG8_LDA(At, 0, 1); PG8_STAGE(PG8_SA(0, 0), a2, voffA);
            PG8_BAR; PG8_WAIT_L(0); PG8_MMA(1, 0, At, B0); PG8_BAR; PG8_SCHED;
            PG8_STAGE(PG8_SB(0, 1), b2 + hstep, voffB);
            PG8_WAIT_V(6); PG8_BAR; PG8_MMA(1, 1, At, B1); PG8_BAR;
            PG8_LDB(B0, 1, 0); PG8_SCHED; PG8_LDA(At, 1, 0); PG8_STAGE(PG8_SA(0, 1), a2 + hstep, voffA);
            PG8_WAIT_L(8); PG8_BAR; PG8_WAIT_L(0); PG8_MMA(0, 0, At, B0); PG8_BAR; PG8_SCHED;
            PG8_LDB(B1, 1, 1); PG8_STAGE(PG8_SB(1, 0), b3, voffB);
            PG8_BAR; PG8_WAIT_L(0); PG8_MMA(0, 1, At, B1); PG8_BAR;
            PG8_LDA(At, 1, 1); PG8_STAGE(PG8_SA(1, 0), a3, voffA);
            PG8_BAR; PG8_WAIT_L(0); PG8_MMA(1, 0, At, B0); PG8_BAR; PG8_SCHED;
            PG8_STAGE(PG8_SB(1, 1), b3 + hstep, voffB);
            PG8_WAIT_V(6); PG8_BAR; PG8_MMA(1, 1, At, B1); PG8_BAR;
            }
        }
        if constexpr (ALIGN_EPI) { if (wr == 0) PG8_BAR; }
        if constexpr (!Epi::AFTER_DRAIN) { E(acc, cur, wr, wc, fr, fq); S.done(cur); }
        if (!has_next) break;
#pragma unroll
        for (int a = 0; a < 2; ++a)
#pragma unroll
            for (int b = 0; b < 2; ++b)
#pragma unroll
                for (int m = 0; m < 4; ++m)
#pragma unroll
                    for (int n = 0; n < 2; ++n) acc[a][b][m][n] = (f32x4){0.f, 0.f, 0.f, 0.f};
        cur = nxt; cA = nA; cB = nB; ++ui;
        if constexpr (ALIGN_EPI) { if (wr == 1) PG8_BAR; }
    }
    PG8_WAIT_V(0);
    if constexpr (!ALIGN_EPI) { if (wr == 0) PG8_BAR; }
    PG8_BAR;
    if constexpr (Epi::AFTER_DRAIN) { E.fused(acc, cur, wr, wc, fr, fq, lds, wid, lane); S.done(cur); }
#undef PG8_SA
#undef PG8_SB
#undef PG8_STAGE
#undef PG8_LDA
#undef PG8_LDB
#undef PG8_MMA
#undef PG8_WAIT_V
#undef PG8_WAIT_L
#undef PG8_BAR
#undef PG8_SCHED
}
}
typedef unsigned short bf16_t;
constexpr int D = 2048, BATCH = 4, SEQ = 2048, T = BATCH * SEQ;
constexpr int NPROJ = 7184, NP = 7424;
constexpr int C_GQ = 0, C_GK = 512, C_GV = 1024, C_GR = 2048, C_RQ = 3072, C_RK = 4096, C_RV = 5120, C_RR = 6144, C_GLR = 7168;
constexpr int NCH = 32, CH = 64;
constexpr float ALPHA = 1.189207115002721f;
constexpr float LN_EPS = 1e-5f;
constexpr size_t MiB = 1u << 20;
constexpr size_t WS_CTL = 0, CTL_ZERO_BYTES = 1 * MiB, WS_WIN = 1 * MiB, WS_WOUT = 31 * MiB, WS_WQ = 39 * MiB, WS_SKB = 47 * MiB, WS_ROPE = 48 * MiB,
                 WS_UB = 50 * MiB, WS_VB = 114 * MiB, WS_XB = 178 * MiB, WS_PROJ = 210 * MiB, WS_BC = 326 * MiB, WS_UT = 342 * MiB,
                 WS_O = 438 * MiB, WS_END = 470 * MiB;
constexpr size_t WS_Y = 210 * MiB, WS_H1B = 274 * MiB, WS_EXP = 306 * MiB, WS_GATE = 310 * MiB;
constexpr size_t WS_Q = 342 * MiB;
constexpr size_t UT_RET_OFF = (size_t)16 * 32 * 256 * 128;
constexpr int CW_BAR = 4096;
constexpr int NWAVES = 8;
constexpr int RING_BYTES = 131072, LDSCTL_OFF = RING_BYTES, MISC_OFF = LDSCTL_OFF + 320, LDS_BYTES = 147456;

#define GAS __attribute__((address_space(1)))
#define LAS __attribute__((address_space(3)))
typedef unsigned v4u __attribute__((ext_vector_type(4)));
typedef unsigned v2u __attribute__((ext_vector_type(2)));
typedef float f32x4 __attribute__((ext_vector_type(4)));
typedef float f32x16 __attribute__((ext_vector_type(16)));
typedef short bf16x8 __attribute__((ext_vector_type(8)));
typedef short bf16x4 __attribute__((ext_vector_type(4)));
typedef GAS unsigned gu32;
#define RLX_AGENT __ATOMIC_RELAXED, __HIP_MEMORY_SCOPE_AGENT
#define LDS_WAIT() asm volatile("s_waitcnt lgkmcnt(0)" ::: "memory")
#define VM_WAIT() asm volatile("s_waitcnt vmcnt(0)" ::: "memory")
__device__ __forceinline__ float bf2f(bf16_t v) { return __uint_as_float(((unsigned)v) << 16); }
__device__ __forceinline__ unsigned f2bfu(float f) { unsigned u = __float_as_uint(f); return (u + 0x7fffu + ((u >> 16) & 1u)) >> 16; }
__device__ __forceinline__ bf16_t f2bf(float f) { return (bf16_t)f2bfu(f); }
__device__ __forceinline__ unsigned pk2(float lo, float hi) { return f2bfu(lo) | (f2bfu(hi) << 16); }
__device__ __forceinline__ float bflo(unsigned w) { return __uint_as_float(w << 16); }
__device__ __forceinline__ float bfhi(unsigned w) { return __uint_as_float(w & 0xffff0000u); }
__device__ __forceinline__ float wave_sum(float v) {
#pragma unroll
    for (int o = 1; o < 64; o <<= 1) v += __shfl_xor(v, o);
    return v;
}
__device__ __forceinline__ float gamma_log(int h) { return logf(1.0f - exp2f(-5.0f - (float)h)); }

#define XB_TMO      128
#define XB_XCNT(j)  (256  + 64 * (j))
#define XB_XSUB(j)  (1280 + 64 * (j))
#define XB_XGEN(j)  (2304 + 64 * (j))
#define XB_TOP      3328
#define XB_TOPGEN   3392
#define XCD_BAR_WORDS 3456
#define XB_SPIN_CAP (1u << 18)

__device__ __forceinline__ unsigned xb_ld(unsigned* p)              { return __hip_atomic_load(p, __ATOMIC_RELAXED, __HIP_MEMORY_SCOPE_AGENT); }
__device__ __forceinline__ unsigned xb_add(unsigned* p, unsigned v) { return __hip_atomic_fetch_add(p, v, __ATOMIC_RELAXED, __HIP_MEMORY_SCOPE_AGENT); }
__device__ __forceinline__ unsigned xb_xcc_id() { return (unsigned)__builtin_amdgcn_s_getreg((3 << 11) | 20) & 0xFu; }
#define XB_SPIN(cond, bar) do { unsigned _sp = 0; while (cond) { __builtin_amdgcn_s_sleep(1); \
    if ((++_sp & 255u) == 0u) { if (xb_ld(&(bar)[XB_TMO])) break; if (_sp > XB_SPIN_CAP) { atomicAdd(&(bar)[XB_TMO], 1u); break; } } } } while (0)

struct XcdBarrier {
    unsigned* bar; unsigned x;
    volatile LAS unsigned* st;
};

__device__ __forceinline__ XcdBarrier xcd_barrier_post(unsigned* bar, volatile LAS unsigned* st) {
    XcdBarrier b; b.bar = bar; b.x = xb_xcc_id(); b.st = st;
    if (threadIdx.x == 0) (void)xb_add(&bar[XB_XCNT(b.x)], 1u);
    return b;
}
__device__ __forceinline__ void xcd_barrier_complete(unsigned* bar, unsigned x, unsigned& nloc, unsigned& nx) {
    const unsigned G = gridDim.x * gridDim.y * gridDim.z;
    unsigned sum, cnt, mine, sp = 0u;
    for (;;) {
        sum = 0u; cnt = 0u; mine = 0u;
#pragma unroll
        for (unsigned j = 0; j < 16; ++j) { const unsigned c = xb_ld(&bar[XB_XCNT(j)]); sum += c; cnt += (c > 0u) ? 1u : 0u; mine = (j == x) ? c : mine; }
        if (sum == G) break;
        __builtin_amdgcn_s_sleep(1);
        if ((++sp & 255u) == 0u) { if (xb_ld(&bar[XB_TMO])) break; if (sp > XB_SPIN_CAP) { atomicAdd(&bar[XB_TMO], 1u); break; } }
    }
    nloc = mine > 0u ? mine : 1u; nx = cnt > 0u ? cnt : 1u;
}

__device__ __forceinline__ void xcd_barrier(const XcdBarrier& b) {
    asm volatile("s_waitcnt vmcnt(0)" ::: "memory");
    __syncthreads();
    if (threadIdx.x == 0) {
        unsigned* bar = b.bar;
        __builtin_amdgcn_s_waitcnt(0);
        unsigned nloc = b.st[0], nx = b.st[1];
        if (nloc == 0u) { xcd_barrier_complete(bar, b.x, nloc, nx); b.st[0] = nloc; b.st[1] = nx; }
        const unsigned old = xb_add(&bar[XB_XSUB(b.x)], 1u);
        const unsigned gen = old / nloc;
        if (old + 1u == (gen + 1u) * nloc) {
            __builtin_amdgcn_fence(__ATOMIC_RELEASE, "agent");
            asm volatile("s_waitcnt vmcnt(0)" ::: "memory");
            const unsigned og = xb_add(&bar[XB_TOP], 1u);
            const unsigned tg = og / nx;
            if (og + 1u == (tg + 1u) * nx) xb_add(&bar[XB_TOPGEN], 1u);
            else XB_SPIN(xb_ld(&bar[XB_TOPGEN]) == tg, bar);
            __builtin_amdgcn_fence(__ATOMIC_ACQUIRE, "agent");
            xb_add(&bar[XB_XGEN(b.x)], 1u);
            asm volatile("s_waitcnt vmcnt(0)" ::: "memory");
        } else {
            XB_SPIN(xb_ld(&bar[XB_XGEN(b.x)]) == gen, bar);
            __builtin_amdgcn_fence(__ATOMIC_ACQUIRE, "agent");
            asm volatile("s_waitcnt vmcnt(0)" ::: "memory");
        }
    }
    __syncthreads();
}
struct Frame {
    LAS unsigned char* lds;
    int tid, lane, wave, vcu, G;
};
struct Args { const float* in[15]; float* out; unsigned char* ws; int ph_lo, ph_hi, li, pad; };

__device__ __forceinline__ unsigned lds_addr(const LAS unsigned char* p) { return (unsigned)(unsigned long)p; }
__device__ __forceinline__ unsigned tr_lane_off(int lane, int S) { const int h = lane >> 5, blk = (lane >> 4) & 1, q = (lane & 15) >> 2, p = lane & 3; return (unsigned)((8 * h + q) * S + 32 * blk + 8 * p); }
template <int OFF0, int OFF1> __device__ __forceinline__ bf16x8 tr_frag(unsigned base) {
    bf16x4 lo, hi;
    asm volatile("ds_read_b64_tr_b16 %0, %2 offset:%3\n\tds_read_b64_tr_b16 %1, %2 offset:%4\n\ts_waitcnt lgkmcnt(0)" : "=&v"(lo), "=&v"(hi) : "v"(base), "i"(OFF0), "i"(OFF1) : "memory");
    return __builtin_shufflevector(lo, hi, 0, 1, 2, 3, 4, 5, 6, 7);
}
__device__ __forceinline__ bf16x8 row_frag(const LAS unsigned char* tile, int S, int row0, int s, int lane) {
    return *(const LAS bf16x8*)(tile + (row0 + (lane & 31)) * S + 32 * s + 16 * (lane >> 5));
}
template <int W, int S> __device__ __forceinline__ void stage_tile(LAS unsigned char* dst, const bf16_t* src, int tid) {
    constexpr int PPR = W / 8;
#pragma unroll
    for (int i = 0; i < 64 * PPR / 512; ++i) { const int pi = tid + 512 * i, r = pi / PPR, c = pi % PPR;
        const v4u v = *(const GAS v4u*)(src + (size_t)r * NP + c * 8); *(LAS v4u*)(dst + r * S + c * 16) = v; }
}
__device__ __forceinline__ void unit_head(int item, int& bchunk, int& head) { bchunk = item >> 3; head = ((item & 7) + 4 * ((item >> 8) & 1)) & 7; }
constexpr int SV = 576, SK128 = 320, SQ128 = 272, SQ256 = 528, SP = 144, SO = 1040;

constexpr int P2_V = 0, P2_K = 36864, P2_SB = 73728, P2_GLR = 106496, P2_GTOT = 110592;
__device__ __forceinline__ void chunk_u_phase(const Frame& F, const bf16_t* PROJ, const float* wg, const float* bg, float* BC, bf16_t* UT) {
    const int tid = F.tid, lane = F.lane, w = F.wave;
    LAS unsigned char* L = F.lds;
    for (int item = F.vcu; item < BATCH * NCH * 8; item += F.G) {
        int bchunk, head; unit_head(item, bchunk, head);
        const int b = bchunk / NCH, ch = bchunk % NCH, t0 = b * SEQ + ch * CH;
        const bf16_t* prow = PROJ + (size_t)t0 * NP;
        if (head < 4) {
            const int h = head;
            stage_tile<256, SV>(L + P2_V, prow + C_GV + h * 256, tid);
            for (int i = tid; i < 64 * 16; i += 512) ((LAS float*)(L + P2_GLR))[i] = bf2f(prow[(size_t)(i >> 4) * NP + C_GLR + (i & 15)]);
            const int d = tid & 127, cg = tid >> 7;
            float wc[16];
#pragma unroll
            for (int r = 0; r < 16; ++r) wc[r] = wg[r * 512 + h * 128 + d];
            const float bias = bg[h * 128 + d];
            __syncthreads();
            float run = 0.f;
            LAS float* sb = (LAS float*)(L + P2_SB);
#pragma unroll 4
            for (int cc = 0; cc < 16; ++cc) { const int c = cg * 16 + cc; const LAS f32x4* gp = (const LAS f32x4*)(L + P2_GLR + c * 64);
                float z = bias;
#pragma unroll
                for (int r4 = 0; r4 < 4; ++r4) { const f32x4 gv = gp[r4]; z = fmaf(gv[0], wc[4 * r4], z); z = fmaf(gv[1], wc[4 * r4 + 1], z); z = fmaf(gv[2], wc[4 * r4 + 2], z); z = fmaf(gv[3], wc[4 * r4 + 3], z); }
                const float ls = fminf(z, 0.f) - __logf(1.0f + __expf(-fabsf(z)));
                run += ls * (1.0f / 16.0f); sb[c * 128 + d] = run; }
            ((LAS float*)(L + P2_GTOT))[cg * 128 + d] = run;
            __syncthreads();
            float off = 0.f;
#pragma unroll
            for (int g = 0; g < 3; ++g) off += (g < cg) ? ((LAS float*)(L + P2_GTOT))[g * 128 + d] : 0.f;
#pragma unroll 4
            for (int cc = 0; cc < 16; ++cc) { const int c = cg * 16 + cc; const float v = sb[c * 128 + d] + off; sb[c * 128 + d] = v; BC[(size_t)(t0 + c) * 512 + h * 128 + d] = v; }
            __syncthreads();
#pragma unroll
            for (int i = 0; i < 2; ++i) { const int pi = tid + 512 * i, c = pi >> 4, d0 = (pi & 15) * 8;
                const v4u kv = *(const GAS v4u*)(prow + (size_t)c * NP + C_GK + h * 128 + d0);
                const f32x4 b0 = *(const LAS f32x4*)(sb + c * 128 + d0), b1 = *(const LAS f32x4*)(sb + c * 128 + d0 + 4);
                const f32x4 l0 = *(const LAS f32x4*)(sb + 63 * 128 + d0), l1 = *(const LAS f32x4*)(sb + 63 * 128 + d0 + 4);
                v4u o;
                o.x = pk2(bflo(kv.x) * __expf(l0[0] - b0[0]), bfhi(kv.x) * __expf(l0[1] - b0[1])); o.y = pk2(bflo(kv.y) * __expf(l0[2] - b0[2]), bfhi(kv.y) * __expf(l0[3] - b0[3]));
                o.z = pk2(bflo(kv.z) * __expf(l1[0] - b1[0]), bfhi(kv.z) * __expf(l1[1] - b1[1])); o.w = pk2(bflo(kv.w) * __expf(l1[2] - b1[2]), bfhi(kv.w) * __expf(l1[3] - b1[3]));
                *(LAS v4u*)(L + P2_K + c * SK128 + d0 * 2) = o; }
            __syncthreads();
            f32x16 acc[4];
#pragma unroll
            for (int i = 0; i < 4; ++i)
#pragma unroll
                for (int r = 0; r < 16; ++r) acc[i][r] = 0.f;
            const unsigned vb = lds_addr(L + P2_V) + tr_lane_off(lane, SV) + 64 * w, kb = lds_addr(L + P2_K) + tr_lane_off(lane, SK128);
#define P2G_STEP(ks) { const bf16x8 a = tr_frag<16 * (ks) * SV, 16 * (ks) * SV + 4 * SV>(vb); \
                acc[0] = __builtin_amdgcn_mfma_f32_32x32x16_bf16(a, tr_frag<16 * (ks) * SK128 + 0, 16 * (ks) * SK128 + 0 + 4 * SK128>(kb), acc[0], 0, 0, 0); \
                acc[1] = __builtin_amdgcn_mfma_f32_32x32x16_bf16(a, tr_frag<16 * (ks) * SK128 + 64, 16 * (ks) * SK128 + 64 + 4 * SK128>(kb), acc[1], 0, 0, 0); \
                acc[2] = __builtin_amdgcn_mfma_f32_32x32x16_bf16(a, tr_frag<16 * (ks) * SK128 + 128, 16 * (ks) * SK128 + 128 + 4 * SK128>(kb), acc[2], 0, 0, 0); \
                acc[3] = __builtin_amdgcn_mfma_f32_32x32x16_bf16(a, tr_frag<16 * (ks) * SK128 + 192, 16 * (ks) * SK128 + 192 + 4 * SK128>(kb), acc[3], 0, 0, 0); }
            P2G_STEP(0) P2G_STEP(1) P2G_STEP(2) P2G_STEP(3)
#undef P2G_STEP
            bf16_t* o = UT + ((size_t)(b * 4 + h) * NCH + ch) * 256 * 128;
#pragma unroll
            for (int rg = 0; rg < 4; ++rg) { bf16_t* pr = o + (size_t)(32 * w + 8 * rg + 4 * (lane >> 5)) * 128 + (lane & 31);
#pragma unroll
                for (int r3 = 0; r3 < 4; ++r3)
#pragma unroll
                    for (int i = 0; i < 4; ++i) pr[r3 * 128 + 32 * i] = (bf16_t)pg8::cvt_pk_bf16(acc[i][rg * 4 + r3], 0.f);
                asm volatile("" ::: "memory"); }
        } else {
            const int h = head - 4; const float lg2 = gamma_log(h) * 1.4426950408889634f;
            stage_tile<256, SV>(L + P2_V, prow + C_RV + h * 256, tid);
#pragma unroll
            for (int i = 0; i < 4; ++i) { const int pi = tid + 512 * i, c = pi >> 5, d0 = (pi & 31) * 8;
                const v4u kv = *(const GAS v4u*)(prow + (size_t)c * NP + C_RK + h * 256 + d0);
                const float sc = exp2f(lg2 * (float)(63 - c));
                v4u o; o.x = pk2(bflo(kv.x) * sc, bfhi(kv.x) * sc); o.y = pk2(bflo(kv.y) * sc, bfhi(kv.y) * sc); o.z = pk2(bflo(kv.z) * sc, bfhi(kv.z) * sc); o.w = pk2(bflo(kv.w) * sc, bfhi(kv.w) * sc);
                *(LAS v4u*)(L + P2_K + c * SV + d0 * 2) = o; }
            __syncthreads();
            f32x16 acc[8];
#pragma unroll
            for (int i = 0; i < 8; ++i)
#pragma unroll
                for (int r = 0; r < 16; ++r) acc[i][r] = 0.f;
            const unsigned vb = lds_addr(L + P2_V) + tr_lane_off(lane, SV) + 64 * w, kb = lds_addr(L + P2_K) + tr_lane_off(lane, SV);
#define P2R_MM(ks, dt) acc[dt] = __builtin_amdgcn_mfma_f32_32x32x16_bf16(a, tr_frag<16 * (ks) * SV + 64 * (dt), 16 * (ks) * SV + 64 * (dt) + 4 * SV>(kb), acc[dt], 0, 0, 0);
#define P2R_STEP(ks) { const bf16x8 a = tr_frag<16 * (ks) * SV, 16 * (ks) * SV + 4 * SV>(vb); P2R_MM(ks, 0) P2R_MM(ks, 1) P2R_MM(ks, 2) P2R_MM(ks, 3) P2R_MM(ks, 4) P2R_MM(ks, 5) P2R_MM(ks, 6) P2R_MM(ks, 7) }
            P2R_STEP(0) P2R_STEP(1) P2R_STEP(2) P2R_STEP(3)
#undef P2R_STEP
#undef P2R_MM
            bf16_t* o = UT + UT_RET_OFF + ((size_t)(b * 4 + h) * NCH + ch) * 256 * 256;
#pragma unroll
            for (int rg = 0; rg < 4; ++rg) { bf16_t* pr = o + (size_t)(32 * w + 8 * rg + 4 * (lane >> 5)) * 256 + (lane & 31);
#pragma unroll
                for (int r3 = 0; r3 < 4; ++r3)
#pragma unroll
                    for (int i = 0; i < 8; ++i) pr[r3 * 256 + 32 * i] = (bf16_t)pg8::cvt_pk_bf16(acc[i][rg * 4 + r3], 0.f);
                asm volatile("" ::: "memory"); }
        }
        __syncthreads();
    }
}

constexpr int P4_QP = 0, P4_QM = 17408, P4_KP = 34816, P4_KM = 52224, P4_RQ = 0, P4_RK = 33792, P4_V = 69632, P4_P = 106496, P4_O = 0;
__device__ __forceinline__ void chunk_o_phase(const Frame& F, const bf16_t* PROJ, const float* BC, const bf16_t* ST, const float* gla_g, const float* ret_g, bf16_t* O) {
    const int tid = F.tid, lane = F.lane, w = F.wave, hh = lane >> 5;
    LAS unsigned char* L = F.lds;
    for (int item = F.vcu; item < BATCH * NCH * 8; item += F.G) {
        int bchunk, head; unit_head(item, bchunk, head);
        const int b = bchunk / NCH, ch = bchunk % NCH, t0 = b * SEQ + ch * CH;
        const bf16_t* prow = PROJ + (size_t)t0 * NP;
        f32x16 acc[2];
#pragma unroll
        for (int i = 0; i < 2; ++i)
#pragma unroll
            for (int r = 0; r < 16; ++r) acc[i][r] = 0.f;
        const bool gla = head < 4; const int h = head & 3;
        if (gla) {
            stage_tile<256, SV>(L + P4_V, prow + C_GV + h * 256, tid);
#pragma unroll
            for (int i = 0; i < 2; ++i) { const int pi = tid + 512 * i, c = pi >> 4, d0 = (pi & 15) * 8;
                const v4u qv = *(const GAS v4u*)(prow + (size_t)c * NP + C_GQ + h * 128 + d0), kv = *(const GAS v4u*)(prow + (size_t)c * NP + C_GK + h * 128 + d0);
                const GAS f32x4* bp = (const GAS f32x4*)(BC + (size_t)(t0 + c) * 512 + h * 128 + d0); const f32x4 b0 = bp[0], b1 = bp[1];
                float eb[8], em[8];
#pragma unroll
                for (int j = 0; j < 4; ++j) { eb[j] = __expf(b0[j]); eb[4 + j] = __expf(b1[j]); em[j] = __expf(-b0[j]); em[4 + j] = __expf(-b1[j]); }
                const unsigned qa[4] = {qv.x, qv.y, qv.z, qv.w}, ka[4] = {kv.x, kv.y, kv.z, kv.w};
                v4u qp, qm, kp, km;
#pragma unroll
                for (int j = 0; j < 4; ++j) { const float q0 = bflo(qa[j]), q1 = bfhi(qa[j]), k0 = bflo(ka[j]), k1 = bfhi(ka[j]);
                    qp[j] = pk2(q0 * eb[2 * j], q1 * eb[2 * j + 1]); qm[j] = pk2(q0 * em[2 * j], q1 * em[2 * j + 1]);
                    kp[j] = pk2(k0 * eb[2 * j], k1 * eb[2 * j + 1]); km[j] = pk2(k0 * em[2 * j], k1 * em[2 * j + 1]); }
                const int lo = c * SQ128 + d0 * 2;
                *(LAS v4u*)(L + P4_QP + lo) = qp; *(LAS v4u*)(L + P4_QM + lo) = qm; *(LAS v4u*)(L + P4_KP + lo) = kp; *(LAS v4u*)(L + P4_KM + lo) = km; }
            __syncthreads();
            if (w < 4) {
                const int ti = w >> 1, tj = w & 1;
                f32x16 s1, s2;
#pragma unroll
                for (int r = 0; r < 16; ++r) { s1[r] = 0.f; s2[r] = 0.f; }
                if (ti >= tj) {
#pragma unroll
                    for (int s = 0; s < 8; ++s) s1 = __builtin_amdgcn_mfma_f32_32x32x16_bf16(row_frag(L + P4_QP, SQ128, 32 * ti, s, lane), row_frag(L + P4_KM, SQ128, 32 * tj, s, lane), s1, 0, 0, 0);
                }
                if (ti <= tj) {
#pragma unroll
                    for (int s = 0; s < 8; ++s) s2 = __builtin_amdgcn_mfma_f32_32x32x16_bf16(row_frag(L + P4_QM, SQ128, 32 * ti, s, lane), row_frag(L + P4_KP, SQ128, 32 * tj, s, lane), s2, 0, 0, 0);
                }
                const int m = 32 * tj + (lane & 31);
#pragma unroll
                for (int r = 0; r < 16; ++r) { const int n = 32 * ti + (r & 3) + 8 * (r >> 2) + 4 * hh;
                    *(LAS bf16_t*)(L + P4_P + n * SP + m * 2) = f2bf(n >= m ? s1[r] : s2[r]); }
            }
            {
                const bf16_t* sp = ST + ((size_t)(b * 4 + h) * NCH + ch) * 256 * 128 + (size_t)(32 * w + (lane & 31)) * 128 + 8 * hh;
#pragma unroll
                for (int s = 0; s < 8; ++s) { const bf16x8 bs = *(const GAS bf16x8*)(sp + 16 * s);
                    acc[0] = __builtin_amdgcn_mfma_f32_32x32x16_bf16(row_frag(L + P4_QP, SQ128, 0, s, lane), bs, acc[0], 0, 0, 0);
                    acc[1] = __builtin_amdgcn_mfma_f32_32x32x16_bf16(row_frag(L + P4_QP, SQ128, 32, s, lane), bs, acc[1], 0, 0, 0); }
            }
        } else {
            stage_tile<256, SV>(L + P4_V, prow + C_RV + h * 256, tid);
            stage_tile<256, SQ256>(L + P4_RQ, prow + C_RQ + h * 256, tid);
            stage_tile<256, SQ256>(L + P4_RK, prow + C_RK + h * 256, tid);
            __syncthreads();
            const float lg2 = gamma_log(h) * 1.4426950408889634f;
            if (w < 4) {
                const int ti = w >> 1, tj = w & 1;
                f32x16 s1;
#pragma unroll
                for (int r = 0; r < 16; ++r) s1[r] = 0.f;
#pragma unroll
                for (int s = 0; s < 16; ++s) s1 = __builtin_amdgcn_mfma_f32_32x32x16_bf16(row_frag(L + P4_RQ, SQ256, 32 * ti, s, lane), row_frag(L + P4_RK, SQ256, 32 * tj, s, lane), s1, 0, 0, 0);
                const int m = 32 * tj + (lane & 31);
#pragma unroll
                for (int r = 0; r < 16; ++r) { const int n = 32 * ti + (r & 3) + 8 * (r >> 2) + 4 * hh; const int dn = n > m ? n - m : m - n;
                    *(LAS bf16_t*)(L + P4_P + n * SP + m * 2) = f2bf(s1[r] * exp2f(lg2 * (float)dn)); }
            }
            {
                const bf16_t* sp = ST + UT_RET_OFF + ((size_t)(b * 4 + h) * NCH + ch) * 256 * 256 + (size_t)(32 * w + (lane & 31)) * 256 + 8 * hh;
#pragma unroll 4
                for (int s = 0; s < 16; ++s) { const bf16x8 bs = *(const GAS bf16x8*)(sp + 16 * s);
                    acc[0] = __builtin_amdgcn_mfma_f32_32x32x16_bf16(row_frag(L + P4_RQ, SQ256, 0, s, lane), bs, acc[0], 0, 0, 0);
                    acc[1] = __builtin_amdgcn_mfma_f32_32x32x16_bf16(row_frag(L + P4_RQ, SQ256, 32, s, lane), bs, acc[1], 0, 0, 0); }
#pragma unroll
                for (int i = 0; i < 2; ++i)
#pragma unroll
                    for (int r = 0; r < 16; ++r) { const int n = 32 * i + (r & 3) + 8 * (r >> 2) + 4 * hh; acc[i][r] *= exp2f(lg2 * (float)(n + 1)); }
            }
        }
        __syncthreads();
        {
            const unsigned vb = lds_addr(L + P4_V) + tr_lane_off(lane, SV) + 64 * w;
#define P4_STEP(ks) { const bf16x8 bv = tr_frag<16 * (ks) * SV, 16 * (ks) * SV + 4 * SV>(vb); \
                acc[0] = __builtin_amdgcn_mfma_f32_32x32x16_bf16(row_frag(L + P4_P, SP, 0, ks, lane), bv, acc[0], 0, 0, 0); \
                acc[1] = __builtin_amdgcn_mfma_f32_32x32x16_bf16(row_frag(L + P4_P, SP, 32, ks, lane), bv, acc[1], 0, 0, 0); }
            P4_STEP(0) P4_STEP(1) P4_STEP(2) P4_STEP(3)
#undef P4_STEP
        }
        __syncthreads();
#pragma unroll
        for (int i = 0; i < 2; ++i)
#pragma unroll
            for (int r = 0; r < 16; ++r) { const int n = 32 * i + (r & 3) + 8 * (r >> 2) + 4 * hh; *(LAS float*)(L + P4_O + n * SO + (32 * w + (lane & 31)) * 4) = acc[i][r]; }
        __syncthreads();
        {
            const f32x4 gn = *(const GAS f32x4*)((gla ? gla_g : ret_g) + h * 256 + 4 * lane);
            const int gcol = (gla ? C_GR : C_RR) + h * 256 + 4 * lane, ocol = (gla ? 0 : 1024) + h * 256 + 4 * lane;
#pragma unroll 2
            for (int rr = 0; rr < 8; ++rr) { const int n = 8 * w + rr;
                f32x4 v = *(const LAS f32x4*)(L + P4_O + n * SO + lane * 16);
                if (!gla) { const float mu = wave_sum((v[0] + v[1]) + (v[2] + v[3])) * (1.0f / 256.0f); v = v - mu; }
                const float ss = wave_sum((v[0] * v[0] + v[1] * v[1]) + (v[2] * v[2] + v[3] * v[3]));
                const float rs = rsqrtf(ss * (1.0f / 256.0f) + LN_EPS);
                const v2u gw = *(const GAS v2u*)(prow + (size_t)n * NP + gcol);
                const float g0 = bflo(gw.x), g1 = bfhi(gw.x), g2 = bflo(gw.y), g3 = bfhi(gw.y);
                const float o0 = v[0] * rs * gn[0] * g0 / (1.0f + __expf(-g0)), o1 = v[1] * rs * gn[1] * g1 / (1.0f + __expf(-g1));
                const float o2 = v[2] * rs * gn[2] * g2 / (1.0f + __expf(-g2)), o3 = v[3] * rs * gn[3] * g3 / (1.0f + __expf(-g3));
                v2u ow; ow.x = pk2(o0, o1); ow.y = pk2(o2, o3);
                *(GAS v2u*)(O + (size_t)(t0 + n) * D + ocol) = ow; }
        }
        __syncthreads();
    }
}
__device__ __forceinline__ void scan_phase(const Frame& F, bf16_t* UT, const float* BC) {
    const size_t gtid = (size_t)F.vcu * (NWAVES * 64) + F.tid, gthreads = (size_t)F.G * (NWAVES * 64);
    constexpr size_t NG4 = (size_t)16 * 256 * 128 / 4, NR4 = (size_t)16 * 256 * 256 / 4;
    for (size_t it = gtid; it < NG4 + NR4; it += gthreads) {
        float s0 = 0.f, s1 = 0.f, s2 = 0.f, s3 = 0.f;
        if (it < NG4) {
            const size_t el = it * 4; const int bh = (int)(el >> 15), d = (int)(el & 127), b = bh >> 2, h = bh & 3;
            GAS v2u* p = (GAS v2u*)(UT + (size_t)bh * NCH * 32768 + (el & 32767));
            const GAS f32x4* bp = (const GAS f32x4*)(BC + (size_t)(b * SEQ + 63) * 512 + h * 128 + d);
#pragma unroll 4
            for (int i = 0; i < NCH; ++i) {
                const v2u u = p[(size_t)i * (32768 / 4)]; const f32x4 bl = bp[(size_t)i * (CH * 512 / 4)];
                v2u o; o.x = pk2(s0, s1); o.y = pk2(s2, s3); p[(size_t)i * (32768 / 4)] = o;
                s0 = fmaf(__expf(bl[0]), s0, bflo(u.x)); s1 = fmaf(__expf(bl[1]), s1, bfhi(u.x)); s2 = fmaf(__expf(bl[2]), s2, bflo(u.y)); s3 = fmaf(__expf(bl[3]), s3, bfhi(u.y));
            }
        } else {
            const size_t el = (it - NG4) * 4; const int bh = (int)(el >> 16), h = bh & 3;
            GAS v2u* p = (GAS v2u*)(UT + UT_RET_OFF + (size_t)bh * NCH * 65536 + (el & 65535));
            const float dec = __expf(gamma_log(h) * 64.0f);
#pragma unroll 4
            for (int i = 0; i < NCH; ++i) {
                const v2u u = p[(size_t)i * (65536 / 4)];
                v2u o; o.x = pk2(s0, s1); o.y = pk2(s2, s3); p[(size_t)i * (65536 / 4)] = o;
                s0 = fmaf(dec, s0, bflo(u.x)); s1 = fmaf(dec, s1, bfhi(u.x)); s2 = fmaf(dec, s2, bflo(u.y)); s3 = fmaf(dec, s3, bfhi(u.y));
            }
        }
    }
}

template <int N> __device__ __forceinline__ void topk16_joint(float (&v)[N], float (&out)[16]) {
#pragma unroll
    for (int r = 0; r < 16; ++r) {
        float m = v[0];
#pragma unroll
        for (int i = 1; i < N; ++i) m = fmaxf(m, v[i]);
        m = fmaxf(m, __shfl_xor(m, 32));
        out[r] = m;
#pragma unroll
        for (int i = 0; i < N; ++i) v[i] = (v[i] == m) ? -INFINITY : v[i];
    }
}
struct CandTab { int ci[50], cj[50]; };
constexpr CandTab make_cands() { CandTab t{}; int n = 0; for (int i = 0; i < 16; ++i) for (int j = 0; j < 16; ++j) if ((i + 1) * (j + 1) <= 16) { t.ci[n] = i; t.cj[n] = j; ++n; } return t; }
constexpr CandTab CANDS = make_cands();

template <int S> __device__ __forceinline__ float cand_slot(const float (&la)[16], const float (&lb)[16], int hh) {
    constexpr int i0 = CANDS.ci[2 * S], j0 = CANDS.cj[2 * S], i1 = CANDS.ci[2 * S + 1], j1 = CANDS.cj[2 * S + 1];
    const float sa = __uint_as_float(__float_as_uint(la[i0]) & ~127u) + __uint_as_float(__float_as_uint(lb[j0]) & ~127u);
    const float sb = __uint_as_float(__float_as_uint(la[i1]) & ~127u) + __uint_as_float(__float_as_uint(lb[j1]) & ~127u);
    const unsigned pa = (__float_as_uint(sa) & ~255u) | (unsigned)(i0 * 16 + j0);
    const unsigned pb = (__float_as_uint(sb) & ~255u) | (unsigned)(i1 * 16 + j1);
    return __uint_as_float(hh ? pb : pa);
}
template <int... S> __device__ __forceinline__ void cand_slots(float (&slot)[25], const float (&la)[16], const float (&lb)[16], int hh, std::integer_sequence<int, S...>) {
    ((slot[S] = cand_slot<S>(la, lb, hh)), ...);
}
__device__ __forceinline__ void peer_topk_phase(const Frame& F, const bf16_t* Q, const bf16_t* SKB, int* EXP, float* GATE) {
    const int lane = F.lane, tok = lane & 31, hh = lane >> 5, h = F.wave;
    for (int blk = F.vcu; blk < T / 32; blk += F.G) {
        const int t0 = blk * 32;
        float lab[2][16];
#pragma unroll
        for (int p = 0; p < 2; ++p) {
            f32x16 acc[4];
#pragma unroll
            for (int i = 0; i < 4; ++i)
#pragma unroll
                for (int r = 0; r < 16; ++r) acc[i][r] = 0.f;
            const bf16_t* qrow = Q + (size_t)(t0 + tok) * D + h * 256 + p * 128 + 8 * hh;
            const bf16_t* skrow = SKB + ((size_t)(h * 2 + p) * 128 + tok) * 128 + 8 * hh;
#pragma unroll 2
            for (int s = 0; s < 8; ++s) {
                const bf16x8 bq = *(const bf16x8*)(qrow + 16 * s);
#pragma unroll
                for (int i = 0; i < 4; ++i) { const bf16x8 ak = *(const bf16x8*)(skrow + (size_t)i * 32 * 128 + 16 * s);
                    acc[i] = __builtin_amdgcn_mfma_f32_32x32x16_bf16(ak, bq, acc[i], 0, 0, 0); }
            }
            float v[64];
#pragma unroll
            for (int i = 0; i < 4; ++i)
#pragma unroll
                for (int r = 0; r < 16; ++r) { const unsigned kb = 32u * i + (r & 3) + 8u * (r >> 2);
                    v[i * 16 + r] = __uint_as_float((__float_as_uint(acc[i][r]) & ~127u) | kb | ((unsigned)hh << 2)); }
            topk16_joint<64>(v, lab[p]);
        }
        float slot[25];
        cand_slots(slot, lab[0], lab[1], hh, std::make_integer_sequence<int, 25>{});
        float win[16];
        topk16_joint<25>(slot, win);
        float ex[16], esum = 0.f;
#pragma unroll
        for (int r = 0; r < 16; ++r) { ex[r] = __expf(win[r] - win[0]); esum += ex[r]; }
        const float inv = 1.0f / esum;
        int eid[8]; float gt[8];
#pragma unroll
        for (int r = 0; r < 8; ++r) {
            const unsigned wb = __float_as_uint(hh ? win[r + 8] : win[r]);
            const int ci = (wb >> 4) & 15, cj = wb & 15;
            unsigned ia = 0, ib = 0;
#pragma unroll
            for (int i = 0; i < 16; ++i) { ia = (ci == i) ? (__float_as_uint(lab[0][i]) & 127u) : ia; ib = (cj == i) ? (__float_as_uint(lab[1][i]) & 127u) : ib; }
            eid[r] = (int)(ia * 128u + ib);
            gt[r] = (hh ? ex[r + 8] : ex[r]) * inv;
        }
        const size_t o = (size_t)(t0 + tok) * 128 + h * 16 + hh * 8;
        *(GAS v4u*)(EXP + o) = (v4u){(unsigned)eid[0], (unsigned)eid[1], (unsigned)eid[2], (unsigned)eid[3]};
        *(GAS v4u*)(EXP + o + 4) = (v4u){(unsigned)eid[4], (unsigned)eid[5], (unsigned)eid[6], (unsigned)eid[7]};
        *(GAS f32x4*)(GATE + o) = (f32x4){gt[0], gt[1], gt[2], gt[3]};
        *(GAS f32x4*)(GATE + o + 4) = (f32x4){gt[4], gt[5], gt[6], gt[7]};
    }
}

typedef __attribute__((ext_vector_type(2))) __bf16 bf16x2_t;
__device__ __forceinline__ float dot2bf(unsigned a, unsigned b, float acc) { return __builtin_amdgcn_fdot2_f32_bf16(__builtin_bit_cast(bf16x2_t, a), __builtin_bit_cast(bf16x2_t, b), acc, false); }
template <int CTRL> __device__ __forceinline__ float dppf(float x) { return __builtin_bit_cast(float, __builtin_amdgcn_mov_dpp(__builtin_bit_cast(int, x), CTRL, 0xf, 0xf, true)); }
__device__ __forceinline__ float wave_sum_dpp(float x) {
    x += dppf<0xB1>(x); x += dppf<0x4E>(x); x += dppf<0x141>(x); x += dppf<0x128>(x);
    auto s = __builtin_amdgcn_permlane16_swap(__float_as_uint(x), __float_as_uint(x), false, false);
    x = __uint_as_float(s[0]) + __uint_as_float(s[1]);
    auto t = __builtin_amdgcn_permlane32_swap(__float_as_uint(x), __float_as_uint(x), false, false);
    return __uint_as_float(t[0]) + __uint_as_float(t[1]);
}
constexpr int PG_NB = 4;
__device__ __forceinline__ void peer_gather_phase(const Frame& F, const float* H1, const bf16_t* UB, const bf16_t* VB, const int* EXP, const float* GATE,
                                                  const float* g2, const float* b2, float* out) {
    const int lane = F.lane, gw = F.vcu * NWAVES + F.wave, NGW = F.G * NWAVES;
    LAS unsigned* sid = (LAS unsigned*)(F.lds + F.wave * 1024);
    LAS float* sw = (LAS float*)(F.lds + F.wave * 1024 + 512);
    for (int t = gw; t < T; t += NGW) {
        const GAS f32x4* hrow = (const GAS f32x4*)(H1 + (size_t)t * D) + 2 * lane;
        unsigned xp[16];
#pragma unroll
        for (int j = 0; j < 4; ++j) { const f32x4 a = hrow[128 * j], b = hrow[128 * j + 1];
            xp[4 * j] = pk2(a[0], a[1]); xp[4 * j + 1] = pk2(a[2], a[3]); xp[4 * j + 2] = pk2(b[0], b[1]); xp[4 * j + 3] = pk2(b[2], b[3]); }
        const unsigned id0 = ((const GAS unsigned*)EXP)[(size_t)t * 128 + lane], id1 = ((const GAS unsigned*)EXP)[(size_t)t * 128 + 64 + lane];
        const float gt0 = ((const GAS float*)GATE)[(size_t)t * 128 + lane], gt1 = ((const GAS float*)GATE)[(size_t)t * 128 + 64 + lane];
        sid[lane] = id0; sid[64 + lane] = id1;
        for (int kb = 0; kb < 128; kb += PG_NB) {
            v4u w[PG_NB][4];
#pragma unroll
            for (int q = 0; q < PG_NB; ++q) { const unsigned e = __builtin_amdgcn_readfirstlane(sid[kb + q]);
                const GAS v4u* rp = (const GAS v4u*)(UB + (size_t)e * D) + lane;
#pragma unroll
                for (int j = 0; j < 4; ++j) w[q][j] = rp[64 * j]; }
#pragma unroll
            for (int q = 0; q < PG_NB; ++q) { float a0 = 0.f, a1 = 0.f;
#pragma unroll
                for (int j = 0; j < 4; ++j) { a0 = dot2bf(w[q][j].x, xp[4 * j], a0); a1 = dot2bf(w[q][j].y, xp[4 * j + 1], a1); a0 = dot2bf(w[q][j].z, xp[4 * j + 2], a0); a1 = dot2bf(w[q][j].w, xp[4 * j + 3], a1); }
                const float dsum = wave_sum_dpp(a0 + a1);
                if (lane == 0) sw[kb + q] = dsum; }
        }
        {
            const float d0 = sw[lane], d1 = sw[64 + lane];
            const float w0 = gt0 * 0.5f * d0 * (1.0f + erff(d0 * 0.7071067811865476f)), w1 = gt1 * 0.5f * d1 * (1.0f + erff(d1 * 0.7071067811865476f));
            sw[lane] = w0; sw[64 + lane] = w1;
        }
        float acc[32];
#pragma unroll
        for (int i = 0; i < 32; ++i) acc[i] = 0.f;
        for (int kb = 0; kb < 128; kb += PG_NB) {
            v4u w[PG_NB][4]; float wk[PG_NB];
#pragma unroll
            for (int q = 0; q < PG_NB; ++q) { const unsigned e = __builtin_amdgcn_readfirstlane(sid[kb + q]);
                wk[q] = __builtin_bit_cast(float, __builtin_amdgcn_readfirstlane(__builtin_bit_cast(unsigned, sw[kb + q])));
                const GAS v4u* rp = (const GAS v4u*)(VB + (size_t)e * D) + lane;
#pragma unroll
                for (int j = 0; j < 4; ++j) w[q][j] = rp[64 * j]; }
#pragma unroll
            for (int q = 0; q < PG_NB; ++q)
#pragma unroll
                for (int j = 0; j < 4; ++j) {
                    acc[8 * j + 0] = fmaf(wk[q], bflo(w[q][j].x), acc[8 * j + 0]); acc[8 * j + 1] = fmaf(wk[q], bfhi(w[q][j].x), acc[8 * j + 1]);
                    acc[8 * j + 2] = fmaf(wk[q], bflo(w[q][j].y), acc[8 * j + 2]); acc[8 * j + 3] = fmaf(wk[q], bfhi(w[q][j].y), acc[8 * j + 3]);
                    acc[8 * j + 4] = fmaf(wk[q], bflo(w[q][j].z), acc[8 * j + 4]); acc[8 * j + 5] = fmaf(wk[q], bfhi(w[q][j].z), acc[8 * j + 5]);
                    acc[8 * j + 6] = fmaf(wk[q], bflo(w[q][j].w), acc[8 * j + 6]); acc[8 * j + 7] = fmaf(wk[q], bfhi(w[q][j].w), acc[8 * j + 7]); }
        }
        float s = 0.f;
#pragma unroll
        for (int j = 0; j < 4; ++j) { const f32x4 a = hrow[128 * j], b = hrow[128 * j + 1];
#pragma unroll
            for (int i = 0; i < 4; ++i) { acc[8 * j + i] = fmaf(ALPHA, a[i], acc[8 * j + i]); acc[8 * j + 4 + i] = fmaf(ALPHA, b[i], acc[8 * j + 4 + i]); }
#pragma unroll
            for (int i = 0; i < 8; ++i) s += acc[8 * j + i]; }
        const float mean = wave_sum(s) * (1.f / D); float s2 = 0.f;
#pragma unroll
        for (int i = 0; i < 32; ++i) { acc[i] -= mean; s2 += acc[i] * acc[i]; }
        const float rstd = 1.f / sqrtf(wave_sum(s2) * (1.f / D) + LN_EPS);
        GAS f32x4* orow = (GAS f32x4*)(out + (size_t)t * D) + 2 * lane;
#pragma unroll
        for (int j = 0; j < 4; ++j) { const f32x4 ga = ((const GAS f32x4*)g2)[128 * j + 2 * lane], gb = ((const GAS f32x4*)g2)[128 * j + 2 * lane + 1];
            const f32x4 ba = ((const GAS f32x4*)b2)[128 * j + 2 * lane], bb = ((const GAS f32x4*)b2)[128 * j + 2 * lane + 1];
            f32x4 oa, ob;
#pragma unroll
            for (int i = 0; i < 4; ++i) { oa[i] = acc[8 * j + i] * rstd * ga[i] + ba[i]; ob[i] = acc[8 * j + 4 + i] * rstd * gb[i] + bb[i]; }
            orow[128 * j] = oa; orow[128 * j + 1] = ob; }
    }
}

template <bool WIN>
__device__ __forceinline__ void p0_transpose_item(const float* W, int K, int N, int nblk, bf16_t* WT, LAS float* scr, int item, int lane) {
    const int kb = item / nblk, nb = item % nblk, k0 = 64 * kb, n0 = 32 * nb;
    const int n = n0 + (lane & 31);
    int src = n; float sc = 1.f; bool ok = true;
    if (WIN) {
        ok = n < NPROJ;
        src = (n < 3072) ? n : (n < 7168 ? n + 16 : n - 7168 + 3072);
        sc = (n < 512) ? 0.08838834764831845f : ((n >= C_RK && n < C_RV) ? 0.0625f : 1.f);
    }
#pragma unroll 8
    for (int i = 0; i < 32; ++i) { const int kk = 2 * i + (lane >> 5); scr[kk * 33 + (lane & 31)] = ok ? W[(size_t)(k0 + kk) * N + src] * sc : 0.f; }
    LDS_WAIT(); asm volatile("" ::: "memory");
    const int c = lane & 7;
#pragma unroll
    for (int j = 0; j < 4; ++j) { const int nn = (lane >> 3) + 8 * j; const LAS float* s = scr + (8 * c) * 33 + nn;
        v4u o; o.x = pk2(s[0 * 33], s[1 * 33]); o.y = pk2(s[2 * 33], s[3 * 33]); o.z = pk2(s[4 * 33], s[5 * 33]); o.w = pk2(s[6 * 33], s[7 * 33]);
        *(GAS v4u*)(WT + (size_t)(n0 + nn) * K + k0 + 8 * c) = o; }
    LDS_WAIT(); asm volatile("" ::: "memory");
}
__device__ __forceinline__ void p0_cvt(const float* src, bf16_t* dst, size_t n8, size_t gtid, size_t gthreads) {
    for (size_t i = gtid; i < n8; i += gthreads) {
        const f32x4 a = ((const GAS f32x4*)src)[2 * i], b = ((const GAS f32x4*)src)[2 * i + 1];
        v4u o; o.x = pk2(a[0], a[1]); o.y = pk2(a[2], a[3]); o.z = pk2(b[0], b[1]); o.w = pk2(b[2], b[3]);
        ((GAS v4u*)dst)[i] = o;
    }
}
__device__ __forceinline__ void p0_prologue(const Frame& F, const Args& a) {
    unsigned char* ws = a.ws;
    LAS float* scr = (LAS float*)(F.lds + F.wave * 16384);
    const int gw = F.vcu * NWAVES + F.wave, NGW = F.G * NWAVES;
    constexpr int I_IN = (D / 64) * (NP / 32), I_SQ = (D / 64) * (D / 32);
    for (int it = gw; it < I_IN + 2 * I_SQ; it += NGW) {
        if (it < I_IN) p0_transpose_item<true>(a.in[1], D, NPROJ, NP / 32, (bf16_t*)(ws + WS_WIN), scr, it, F.lane);
        else if (it < I_IN + I_SQ) p0_transpose_item<false>(a.in[6], D, D, D / 32, (bf16_t*)(ws + WS_WOUT), scr, it - I_IN, F.lane);
        else p0_transpose_item<false>(a.in[9], D, D, D / 32, (bf16_t*)(ws + WS_WQ), scr, it - I_IN - I_SQ, F.lane);
    }
    const size_t gtid = (size_t)F.vcu * (NWAVES * 64) + F.tid, gthreads = (size_t)F.G * (NWAVES * 64);
    p0_cvt(a.in[0], (bf16_t*)(ws + WS_XB), (size_t)T * D / 8, gtid, gthreads);
    p0_cvt(a.in[11], (bf16_t*)(ws + WS_UB), (size_t)16384 * D / 8, gtid, gthreads);
    p0_cvt(a.in[12], (bf16_t*)(ws + WS_VB), (size_t)16384 * D / 8, gtid, gthreads);
    p0_cvt(a.in[10], (bf16_t*)(ws + WS_SKB), (size_t)8 * 2 * 128 * 128 / 8, gtid, gthreads);
    float* rope = (float*)(ws + WS_ROPE);
    for (size_t idx = gtid; idx < (size_t)SEQ * 128; idx += gthreads) {
        const int pos = (int)(idx >> 7), i = (int)(idx & 127);
        const float inv = powf(10000.0f, -(float)i / 128.0f);
        const float ang = (float)pos * inv;
        const float n = rintf(ang * 0.15915494309189535f);
        float r = fmaf(-n, 6.28125f, ang); r = fmaf(-n, 0.0019353071795864769f, r);
        rope[2 * idx] = cosf(r); rope[2 * idx + 1] = sinf(r);
    }
}
__device__ __forceinline__ void ln_rows_phase(const Frame& F, float* Y, const float* g, const float* bta, bf16_t* Hb) {
    const int gw = F.vcu * NWAVES + F.wave, NGW = F.G * NWAVES;
    for (int row = gw; row < T; row += NGW) {
        GAS f32x4* yr = (GAS f32x4*)(Y + (size_t)row * D) + F.lane;
        f32x4 v[8]; float s = 0.f;
#pragma unroll
        for (int j = 0; j < 8; ++j) { v[j] = yr[64 * j]; s += (v[j][0] + v[j][1]) + (v[j][2] + v[j][3]); }
        const float mean = wave_sum(s) * (1.f / D); float s2 = 0.f;
#pragma unroll
        for (int j = 0; j < 8; ++j) { v[j] = v[j] - mean; s2 += (v[j][0] * v[j][0] + v[j][1] * v[j][1]) + (v[j][2] * v[j][2] + v[j][3] * v[j][3]); }
        const float rstd = 1.f / sqrtf(wave_sum(s2) * (1.f / D) + LN_EPS);
        GAS v2u* o8 = (GAS v2u*)(Hb + (size_t)row * D) + F.lane;
#pragma unroll
        for (int j = 0; j < 8; ++j) { const f32x4 gg = ((const GAS f32x4*)g)[64 * j + F.lane], bb = ((const GAS f32x4*)bta)[64 * j + F.lane];
            const f32x4 o = v[j] * rstd * gg + bb; yr[64 * j] = o; v2u w; w.x = pk2(o[0], o[1]); w.y = pk2(o[2], o[3]); o8[64 * j] = w; }
    }
}

constexpr int N_PHASES = 10;
__global__ void __launch_bounds__(NWAVES * 64, 2) mega_fwd(Args args) {
    extern __shared__ __attribute__((aligned(16))) unsigned char lds[];
    Frame F;
    F.lds = (LAS unsigned char*)lds;
    volatile LAS unsigned* MISC = (volatile LAS unsigned*)(F.lds + MISC_OFF);
    F.tid = threadIdx.x; F.lane = F.tid & 63; F.wave = __builtin_amdgcn_readfirstlane(F.tid >> 6);
    F.G = gridDim.x; { const int bx = blockIdx.x; F.vcu = (F.G % 8 == 0) ? (bx % 8) * (F.G / 8) + bx / 8 : bx; }
    unsigned char* ws = args.ws;
    gu32* ctl = (gu32*)(ws + WS_CTL);
    for (int u = F.tid; u < (LDS_BYTES - LDSCTL_OFF) / 4; u += NWAVES * 64) ((LAS unsigned*)(F.lds + LDSCTL_OFF))[u] = 0u;
    __syncthreads();
    const int lo = args.ph_lo, hi = args.ph_hi;
    XcdBarrier bar; bar.bar = (unsigned*)(ctl + CW_BAR) + args.li * XCD_BAR_WORDS; bar.x = 0; bar.st = nullptr;
    if (hi - lo > 1) bar = xcd_barrier_post((unsigned*)(ctl + CW_BAR) + args.li * XCD_BAR_WORDS, MISC + 8);
#define IN(k) (lo <= (k) && (k) < hi)
#define BOTH(k) (IN(k) && IN((k) + 1))
#define SEAM(k) do { if (BOTH(k)) xcd_barrier(bar); } while (0)
    bf16_t* WIN = (bf16_t*)(ws + WS_WIN); bf16_t* WOUT = (bf16_t*)(ws + WS_WOUT); bf16_t* WQ = (bf16_t*)(ws + WS_WQ);
    bf16_t* XB = (bf16_t*)(ws + WS_XB); bf16_t* PROJ = (bf16_t*)(ws + WS_PROJ); bf16_t* OB = (bf16_t*)(ws + WS_O);
    float* Y = (float*)(ws + WS_Y); bf16_t* H1B = (bf16_t*)(ws + WS_H1B); bf16_t* QB = (bf16_t*)(ws + WS_Q);
    const float* ROPE = (const float*)(ws + WS_ROPE);

    if (IN(0)) { p0_prologue(F, args); SEAM(0); }
    if (IN(1)) {
        pg8::Gemm g{XB, WIN, T, NP, D}; pg8::StaticOrder S; S.init(T, NP, F.G, (int)blockIdx.x);
        pg8::EpiBf16 E{PROJ, NP, ROPE, 12, 20};
        pg8::gemm_phase<pg8::EpiBf16, pg8::StaticOrder, true, true>(F.lds, g, S, E);
        SEAM(1);
    }
    if (IN(2)) { chunk_u_phase(F, PROJ, args.in[2], args.in[3], (float*)(ws + WS_BC), (bf16_t*)(ws + WS_UT)); SEAM(2); }
    if (IN(3)) { scan_phase(F, (bf16_t*)(ws + WS_UT), (const float*)(ws + WS_BC)); SEAM(3); }
    if (IN(4)) { chunk_o_phase(F, PROJ, (const float*)(ws + WS_BC), (const bf16_t*)(ws + WS_UT), args.in[4], args.in[5], OB); SEAM(4); }
    if (IN(5)) {
        pg8::Gemm g{OB, WOUT, T, D, D}; pg8::StaticOrder S; S.init(T, D, F.G, (int)blockIdx.x);
        pg8::EpiResF32 E{Y, args.in[0], D, ALPHA};
        pg8::gemm_phase<pg8::EpiResF32, pg8::StaticOrder, true, true>(F.lds, g, S, E);
        SEAM(5);
    }
    if (IN(6)) { ln_rows_phase(F, Y, args.in[7], args.in[8], H1B); SEAM(6); }
    if (IN(7)) {
        pg8::Gemm g{H1B, WQ, T, D, D}; pg8::StaticOrder S; S.init(T, D, F.G, (int)blockIdx.x);
        pg8::EpiBf16 E{QB, D, nullptr, 0, 0};
        pg8::gemm_phase<pg8::EpiBf16, pg8::StaticOrder, true, true>(F.lds, g, S, E);
        SEAM(7);
    }
    if (IN(8)) { peer_topk_phase(F, QB, (const bf16_t*)(ws + WS_SKB), (int*)(ws + WS_EXP), (float*)(ws + WS_GATE)); SEAM(8); }
    if (IN(9)) peer_gather_phase(F, Y, (const bf16_t*)(ws + WS_UB), (const bf16_t*)(ws + WS_VB), (const int*)(ws + WS_EXP), (const float*)(ws + WS_GATE), args.in[13], args.in[14], args.out);
#undef IN
#undef BOTH
#undef SEAM
}

__global__ void __launch_bounds__(256) k_chunk_u(const bf16_t* __restrict__ proj, const float* __restrict__ wg, const float* __restrict__ bg,
                                                float* __restrict__ bc, bf16_t* __restrict__ ut) {
    __shared__ float sb[64][128];
    __shared__ bf16_t kt[64][256];
    const int unit = blockIdx.x, head = unit & 7, bchunk = unit >> 3, b = bchunk / NCH, ch = bchunk % NCH;
    const int t0 = b * SEQ + ch * CH, tid = threadIdx.x;
    if (head < 4) {
        const int h = head;
        for (int idx = tid; idx < 64 * 128; idx += 256) {
            const int c = idx >> 7, d = idx & 127;
            float z = bg[h * 128 + d];
            for (int r = 0; r < 16; ++r) z = fmaf(bf2f(proj[(size_t)(t0 + c) * NP + C_GLR + r]), wg[r * 512 + h * 128 + d], z);
            const float ls = fminf(z, 0.f) - log1pf(expf(-fabsf(z)));
            sb[c][d] = ls * (1.0f / 16.0f);
        }
        __syncthreads();
        if (tid < 128) { float s = 0.f; for (int c = 0; c < 64; ++c) { s += sb[c][tid]; sb[c][tid] = s; bc[(size_t)(t0 + c) * 512 + h * 128 + tid] = s; } }
        __syncthreads();
        for (int idx = tid; idx < 64 * 128; idx += 256) { const int c = idx >> 7, d = idx & 127;
            kt[c][d] = f2bf(bf2f(proj[(size_t)(t0 + c) * NP + C_GK + h * 128 + d]) * expf(sb[63][d] - sb[c][d])); }
        __syncthreads();
        bf16_t* o = ut + ((size_t)(b * 4 + h) * NCH + ch) * 256 * 128;
        for (int idx = tid; idx < 256 * 128; idx += 256) { const int e = idx >> 7, d = idx & 127; float s = 0.f;
            for (int c = 0; c < 64; ++c) s = fmaf(bf2f(proj[(size_t)(t0 + c) * NP + C_GV + h * 256 + e]), bf2f(kt[c][d]), s);
            o[idx] = f2bf(s); }
    } else {
        const int h = head - 4; const float lg = gamma_log(h);
        for (int idx = tid; idx < 64 * 256; idx += 256) { const int c = idx >> 8, d = idx & 255;
            kt[c][d] = f2bf(bf2f(proj[(size_t)(t0 + c) * NP + C_RK + h * 256 + d]) * expf(lg * (float)(63 - c))); }
        __syncthreads();
        bf16_t* o = ut + UT_RET_OFF + ((size_t)(b * 4 + h) * NCH + ch) * 256 * 256;
        for (int idx = tid; idx < 256 * 256; idx += 256) { const int e = idx >> 8, d = idx & 255; float s = 0.f;
            for (int c = 0; c < 64; ++c) s = fmaf(bf2f(proj[(size_t)(t0 + c) * NP + C_RV + h * 256 + e]), bf2f(kt[c][d]), s);
            o[idx] = f2bf(s); }
    }
}
__global__ void k_scan(bf16_t* __restrict__ ut, const float* __restrict__ bc) {
    const size_t idx = (size_t)blockIdx.x * blockDim.x + threadIdx.x;
    const size_t NG = (size_t)16 * 256 * 128, NR = (size_t)16 * 256 * 256;
    if (idx < NG) {
        const int bh = (int)(idx >> 15), d = (int)(idx & 127), b = bh >> 2, h = bh & 3;
        bf16_t* p = ut + (size_t)bh * NCH * 32768 + (idx & 32767);
        float s = 0.f;
        for (int i = 0; i < NCH; ++i) { const float u = bf2f(p[(size_t)i * 32768]); p[(size_t)i * 32768] = f2bf(s);
            const float dec = expf(bc[(size_t)(b * SEQ + i * CH + 63) * 512 + h * 128 + d]); s = fmaf(dec, s, u); }
    } else if (idx < NG + NR) {
        const size_t j = idx - NG; const int bh = (int)(j >> 16), h = bh & 3;
        bf16_t* p = ut + UT_RET_OFF + (size_t)bh * NCH * 65536 + (j & 65535);
        const float dec = expf(gamma_log(h) * 64.0f); float s = 0.f;
        for (int i = 0; i < NCH; ++i) { const float u = bf2f(p[(size_t)i * 65536]); p[(size_t)i * 65536] = f2bf(s); s = fmaf(dec, s, u); }
    }
}
__device__ __forceinline__ float block_sum256(float v, float* red) {
    v = wave_sum(v);
    __syncthreads();
    if ((threadIdx.x & 63) == 0) red[threadIdx.x >> 6] = v;
    __syncthreads();
    return red[0] + red[1] + red[2] + red[3];
}
__global__ void __launch_bounds__(256) k_chunk_o(const bf16_t* __restrict__ proj, const float* __restrict__ bc, const bf16_t* __restrict__ st,
                                                const float* __restrict__ gla_g, const float* __restrict__ ret_g, bf16_t* __restrict__ O) {
    __shared__ float sb[64][128];
    __shared__ float sa[64][65];
    __shared__ float red[4];
    const int unit = blockIdx.x, head = unit & 7, bchunk = unit >> 3, b = bchunk / NCH, ch = bchunk % NCH;
    const int t0 = b * SEQ + ch * CH, tid = threadIdx.x;
    if (head < 4) {
        const int h = head;
        for (int idx = tid; idx < 64 * 128; idx += 256) { const int c = idx >> 7, d = idx & 127; sb[c][d] = bc[(size_t)(t0 + c) * 512 + h * 128 + d]; }
        __syncthreads();
        for (int idx = tid; idx < 64 * 64; idx += 256) { const int n = idx >> 6, m = idx & 63; float s = 0.f;
            const bf16_t* qp = proj + (size_t)(t0 + n) * NP + C_GQ + h * 128; const bf16_t* kp = proj + (size_t)(t0 + m) * NP + C_GK + h * 128;
            for (int d = 0; d < 128; ++d) s = fmaf(bf2f(qp[d]) * bf2f(kp[d]), expf(-fabsf(sb[n][d] - sb[m][d])), s);
            sa[n][m] = s; }
        __syncthreads();
        const int e = tid; const bf16_t* sp = st + ((size_t)(b * 4 + h) * NCH + ch) * 256 * 128 + (size_t)e * 128;
        const float g = gla_g[h * 256 + e];
        for (int n = 0; n < 64; ++n) {
            float o = 0.f;
            for (int m = 0; m < 64; ++m) o = fmaf(sa[n][m], bf2f(proj[(size_t)(t0 + m) * NP + C_GV + h * 256 + e]), o);
            const bf16_t* qp = proj + (size_t)(t0 + n) * NP + C_GQ + h * 128;
            for (int d = 0; d < 128; ++d) o = fmaf(bf2f(qp[d]) * expf(sb[n][d]), bf2f(sp[d]), o);
            const float ss = block_sum256(o * o, red);
            const float y = o * rsqrtf(ss * (1.0f / 256.0f) + LN_EPS) * g;
            const float gt = bf2f(proj[(size_t)(t0 + n) * NP + C_GR + h * 256 + e]);
            O[(size_t)(t0 + n) * D + h * 256 + e] = f2bf(y * gt / (1.0f + expf(-gt)));
        }
    } else {
        const int h = head - 4; const float lg = gamma_log(h);
        for (int idx = tid; idx < 64 * 64; idx += 256) { const int n = idx >> 6, m = idx & 63; float s = 0.f;
            const bf16_t* qp = proj + (size_t)(t0 + n) * NP + C_RQ + h * 256; const bf16_t* kp = proj + (size_t)(t0 + m) * NP + C_RK + h * 256;
            for (int d = 0; d < 256; ++d) s = fmaf(bf2f(qp[d]), bf2f(kp[d]), s);
            sa[n][m] = s * expf(lg * fabsf((float)(n - m))); }
        __syncthreads();
        const int e = tid; const bf16_t* sp = st + UT_RET_OFF + ((size_t)(b * 4 + h) * NCH + ch) * 256 * 256 + (size_t)e * 256;
        const float g = ret_g[h * 256 + e];
        for (int n = 0; n < 64; ++n) {
            float o = 0.f, oi = 0.f;
            for (int m = 0; m < 64; ++m) o = fmaf(sa[n][m], bf2f(proj[(size_t)(t0 + m) * NP + C_RV + h * 256 + e]), o);
            const bf16_t* qp = proj + (size_t)(t0 + n) * NP + C_RQ + h * 256;
            for (int d = 0; d < 256; ++d) oi = fmaf(bf2f(qp[d]), bf2f(sp[d]), oi);
            o += oi * expf(lg * (float)(n + 1));
            const float mu = block_sum256(o, red) * (1.0f / 256.0f);
            const float oc = o - mu;
            const float ss = block_sum256(oc * oc, red);
            const float y = oc * rsqrtf(ss * (1.0f / 256.0f) + LN_EPS) * g;
            const float gt = bf2f(proj[(size_t)(t0 + n) * NP + C_RR + h * 256 + e]);
            O[(size_t)(t0 + n) * D + 1024 + h * 256 + e] = f2bf(y * gt / (1.0f + expf(-gt)));
        }
    }
}
__global__ void __launch_bounds__(32) k_peer_topk(const bf16_t* __restrict__ Q, const bf16_t* __restrict__ skb, int* __restrict__ ex, float* __restrict__ gate) {
    __shared__ float sc[32][129];
    __shared__ float tv[32][2][16];
    __shared__ int ti[32][2][16];
    __shared__ float cand[32][257];
    const int lt = threadIdx.x, gidx = blockIdx.x * 32 + lt, t = gidx >> 3, h = gidx & 7;
    for (int p = 0; p < 2; ++p) {
        const bf16_t* q = Q + (size_t)t * D + h * 256 + p * 128;
        const bf16_t* sk = skb + (size_t)(h * 2 + p) * 128 * 128;
        for (int k = 0; k < 128; ++k) { float s = 0.f; for (int d = 0; d < 128; ++d) s = fmaf(bf2f(q[d]), bf2f(sk[k * 128 + d]), s); sc[lt][k] = s; }
        for (int r = 0; r < 16; ++r) { float best = -INFINITY; int bi = 0;
            for (int k = 0; k < 128; ++k) { const float v = sc[lt][k]; if (v > best) { best = v; bi = k; } }
            tv[lt][p][r] = best; ti[lt][p][r] = bi; sc[lt][bi] = -INFINITY; }
    }
    for (int i = 0; i < 16; ++i) for (int j = 0; j < 16; ++j) cand[lt][i * 16 + j] = tv[lt][0][i] + tv[lt][1][j];
    float mx = 0.f, sum = 0.f;
    for (int r = 0; r < 16; ++r) { float best = -INFINITY; int bi = 0;
        for (int k = 0; k < 256; ++k) { const float v = cand[lt][k]; if (v > best) { best = v; bi = k; } }
        cand[lt][bi] = -INFINITY;
        if (r == 0) mx = best;
        const float e = expf(best - mx); sum += e;
        ex[(size_t)t * 128 + h * 16 + r] = ti[lt][0][bi >> 4] * 128 + ti[lt][1][bi & 15];
        gate[(size_t)t * 128 + h * 16 + r] = e; }
    const float inv = 1.0f / sum;
    for (int r = 0; r < 16; ++r) gate[(size_t)t * 128 + h * 16 + r] *= inv;
}
__global__ void __launch_bounds__(256) k_peer_gather(const float* __restrict__ H1, const bf16_t* __restrict__ ub, const bf16_t* __restrict__ vb,
                                                    const int* __restrict__ ex, const float* __restrict__ gate,
                                                    const float* __restrict__ g2, const float* __restrict__ b2, float* __restrict__ out) {
    const int t = blockIdx.x * 4 + (threadIdx.x >> 6), lane = threadIdx.x & 63;
    const float* hrow = H1 + (size_t)t * D;
    float x[32], acc[32];
#pragma unroll
    for (int j = 0; j < 32; ++j) { x[j] = hrow[j * 64 + lane]; acc[j] = 0.f; }
    for (int k = 0; k < 128; ++k) {
        const int e = ex[(size_t)t * 128 + k]; const float gt = gate[(size_t)t * 128 + k];
        const bf16_t* ur = ub + (size_t)e * D; const bf16_t* vr = vb + (size_t)e * D;
        float s = 0.f;
#pragma unroll
        for (int j = 0; j < 32; ++j) s = fmaf(bf2f(ur[j * 64 + lane]), x[j], s);
        s = wave_sum(s);
        const float w = gt * 0.5f * s * (1.0f + erff(s * 0.7071067811865476f));
#pragma unroll
        for (int j = 0; j < 32; ++j) acc[j] = fmaf(w, bf2f(vr[j * 64 + lane]), acc[j]);
    }
    float s = 0.f;
#pragma unroll
    for (int j = 0; j < 32; ++j) { acc[j] = ALPHA * x[j] + acc[j]; s += acc[j]; }
    const float mu = wave_sum(s) * (1.0f / D); float q = 0.f;
#pragma unroll
    for (int j = 0; j < 32; ++j) { acc[j] -= mu; q += acc[j] * acc[j]; }
    const float rstd = rsqrtf(wave_sum(q) * (1.0f / D) + LN_EPS);
#pragma unroll
    for (int j = 0; j < 32; ++j) { const int c = j * 64 + lane; out[(size_t)t * D + c] = acc[j] * rstd * g2[c] + b2[c]; }
}

extern "C" void kernel_launch(void* const* d_in, const int* in_sizes, int n_in, void* d_out, int out_size, void* d_ws, size_t ws_size, hipStream_t stream) {
    static int grid = 0;
    if (grid == 0) {
        if (n_in != 15 || in_sizes[0] != T * D || out_size != T * D || ws_size < WS_END) { fprintf(stderr, "kernel_launch: unexpected shapes / workspace (n_in %d, ws %zu)\n", n_in, ws_size); grid = -1; return; }
        int dev = 0, cus = 0, per_cu = 0;
        if (hipGetDevice(&dev) != hipSuccess || hipDeviceGetAttribute(&cus, hipDeviceAttributeMultiprocessorCount, dev) != hipSuccess) { grid = -1; return; }
        if (hipFuncSetAttribute((const void*)mega_fwd, hipFuncAttributeMaxDynamicSharedMemorySize, LDS_BYTES) != hipSuccess) { fprintf(stderr, "kernel_launch: hipFuncSetAttribute failed\n"); grid = -1; return; }
        if (hipOccupancyMaxActiveBlocksPerMultiprocessor(&per_cu, (const void*)mega_fwd, NWAVES * 64, LDS_BYTES) != hipSuccess || per_cu < 1)
            fprintf(stderr, "kernel_launch: occupancy query reports %d workgroups per CU\n", per_cu);
        (void)hipGetLastError();
        grid = cus;
    }
    if (grid < 0) return;
    hipMemsetAsync((char*)d_ws + WS_CTL, 0, CTL_ZERO_BYTES, stream);
    Args a{};
    for (int i = 0; i < 15; ++i) a.in[i] = (const float*)d_in[i];
    a.out = (float*)d_out; a.ws = (unsigned char*)d_ws;
    unsigned char* ws = (unsigned char*)d_ws;
    const float* wg = (const float*)d_in[2]; const float* bg = (const float*)d_in[3]; const float* gla_g = (const float*)d_in[4]; const float* ret_g = (const float*)d_in[5];
    const float* ln2_g = (const float*)d_in[13]; const float* ln2_b = (const float*)d_in[14];
    bf16_t* SKB = (bf16_t*)(ws + WS_SKB); bf16_t* UB = (bf16_t*)(ws + WS_UB); bf16_t* VB = (bf16_t*)(ws + WS_VB);
    bf16_t* PROJ = (bf16_t*)(ws + WS_PROJ); float* BC = (float*)(ws + WS_BC); bf16_t* UT = (bf16_t*)(ws + WS_UT); bf16_t* O = (bf16_t*)(ws + WS_O);
    float* Y = (float*)(ws + WS_Y); int* EXP = (int*)(ws + WS_EXP); float* GATE = (float*)(ws + WS_GATE); bf16_t* Q = (bf16_t*)(ws + WS_Q);
    a.ph_lo = 0; a.ph_hi = N_PHASES; a.li = 0;
    hipLaunchKernelGGL(mega_fwd, dim3(grid), dim3(NWAVES * 64), LDS_BYTES, stream, a);
}
```

```cpp
#include <hip/hip_runtime.h>
#include <stdint.h>
#include <math.h>
#include <cstdio>
#include <utility>

namespace pg8 {
#define PG8_LAS __attribute__((address_space(3)))
typedef unsigned short bf16_t;
typedef short bf16x8 __attribute__((ext_vector_type(8)));
typedef float f32x4 __attribute__((ext_vector_type(4)));
typedef unsigned u32x4 __attribute__((ext_vector_type(4)));
constexpr int BM = 256, BK = 64, HALF = 128, HTB = HALF * BK * 2  , STAGE_BYTES = 8 * HTB, NXCD = 8, WGM = 8;

__host__ __device__ __forceinline__ int lds_byte(int r, int c) { const int st = (r >> 4) * 2 + (c >> 5), rr = r & 15, cc = c & 31, ob = rr * 64 + cc * 2; return st * 1024 + (ob ^ (((ob >> 9) & 1) << 5)); }
__host__ __device__ __forceinline__ void stage_rc(int b, int& R, int& C) { const int st = b / 1024, sb = b % 1024, swz = sb ^ (((sb >> 9) & 1) << 5); R = (st >> 1) * 16 + swz / 64; C = (st & 1) * 32 + (swz % 64) / 2; }
__host__ __device__ __forceinline__ int perm32(int rho) { const int n = rho >> 4, i = rho & 15; return 8 * (i >> 2) + 4 * n + (i & 3); }

struct Unit { int pm, pn; };
struct Gemm { const bf16_t* A; const bf16_t* Bt; int M, N, K; };

struct StaticOrder {
    int nM, nN, nwg, G, c;
    __host__ __device__ void init(int M, int N, int G_, int c_) { nM = M / BM; nN = N / BM; nwg = nM * nN; G = G_; c = c_; }
    __host__ __device__ bool next(int i, Unit& u) const {
        const long L = (long)i * G + c; if (L >= nwg) return false;
        int wgid = (int)L; { const int q = nwg / NXCD, r = nwg % NXCD, xcd = wgid % NXCD, off = wgid / NXCD; wgid = (xcd < r ? xcd * (q + 1) : r * (q + 1) + (xcd - r) * q) + off; }
        const int nig = WGM * nN, gid = wgid / nig, fm = gid * WGM, gsz = (nM - fm) < WGM ? (nM - fm) : WGM;
        u.pm = fm + ((wgid % nig) % gsz); u.pn = (wgid % nig) / gsz; return true;
    }
    __device__ __forceinline__ void a_ready(const Unit&) const {}
    __device__ __forceinline__ void done(const Unit&) const {}
};

typedef unsigned u32x4 __attribute__((ext_vector_type(4)));
__device__ __forceinline__ unsigned cvt_pk_bf16(float lo, float hi) { unsigned r; asm volatile("v_cvt_pk_bf16_f32 %0, %1, %2" : "=v"(r) : "v"(lo), "v"(hi)); return r; }
struct EpiBf16 {
    static constexpr bool PERM = true, AFTER_DRAIN = false;
    bf16_t* O; int ldc; const float* rope; int rot_lo, rot_hi;
    __device__ __forceinline__ void operator()(const f32x4 (&acc)[2][2][4][2], const Unit& u, int wr, int wc, int fr, int fq) const {
        const int row0 = u.pm * BM + wr * 64 + fr, colw = wc * 32 + 8 * fq;
        const bool rot = (u.pn >= rot_lo && u.pn < rot_hi);
#pragma unroll
        for (int ai = 0; ai < 2; ++ai)
#pragma unroll
            for (int m = 0; m < 4; ++m) {
                const int row = row0 + ai * HALF + m * 16;
                f32x4 a0 = acc[ai][0][m][0], a1 = acc[ai][0][m][1], b0 = acc[ai][1][m][0], b1 = acc[ai][1][m][1];
                if (rot) {
                    const f32x4* rp = (const f32x4*)(rope + (size_t)((row & 2047) * 128 + colw) * 2);
                    const f32x4 r0 = rp[0], r1 = rp[1], r2 = rp[2], r3 = rp[3];
                    f32x4 x0, x1, y0, y1;
                    x0[0] = a0[0] * r0[0] - b0[0] * r0[1]; y0[0] = a0[0] * r0[1] + b0[0] * r0[0];
                    x0[1] = a0[1] * r0[2] - b0[1] * r0[3]; y0[1] = a0[1] * r0[3] + b0[1] * r0[2];
                    x0[2] = a0[2] * r1[0] - b0[2] * r1[1]; y0[2] = a0[2] * r1[1] + b0[2] * r1[0];
                    x0[3] = a0[3] * r1[2] - b0[3] * r1[3]; y0[3] = a0[3] * r1[3] + b0[3] * r1[2];
                    x1[0] = a1[0] * r2[0] - b1[0] * r2[1]; y1[0] = a1[0] * r2[1] + b1[0] * r2[0];
                    x1[1] = a1[1] * r2[2] - b1[1] * r2[3]; y1[1] = a1[1] * r2[3] + b1[1] * r2[2];
                    x1[2] = a1[2] * r3[0] - b1[2] * r3[1]; y1[2] = a1[2] * r3[1] + b1[2] * r3[0];
                    x1[3] = a1[3] * r3[2] - b1[3] * r3[3]; y1[3] = a1[3] * r3[3] + b1[3] * r3[2];
                    a0 = x0; a1 = x1; b0 = y0; b1 = y1;
                }
                bf16_t* rowp = O + (size_t)row * ldc + u.pn * BM + colw;
                u32x4 w; w.x = cvt_pk_bf16(a0[0], a0[1]); w.y = cvt_pk_bf16(a0[2], a0[3]); w.z = cvt_pk_bf16(a1[0], a1[1]); w.w = cvt_pk_bf16(a1[2], a1[3]);
                *(u32x4*)(rowp) = w;
                w.x = cvt_pk_bf16(b0[0], b0[1]); w.y = cvt_pk_bf16(b0[2], b0[3]); w.z = cvt_pk_bf16(b1[0], b1[1]); w.w = cvt_pk_bf16(b1[2], b1[3]);
                *(u32x4*)(rowp + HALF) = w;
            }
    }
};
struct EpiResF32 {
    static constexpr bool PERM = false, AFTER_DRAIN = false;
    float* Y; const float* X; int ldc; float alpha;
    __device__ __forceinline__ void operator()(const f32x4 (&acc)[2][2][4][2], const Unit& u, int wr, int wc, int fr, int fq) const {
        const int row0 = u.pm * BM + wr * 64 + fr, col0 = u.pn * BM + wc * 32 + 4 * fq;
#pragma unroll
        for (int ai = 0; ai < 2; ++ai)
#pragma unroll
            for (int m = 0; m < 4; ++m) { const size_t off = (size_t)(row0 + ai * HALF + m * 16) * ldc + col0;
#pragma unroll
                for (int bj = 0; bj < 2; ++bj)
#pragma unroll
                    for (int n = 0; n < 2; ++n) { const size_t o2 = off + bj * HALF + n * 16; const f32x4 xv = *(const f32x4*)(X + o2); *(f32x4*)(Y + o2) = xv * alpha + acc[ai][bj][m][n]; } }
    }
};
template <class Epi, class Sched, bool ALIGN_EPI = false, bool SP2 = false>
__device__ __forceinline__ void gemm_phase(PG8_LAS unsigned char* lds, const Gemm g, const Sched& S, const Epi& E) {
    const int tid = threadIdx.x, wid = __builtin_amdgcn_readfirstlane(tid >> 6), lane = tid & 63, wr = wid >> 2, wc = wid & 3, fr = lane & 15, fq = lane >> 4;
    const int K = g.K, nt = K / BK;
    unsigned voffA[2], voffB[2];
#pragma unroll
    for (int i = 0; i < 2; ++i) { int R, C; stage_rc(tid * 16 + i * 8192, R, C); const int Rb = Epi::PERM ? ((R & ~31) + perm32(R & 31)) : R;
        voffA[i] = (unsigned)(R * K + C) * 2u; voffB[i] = (unsigned)(Rb * K + C) * 2u; }
    const size_t kstep = (size_t)(BK * 2);
    const size_t hstep = (size_t)HALF * K * 2;
    const size_t tstep = 2 * hstep;
    const unsigned ldsw = (unsigned)wid * 1024u;
    const int aoff = lds_byte(wr * 64 + fr, fq * 8), boff = lds_byte(wc * 32 + fr, fq * 8);
#define PG8_SA(b, h) (((b) * 2 + (h)) * HTB)
#define PG8_SB(b, h) ((4 + (b) * 2 + (h)) * HTB)
#define PG8_STAGE(bufoff, gbase, voff) do { _Pragma("unroll") for (int _i = 0; _i < 2; ++_i) \
        __builtin_amdgcn_global_load_lds((const unsigned*)((const char*)(gbase) + (voff)[_i]), (PG8_LAS unsigned*)(lds + (bufoff) + ldsw + _i * 8192), 16, 0, 0); } while (0)
#define PG8_LDA(dst, b, h) do { _Pragma("unroll") for (int m = 0; m < 4; ++m) _Pragma("unroll") for (int k = 0; k < 2; ++k) dst[m][k] = *(const PG8_LAS bf16x8*)(lds + PG8_SA(b, h) + aoff + m * 2048 + k * 1024); } while (0)
#define PG8_LDB(dst, b, h) do { _Pragma("unroll") for (int n = 0; n < 2; ++n) _Pragma("unroll") for (int k = 0; k < 2; ++k) dst[n][k] = *(const PG8_LAS bf16x8*)(lds + PG8_SB(b, h) + boff + n * 2048 + k * 1024); } while (0)
#define PG8_MMA(ai, bj, At, Bt) do { __builtin_amdgcn_s_setprio(1); _Pragma("unroll") for (int m = 0; m < 4; ++m) _Pragma("unroll") for (int n = 0; n < 2; ++n) _Pragma("unroll") for (int k = 0; k < 2; ++k) \
        acc[ai][bj][m][n] = __builtin_amdgcn_mfma_f32_16x16x32_bf16(Bt[n][k], At[m][k], acc[ai][bj][m][n], 0, 0, 0); __builtin_amdgcn_s_setprio(0); } while (0)
#define PG8_WAIT_V(n) asm volatile("s_waitcnt vmcnt(" #n ")" ::: "memory")
#define PG8_WAIT_L(n) asm volatile("s_waitcnt lgkmcnt(" #n ")" ::: "memory")
#define PG8_BAR __builtin_amdgcn_s_barrier()
#define PG8_SCHED __builtin_amdgcn_sched_barrier(0)
    Unit cur, nxt; int ui = 0;
    if (!S.next(0, cur)) return;
    f32x4 acc[2][2][4][2];
#pragma unroll
    for (int a = 0; a < 2; ++a)
#pragma unroll
        for (int b = 0; b < 2; ++b)
#pragma unroll
            for (int m = 0; m < 4; ++m)
#pragma unroll
                for (int n = 0; n < 2; ++n) acc[a][b][m][n] = (f32x4){0.f, 0.f, 0.f, 0.f};
    bf16x8 At[4][2], B0[2][2], B1[2][2];
    const char* cA = (const char*)g.A + (size_t)cur.pm * tstep; const char* cB = (const char*)g.Bt + (size_t)cur.pn * tstep;
    S.a_ready(cur);
    if constexpr (SP2) {
        PG8_STAGE(PG8_SB(0, 0), cB, voffB); PG8_STAGE(PG8_SB(0, 1), cB + hstep, voffB); PG8_STAGE(PG8_SA(0, 0), cA, voffA); PG8_STAGE(PG8_SA(0, 1), cA + hstep, voffA);
        if (wr == 1) PG8_BAR;
        PG8_WAIT_V(2); PG8_BAR;
        PG8_STAGE(PG8_SB(1, 0), cB + kstep, voffB); PG8_STAGE(PG8_SA(1, 0), cA + kstep, voffA); PG8_STAGE(PG8_SB(1, 1), cB + hstep + kstep, voffB);
        PG8_WAIT_V(6); PG8_BAR;
    } else {
        PG8_STAGE(PG8_SB(0, 0), cB, voffB); PG8_STAGE(PG8_SA(0, 0), cA, voffA); PG8_STAGE(PG8_SB(0, 1), cB + hstep, voffB); PG8_STAGE(PG8_SA(0, 1), cA + hstep, voffA);
        if (wr == 1) PG8_BAR;
        PG8_WAIT_V(4); PG8_BAR;
        PG8_STAGE(PG8_SB(1, 0), cB + kstep, voffB); PG8_STAGE(PG8_SA(1, 0), cA + kstep, voffA); PG8_STAGE(PG8_SB(1, 1), cB + hstep + kstep, voffB);
        PG8_WAIT_V(6); PG8_BAR;
    }
    for (;;) {
        const bool has_next = S.next(ui + 1, nxt);
        const char* nA = has_next ? (const char*)g.A + (size_t)nxt.pm * tstep : cA; const char* nB = has_next ? (const char*)g.Bt + (size_t)nxt.pn * tstep : cB;
        for (int t = 0; t < nt; t += 2) {
            const bool last = (t == nt - 2);
            const char* a1 = cA + (size_t)(t + 1) * kstep;
            const char* a2 = last ? nA : cA + (size_t)(t + 2) * kstep; const char* b2 = last ? nB : cB + (size_t)(t + 2) * kstep;
            const char* a3 = a2 + kstep; const char* b3 = b2 + kstep;
            if (last && has_next) S.a_ready(nxt);
            if constexpr (SP2) {
            PG8_LDB(B0, 0, 0); PG8_LDB(B1, 0, 1); PG8_SCHED; PG8_LDA(At, 0, 0); PG8_STAGE(PG8_SA(1, 1), a1 + hstep, voffA);
            PG8_WAIT_V(8); PG8_WAIT_L(0); PG8_BAR; PG8_MMA(0, 0, At, B0); PG8_MMA(0, 1, At, B1); PG8_BAR; PG8_SCHED;
            PG8_LDA(At, 0, 1); PG8_STAGE(PG8_SB(0, 0), b2, voffB); PG8_STAGE(PG8_SB(0, 1), b2 + hstep, voffB); PG8_STAGE(PG8_SA(0, 0), a2, voffA);
            PG8_WAIT_V(8); PG8_WAIT_L(0); PG8_BAR; PG8_MMA(1, 0, At, B0); PG8_MMA(1, 1, At, B1); PG8_BAR; PG8_SCHED;
            PG8_LDB(B0, 1, 0); PG8_LDB(B1, 1, 1); PG8_SCHED; PG8_LDA(At, 1, 0); PG8_STAGE(PG8_SA(0, 1), a2 + hstep, voffA);
            PG8_WAIT_V(8); PG8_WAIT_L(0); PG8_BAR; PG8_MMA(0, 0, At, B0); PG8_MMA(0, 1, At, B1); PG8_BAR; PG8_SCHED;
            PG8_LDA(At, 1, 1); PG8_STAGE(PG8_SB(1, 0), b3, voffB); PG8_STAGE(PG8_SB(1, 1), b3 + hstep, voffB); PG8_STAGE(PG8_SA(1, 0), a3, voffA);
            PG8_WAIT_V(8); PG8_WAIT_L(0); PG8_BAR; PG8_MMA(1, 0, At, B0); PG8_MMA(1, 1, At, B1); PG8_BAR; PG8_SCHED;
            } else {
            PG8_LDB(B0, 0, 0); PG8_SCHED; PG8_LDA(At, 0, 0); PG8_STAGE(PG8_SA(1, 1), a1 + hstep, voffA);
            PG8_WAIT_L(8); PG8_BAR; PG8_WAIT_L(0); PG8_MMA(0, 0, At, B0); PG8_BAR; PG8_SCHED;
            PG8_LDB(B1, 0, 1); PG8_STAGE(PG8_SB(0, 0), b2, voffB);
            PG8_BAR; PG8_WAIT_L(0); PG8_MMA(0, 1, At, B1); PG8_BAR;
            PG8_LDA(At, 0, 1); PG8_STAGE(PG8_SA(0, 0), a2, voffA);
            PG8_BAR; PG8_WAIT_L(0); PG8_MMA(1, 0, At, B0); PG8_BAR; PG8_SCHED;
            PG8_STAGE(PG8_SB(0, 1), b2 + hstep, voffB);
            PG8_WAIT_V(6); PG8_BAR; PG8_MMA(1, 1, At, B1); PG8_BAR;
            PG8_LDB(B0, 1, 0); PG8_SCHED; PG8_LDA(At, 1, 0); PG8_STAGE(PG8_SA(0, 1), a2 + hstep, voffA);
            PG8_WAIT_L(8); PG8_BAR; PG8_WAIT_L(0); PG8_MMA(0, 0, At, B0); PG8_BAR; PG8_SCHED;
            PG8_LDB(B1, 1, 1); PG8_STAGE(PG8_SB(1, 0), b3, voffB);
            PG8_BAR; PG8_WAIT_L(0); PG8_MMA(0, 1, At, B1); PG8_BAR;
            PG8_LDA(At, 1, 1); PG8_STAGE(PG8_SA(1, 0), a3, voffA);
            PG8_BAR; PG8_WAIT_L(0); PG8_MMA(1, 0, At, B0); PG8_BAR; PG8_SCHED;
            PG8_STAGE(PG8_SB(1, 1), b3 + hstep, voffB);
            PG8_WAIT_V(6); PG8_BAR; PG8_MMA(1, 1, At, B1); PG8_BAR;
            }
        }
        if constexpr (ALIGN_EPI) { if (wr == 0) PG8_BAR; }
        if constexpr (!Epi::AFTER_DRAIN) { E(acc, cur, wr, wc, fr, fq); S.done(cur); }
        if (!has_next) break;
#pragma unroll
        for (int a = 0; a < 2; ++a)
#pragma unroll
            for (int b = 0; b < 2; ++b)
#pragma unroll
                for (int m = 0; m < 4; ++m)
#pragma unroll
                    for (int n = 0; n < 2; ++n) acc[a][b][m][n] = (f32x4){0.f, 0.f, 0.f, 0.f};
        cur = nxt; cA = nA; cB = nB; ++ui;
        if constexpr (ALIGN_EPI) { if (wr == 1) PG8_BAR; }
    }
    PG8_WAIT_V(0);
    if constexpr (!ALIGN_EPI) { if (wr == 0) PG8_BAR; }
    PG8_BAR;
    if constexpr (Epi::AFTER_DRAIN) { E.fused(acc, cur, wr, wc, fr, fq, lds, wid, lane); S.done(cur); }
#undef PG8_SA
#undef PG8_SB
#undef PG8_STAGE
#undef PG8_LDA
#undef PG8_LDB
#undef PG8_MMA
#undef PG8_WAIT_V
#undef PG8_WAIT_L
#undef PG8_BAR
#undef PG8_SCHED
}
}
typedef unsigned short bf16_t;
constexpr int D = 2048, BATCH = 4, SEQ = 2048, T = BATCH * SEQ;
constexpr int NPROJ = 7184, NP = 7424;
constexpr int C_GQ = 0, C_GK = 512, C_GV = 1024, C_GR = 2048, C_RQ = 3072, C_RK = 4096, C_RV = 5120, C_RR = 6144, C_GLR = 7168;
constexpr int NCH = 32, CH = 64;
constexpr float ALPHA = 1.189207115002721f;
constexpr float LN_EPS = 1e-5f;
constexpr size_t MiB = 1u << 20;
constexpr size_t WS_CTL = 0, CTL_ZERO_BYTES = 1 * MiB, WS_WIN = 1 * MiB, WS_WOUT = 31 * MiB, WS_WQ = 39 * MiB, WS_SKB = 47 * MiB, WS_ROPE = 48 * MiB,
                 WS_UB = 50 * MiB, WS_VB = 114 * MiB, WS_XB = 178 * MiB, WS_PROJ = 210 * MiB, WS_BC = 326 * MiB, WS_UT = 342 * MiB,
                 WS_O = 438 * MiB, WS_END = 470 * MiB;
constexpr size_t WS_Y = 210 * MiB, WS_H1B = 274 * MiB, WS_EXP = 306 * MiB, WS_GATE = 310 * MiB;
constexpr size_t WS_Q = 342 * MiB;
constexpr size_t WS_USC = 47 * MiB + 512 * 1024, WS_VSC = WS_USC + 65536;
constexpr size_t UT_RET_OFF = (size_t)16 * 32 * 256 * 128;
constexpr int CW_BAR = 4096;
constexpr int NWAVES = 8;
constexpr int RING_BYTES = 131072, LDSCTL_OFF = RING_BYTES, MISC_OFF = LDSCTL_OFF + 320, LDS_BYTES = 147456;

#define GAS __attribute__((address_space(1)))
#define LAS __attribute__((address_space(3)))
typedef unsigned v4u __attribute__((ext_vector_type(4)));
typedef unsigned v2u __attribute__((ext_vector_type(2)));
typedef float f32x4 __attribute__((ext_vector_type(4)));
typedef float f32x16 __attribute__((ext_vector_type(16)));
typedef short bf16x8 __attribute__((ext_vector_type(8)));
typedef short bf16x4 __attribute__((ext_vector_type(4)));
typedef GAS unsigned gu32;
#define RLX_AGENT __ATOMIC_RELAXED, __HIP_MEMORY_SCOPE_AGENT
#define LDS_WAIT() asm volatile("s_waitcnt lgkmcnt(0)" ::: "memory")
#define VM_WAIT() asm volatile("s_waitcnt vmcnt(0)" ::: "memory")
__device__ __forceinline__ float bf2f(bf16_t v) { return __uint_as_float(((unsigned)v) << 16); }
__device__ __forceinline__ unsigned f2bfu(float f) { unsigned u = __float_as_uint(f); return (u + 0x7fffu + ((u >> 16) & 1u)) >> 16; }
__device__ __forceinline__ bf16_t f2bf(float f) { return (bf16_t)f2bfu(f); }
__device__ __forceinline__ unsigned pk2(float lo, float hi) { return f2bfu(lo) | (f2bfu(hi) << 16); }
__device__ __forceinline__ float bflo(unsigned w) { return __uint_as_float(w << 16); }
__device__ __forceinline__ float bfhi(unsigned w) { return __uint_as_float(w & 0xffff0000u); }
__device__ __forceinline__ float wave_sum(float v) {
#pragma unroll
    for (int o = 1; o < 64; o <<= 1) v += __shfl_xor(v, o);
    return v;
}
__device__ __forceinline__ float gamma_log(int h) { return logf(1.0f - exp2f(-5.0f - (float)h)); }

#define XB_TMO      128
#define XB_XCNT(j)  (256  + 64 * (j))
#define XB_XSUB(j)  (1280 + 64 * (j))
#define XB_XGEN(j)  (2304 + 64 * (j))
#define XB_TOP      3328
#define XB_TOPGEN   3392
#define XCD_BAR_WORDS 3456
#define XB_SPIN_CAP (1u << 18)

__device__ __forceinline__ unsigned xb_ld(unsigned* p)              { return __hip_atomic_load(p, __ATOMIC_RELAXED, __HIP_MEMORY_SCOPE_AGENT); }
__device__ __forceinline__ unsigned xb_add(unsigned* p, unsigned v) { return __hip_atomic_fetch_add(p, v, __ATOMIC_RELAXED, __HIP_MEMORY_SCOPE_AGENT); }
__device__ __forceinline__ unsigned xb_xcc_id() { return (unsigned)__builtin_amdgcn_s_getreg((3 << 11) | 20) & 0xFu; }
#define XB_SPIN(cond, bar) do { unsigned _sp = 0; while (cond) { __builtin_amdgcn_s_sleep(1); \
    if ((++_sp & 255u) == 0u) { if (xb_ld(&(bar)[XB_TMO])) break; if (_sp > XB_SPIN_CAP) { atomicAdd(&(bar)[XB_TMO], 1u); break; } } } } while (0)

struct XcdBarrier {
    unsigned* bar; unsigned x;
    volatile LAS unsigned* st;
};

__device__ __forceinline__ XcdBarrier xcd_barrier_post(unsigned* bar, volatile LAS unsigned* st) {
    XcdBarrier b; b.bar = bar; b.x = xb_xcc_id(); b.st = st;
    if (threadIdx.x == 0) (void)xb_add(&bar[XB_XCNT(b.x)], 1u);
    return b;
}
__device__ __forceinline__ void xcd_barrier_complete(unsigned* bar, unsigned x, unsigned& nloc, unsigned& nx) {
    const unsigned G = gridDim.x * gridDim.y * gridDim.z;
    unsigned sum, cnt, mine, sp = 0u;
    for (;;) {
        sum = 0u; cnt = 0u; mine = 0u;
#pragma unroll
        for (unsigned j = 0; j < 16; ++j) { const unsigned c = xb_ld(&bar[XB_XCNT(j)]); sum += c; cnt += (c > 0u) ? 1u : 0u; mine = (j == x) ? c : mine; }
        if (sum == G) break;
        __builtin_amdgcn_s_sleep(1);
        if ((++sp & 255u) == 0u) { if (xb_ld(&bar[XB_TMO])) break; if (sp > XB_SPIN_CAP) { atomicAdd(&bar[XB_TMO], 1u); break; } }
    }
    nloc = mine > 0u ? mine : 1u; nx = cnt > 0u ? cnt : 1u;
}

__device__ __forceinline__ void xcd_barrier(const XcdBarrier& b) {
    asm volatile("s_waitcnt vmcnt(0)" ::: "memory");
    __syncthreads();
    if (threadIdx.x == 0) {
        unsigned* bar = b.bar;
        __builtin_amdgcn_s_waitcnt(0);
        unsigned nloc = b.st[0], nx = b.st[1];
        if (nloc == 0u) { xcd_barrier_complete(bar, b.x, nloc, nx); b.st[0] = nloc; b.st[1] = nx; }
        const unsigned old = xb_add(&bar[XB_XSUB(b.x)], 1u);
        const unsigned gen = old / nloc;
        if (old + 1u == (gen + 1u) * nloc) {
            __builtin_amdgcn_fence(__ATOMIC_RELEASE, "agent");
            asm volatile("s_waitcnt vmcnt(0)" ::: "memory");
            const unsigned og = xb_add(&bar[XB_TOP], 1u);
            const unsigned tg = og / nx;
            if (og + 1u == (tg + 1u) * nx) xb_add(&bar[XB_TOPGEN], 1u);
            else XB_SPIN(xb_ld(&bar[XB_TOPGEN]) == tg, bar);
            __builtin_amdgcn_fence(__ATOMIC_ACQUIRE, "agent");
            xb_add(&bar[XB_XGEN(b.x)], 1u);
            asm volatile("s_waitcnt vmcnt(0)" ::: "memory");
        } else {
            XB_SPIN(xb_ld(&bar[XB_XGEN(b.x)]) == gen, bar);
            __builtin_amdgcn_fence(__ATOMIC_ACQUIRE, "agent");
            asm volatile("s_waitcnt vmcnt(0)" ::: "memory");
        }
    }
    __syncthreads();
}
struct Frame {
    LAS unsigned char* lds;
    int tid, lane, wave, vcu, G;
};
struct Args { const float* in[15]; float* out; unsigned char* ws; int ph_lo, ph_hi, li, pad; };

__device__ __forceinline__ unsigned lds_addr(const LAS unsigned char* p) { return (unsigned)(unsigned long)p; }
__device__ __forceinline__ unsigned tr_lane_off(int lane, int S) { const int h = lane >> 5, blk = (lane >> 4) & 1, q = (lane & 15) >> 2, p = lane & 3; return (unsigned)((8 * h + q) * S + 32 * blk + 8 * p); }
template <int OFF0, int OFF1> __device__ __forceinline__ bf16x8 tr_frag(unsigned base) {
    bf16x4 lo, hi;
    asm volatile("ds_read_b64_tr_b16 %0, %2 offset:%3\n\tds_read_b64_tr_b16 %1, %2 offset:%4\n\ts_waitcnt lgkmcnt(0)" : "=&v"(lo), "=&v"(hi) : "v"(base), "i"(OFF0), "i"(OFF1) : "memory");
    return __builtin_shufflevector(lo, hi, 0, 1, 2, 3, 4, 5, 6, 7);
}
__device__ __forceinline__ bf16x8 row_frag(const LAS unsigned char* tile, int S, int row0, int s, int lane) {
    return *(const LAS bf16x8*)(tile + (row0 + (lane & 31)) * S + 32 * s + 16 * (lane >> 5));
}
template <int W, int S> __device__ __forceinline__ void stage_tile(LAS unsigned char* dst, const bf16_t* src, int tid) {
    constexpr int PPR = W / 8;
#pragma unroll
    for (int i = 0; i < 64 * PPR / 512; ++i) { const int pi = tid + 512 * i, r = pi / PPR, c = pi % PPR;
        const v4u v = *(const GAS v4u*)(src + (size_t)r * NP + c * 8); *(LAS v4u*)(dst + r * S + c * 16) = v; }
}
__device__ __forceinline__ void unit_head(int item, int& bchunk, int& head) { bchunk = item >> 3; head = ((item & 7) + 4 * ((item >> 8) & 1)) & 7; }
constexpr int SV = 576, SK128 = 320, SQ128 = 272, SQ256 = 528, SP = 144, SO = 1040;

constexpr int P2_V = 0, P2_K = 36864, P2_SB = 73728, P2_GLR = 106496, P2_GTOT = 110592;
__device__ __forceinline__ void chunk_u_phase(const Frame& F, const bf16_t* PROJ, const float* wg, const float* bg, float* BC, bf16_t* UT) {
    const int tid = F.tid, lane = F.lane, w = F.wave;
    LAS unsigned char* L = F.lds;
    for (int item = F.vcu; item < BATCH * NCH * 8; item += F.G) {
        int bchunk, head; unit_head(item, bchunk, head);
        const int b = bchunk / NCH, ch = bchunk % NCH, t0 = b * SEQ + ch * CH;
        const bf16_t* prow = PROJ + (size_t)t0 * NP;
        if (head < 4) {
            const int h = head;
            stage_tile<256, SV>(L + P2_V, prow + C_GV + h * 256, tid);
            for (int i = tid; i < 64 * 16; i += 512) ((LAS float*)(L + P2_GLR))[i] = bf2f(prow[(size_t)(i >> 4) * NP + C_GLR + (i & 15)]);
            const int d = tid & 127, cg = tid >> 7;
            float wc[16];
#pragma unroll
            for (int r = 0; r < 16; ++r) wc[r] = wg[r * 512 + h * 128 + d];
            const float bias = bg[h * 128 + d];
            __syncthreads();
            float run = 0.f;
            LAS float* sb = (LAS float*)(L + P2_SB);
#pragma unroll 4
            for (int cc = 0; cc < 16; ++cc) { const int c = cg * 16 + cc; const LAS f32x4* gp = (const LAS f32x4*)(L + P2_GLR + c * 64);
                float z = bias;
#pragma unroll
                for (int r4 = 0; r4 < 4; ++r4) { const f32x4 gv = gp[r4]; z = fmaf(gv[0], wc[4 * r4], z); z = fmaf(gv[1], wc[4 * r4 + 1], z); z = fmaf(gv[2], wc[4 * r4 + 2], z); z = fmaf(gv[3], wc[4 * r4 + 3], z); }
                const float ls = fminf(z, 0.f) - __logf(1.0f + __expf(-fabsf(z)));
                run += ls * (1.0f / 16.0f); sb[c * 128 + d] = run; }
            ((LAS float*)(L + P2_GTOT))[cg * 128 + d] = run;
            __syncthreads();
            float off = 0.f;
#pragma unroll
            for (int g = 0; g < 3; ++g) off += (g < cg) ? ((LAS float*)(L + P2_GTOT))[g * 128 + d] : 0.f;
#pragma unroll 4
            for (int cc = 0; cc < 16; ++cc) { const int c = cg * 16 + cc; const float v = sb[c * 128 + d] + off; sb[c * 128 + d] = v; BC[(size_t)(t0 + c) * 512 + h * 128 + d] = v; }
            __syncthreads();
#pragma unroll
            for (int i = 0; i < 2; ++i) { const int pi = tid + 512 * i, c = pi >> 4, d0 = (pi & 15) * 8;
                const v4u kv = *(const GAS v4u*)(prow + (size_t)c * NP + C_GK + h * 128 + d0);
                const f32x4 b0 = *(const LAS f32x4*)(sb + c * 128 + d0), b1 = *(const LAS f32x4*)(sb + c * 128 + d0 + 4);
                const f32x4 l0 = *(const LAS f32x4*)(sb + 63 * 128 + d0), l1 = *(const LAS f32x4*)(sb + 63 * 128 + d0 + 4);
                v4u o;
                o.x = pk2(bflo(kv.x) * __expf(l0[0] - b0[0]), bfhi(kv.x) * __expf(l0[1] - b0[1])); o.y = pk2(bflo(kv.y) * __expf(l0[2] - b0[2]), bfhi(kv.y) * __expf(l0[3] - b0[3]));
                o.z = pk2(bflo(kv.z) * __expf(l1[0] - b1[0]), bfhi(kv.z) * __expf(l1[1] - b1[1])); o.w = pk2(bflo(kv.w) * __expf(l1[2] - b1[2]), bfhi(kv.w) * __expf(l1[3] - b1[3]));
                *(LAS v4u*)(L + P2_K + c * SK128 + d0 * 2) = o; }
            __syncthreads();
            f32x16 acc[4];
#pragma unroll
            for (int i = 0; i < 4; ++i)
#pragma unroll
                for (int r = 0; r < 16; ++r) acc[i][r] = 0.f;
            const unsigned vb = lds_addr(L + P2_V) + tr_lane_off(lane, SV) + 64 * w, kb = lds_addr(L + P2_K) + tr_lane_off(lane, SK128);
#define P2G_STEP(ks) { const bf16x8 a = tr_frag<16 * (ks) * SV, 16 * (ks) * SV + 4 * SV>(vb); \
                acc[0] = __builtin_amdgcn_mfma_f32_32x32x16_bf16(a, tr_frag<16 * (ks) * SK128 + 0, 16 * (ks) * SK128 + 0 + 4 * SK128>(kb), acc[0], 0, 0, 0); \
                acc[1] = __builtin_amdgcn_mfma_f32_32x32x16_bf16(a, tr_frag<16 * (ks) * SK128 + 64, 16 * (ks) * SK128 + 64 + 4 * SK128>(kb), acc[1], 0, 0, 0); \
                acc[2] = __builtin_amdgcn_mfma_f32_32x32x16_bf16(a, tr_frag<16 * (ks) * SK128 + 128, 16 * (ks) * SK128 + 128 + 4 * SK128>(kb), acc[2], 0, 0, 0); \
                acc[3] = __builtin_amdgcn_mfma_f32_32x32x16_bf16(a, tr_frag<16 * (ks) * SK128 + 192, 16 * (ks) * SK128 + 192 + 4 * SK128>(kb), acc[3], 0, 0, 0); }
            P2G_STEP(0) P2G_STEP(1) P2G_STEP(2) P2G_STEP(3)
#undef P2G_STEP
            bf16_t* o = UT + ((size_t)(b * 4 + h) * NCH + ch) * 256 * 128;
#pragma unroll
            for (int rg = 0; rg < 4; ++rg) { bf16_t* pr = o + (size_t)(32 * w + 8 * rg + 4 * (lane >> 5)) * 128 + (lane & 31);
#pragma unroll
                for (int r3 = 0; r3 < 4; ++r3)
#pragma unroll
                    for (int i = 0; i < 4; ++i) pr[r3 * 128 + 32 * i] = (bf16_t)pg8::cvt_pk_bf16(acc[i][rg * 4 + r3], 0.f);
                asm volatile("" ::: "memory"); }
        } else {
            const int h = head - 4; const float lg2 = gamma_log(h) * 1.4426950408889634f;
            stage_tile<256, SV>(L + P2_V, prow + C_RV + h * 256, tid);
#pragma unroll
            for (int i = 0; i < 4; ++i) { const int pi = tid + 512 * i, c = pi >> 5, d0 = (pi & 31) * 8;
                const v4u kv = *(const GAS v4u*)(prow + (size_t)c * NP + C_RK + h * 256 + d0);
                const float sc = exp2f(lg2 * (float)(63 - c));
                v4u o; o.x = pk2(bflo(kv.x) * sc, bfhi(kv.x) * sc); o.y = pk2(bflo(kv.y) * sc, bfhi(kv.y) * sc); o.z = pk2(bflo(kv.z) * sc, bfhi(kv.z) * sc); o.w = pk2(bflo(kv.w) * sc, bfhi(kv.w) * sc);
                *(LAS v4u*)(L + P2_K + c * SV + d0 * 2) = o; }
            __syncthreads();
            f32x16 acc[8];
#pragma unroll
            for (int i = 0; i < 8; ++i)
#pragma unroll
                for (int r = 0; r < 16; ++r) acc[i][r] = 0.f;
            const unsigned vb = lds_addr(L + P2_V) + tr_lane_off(lane, SV) + 64 * w, kb = lds_addr(L + P2_K) + tr_lane_off(lane, SV);
#define P2R_MM(ks, dt) acc[dt] = __builtin_amdgcn_mfma_f32_32x32x16_bf16(a, tr_frag<16 * (ks) * SV + 64 * (dt), 16 * (ks) * SV + 64 * (dt) + 4 * SV>(kb), acc[dt], 0, 0, 0);
#define P2R_STEP(ks) { const bf16x8 a = tr_frag<16 * (ks) * SV, 16 * (ks) * SV + 4 * SV>(vb); P2R_MM(ks, 0) P2R_MM(ks, 1) P2R_MM(ks, 2) P2R_MM(ks, 3) P2R_MM(ks, 4) P2R_MM(ks, 5) P2R_MM(ks, 6) P2R_MM(ks, 7) }
            P2R_STEP(0) P2R_STEP(1) P2R_STEP(2) P2R_STEP(3)
#undef P2R_STEP
#undef P2R_MM
            bf16_t* o = UT + UT_RET_OFF + ((size_t)(b * 4 + h) * NCH + ch) * 256 * 256;
#pragma unroll
            for (int rg = 0; rg < 4; ++rg) { bf16_t* pr = o + (size_t)(32 * w + 8 * rg + 4 * (lane >> 5)) * 256 + (lane & 31);
#pragma unroll
                for (int r3 = 0; r3 < 4; ++r3)
#pragma unroll
                    for (int i = 0; i < 8; ++i) pr[r3 * 256 + 32 * i] = (bf16_t)pg8::cvt_pk_bf16(acc[i][rg * 4 + r3], 0.f);
                asm volatile("" ::: "memory"); }
        }
        __syncthreads();
    }
}

constexpr int P4_QP = 0, P4_QM = 17408, P4_KP = 34816, P4_KM = 52224, P4_RQ = 0, P4_RK = 33792, P4_V = 69632, P4_P = 106496, P4_O = 0;
__device__ __forceinline__ void chunk_o_phase(const Frame& F, const bf16_t* PROJ, const float* BC, const bf16_t* ST, const float* gla_g, const float* ret_g, bf16_t* O) {
    const int tid = F.tid, lane = F.lane, w = F.wave, hh = lane >> 5;
    LAS unsigned char* L = F.lds;
    for (int item = F.vcu; item < BATCH * NCH * 8; item += F.G) {
        int bchunk, head; unit_head(item, bchunk, head);
        const int b = bchunk / NCH, ch = bchunk % NCH, t0 = b * SEQ + ch * CH;
        const bf16_t* prow = PROJ + (size_t)t0 * NP;
        f32x16 acc[2];
#pragma unroll
        for (int i = 0; i < 2; ++i)
#pragma unroll
            for (int r = 0; r < 16; ++r) acc[i][r] = 0.f;
        const bool gla = head < 4; const int h = head & 3;
        if (gla) {
            stage_tile<256, SV>(L + P4_V, prow + C_GV + h * 256, tid);
#pragma unroll
            for (int i = 0; i < 2; ++i) { const int pi = tid + 512 * i, c = pi >> 4, d0 = (pi & 15) * 8;
                const v4u qv = *(const GAS v4u*)(prow + (size_t)c * NP + C_GQ + h * 128 + d0), kv = *(const GAS v4u*)(prow + (size_t)c * NP + C_GK + h * 128 + d0);
                const GAS f32x4* bp = (const GAS f32x4*)(BC + (size_t)(t0 + c) * 512 + h * 128 + d0); const f32x4 b0 = bp[0], b1 = bp[1];
                float eb[8], em[8];
#pragma unroll
                for (int j = 0; j < 4; ++j) { eb[j] = __expf(b0[j]); eb[4 + j] = __expf(b1[j]); em[j] = __expf(-b0[j]); em[4 + j] = __expf(-b1[j]); }
                const unsigned qa[4] = {qv.x, qv.y, qv.z, qv.w}, ka[4] = {kv.x, kv.y, kv.z, kv.w};
                v4u qp, qm, kp, km;
#pragma unroll
                for (int j = 0; j < 4; ++j) { const float q0 = bflo(qa[j]), q1 = bfhi(qa[j]), k0 = bflo(ka[j]), k1 = bfhi(ka[j]);
                    qp[j] = pk2(q0 * eb[2 * j], q1 * eb[2 * j + 1]); qm[j] = pk2(q0 * em[2 * j], q1 * em[2 * j + 1]);
                    kp[j] = pk2(k0 * eb[2 * j], k1 * eb[2 * j + 1]); km[j] = pk2(k0 * em[2 * j], k1 * em[2 * j + 1]); }
                const int lo = c * SQ128 + d0 * 2;
                *(LAS v4u*)(L + P4_QP + lo) = qp; *(LAS v4u*)(L + P4_QM + lo) = qm; *(LAS v4u*)(L + P4_KP + lo) = kp; *(LAS v4u*)(L + P4_KM + lo) = km; }
            __syncthreads();
            if (w < 4) {
                const int ti = w >> 1, tj = w & 1;
                f32x16 s1, s2;
#pragma unroll
                for (int r = 0; r < 16; ++r) { s1[r] = 0.f; s2[r] = 0.f; }
                if (ti >= tj) {
#pragma unroll
                    for (int s = 0; s < 8; ++s) s1 = __builtin_amdgcn_mfma_f32_32x32x16_bf16(row_frag(L + P4_QP, SQ128, 32 * ti, s, lane), row_frag(L + P4_KM, SQ128, 32 * tj, s, lane), s1, 0, 0, 0);
                }
                if (ti <= tj) {
#pragma unroll
                    for (int s = 0; s < 8; ++s) s2 = __builtin_amdgcn_mfma_f32_32x32x16_bf16(row_frag(L + P4_QM, SQ128, 32 * ti, s, lane), row_frag(L + P4_KP, SQ128, 32 * tj, s, lane), s2, 0, 0, 0);
                }
                const int m = 32 * tj + (lane & 31);
#pragma unroll
                for (int r = 0; r < 16; ++r) { const int n = 32 * ti + (r & 3) + 8 * (r >> 2) + 4 * hh;
                    *(LAS bf16_t*)(L + P4_P + n * SP + m * 2) = f2bf(n >= m ? s1[r] : s2[r]); }
            }
            {
                const bf16_t* sp = ST + ((size_t)(b * 4 + h) * NCH + ch) * 256 * 128 + (size_t)(32 * w + (lane & 31)) * 128 + 8 * hh;
#pragma unroll
                for (int s = 0; s < 8; ++s) { const bf16x8 bs = *(const GAS bf16x8*)(sp + 16 * s);
                    acc[0] = __builtin_amdgcn_mfma_f32_32x32x16_bf16(row_frag(L + P4_QP, SQ128, 0, s, lane), bs, acc[0], 0, 0, 0);
                    acc[1] = __builtin_amdgcn_mfma_f32_32x32x16_bf16(row_frag(L + P4_QP, SQ128, 32, s, lane), bs, acc[1], 0, 0, 0); }
            }
        } else {
            stage_tile<256, SV>(L + P4_V, prow + C_RV + h * 256, tid);
            stage_tile<256, SQ256>(L + P4_RQ, prow + C_RQ + h * 256, tid);
            stage_tile<256, SQ256>(L + P4_RK, prow + C_RK + h * 256, tid);
            __syncthreads();
            const float lg2 = gamma_log(h) * 1.4426950408889634f;
            if (w < 4) {
                const int ti = w >> 1, tj = w & 1;
                f32x16 s1;
#pragma unroll
                for (int r = 0; r < 16; ++r) s1[r] = 0.f;
#pragma unroll
                for (int s = 0; s < 16; ++s) s1 = __builtin_amdgcn_mfma_f32_32x32x16_bf16(row_frag(L + P4_RQ, SQ256, 32 * ti, s, lane), row_frag(L + P4_RK, SQ256, 32 * tj, s, lane), s1, 0, 0, 0);
                const int m = 32 * tj + (lane & 31);
#pragma unroll
                for (int r = 0; r < 16; ++r) { const int n = 32 * ti + (r & 3) + 8 * (r >> 2) + 4 * hh; const int dn = n > m ? n - m : m - n;
                    *(LAS bf16_t*)(L + P4_P + n * SP + m * 2) = f2bf(s1[r] * exp2f(lg2 * (float)dn)); }
            }
            {
                const bf16_t* sp = ST + UT_RET_OFF + ((size_t)(b * 4 + h) * NCH + ch) * 256 * 256 + (size_t)(32 * w + (lane & 31)) * 256 + 8 * hh;
#pragma unroll 4
                for (int s = 0; s < 16; ++s) { const bf16x8 bs = *(const GAS bf16x8*)(sp + 16 * s);
                    acc[0] = __builtin_amdgcn_mfma_f32_32x32x16_bf16(row_frag(L + P4_RQ, SQ256, 0, s, lane), bs, acc[0], 0, 0, 0);
                    acc[1] = __builtin_amdgcn_mfma_f32_32x32x16_bf16(row_frag(L + P4_RQ, SQ256, 32, s, lane), bs, acc[1], 0, 0, 0); }
#pragma unroll
                for (int i = 0; i < 2; ++i)
#pragma unroll
                    for (int r = 0; r < 16; ++r) { const int n = 32 * i + (r & 3) + 8 * (r >> 2) + 4 * hh; acc[i][r] *= exp2f(lg2 * (float)(n + 1)); }
            }
        }
        __syncthreads();
        {
            const unsigned vb = lds_addr(L + P4_V) + tr_lane_off(lane, SV) + 64 * w;
#define P4_STEP(ks) { const bf16x8 bv = tr_frag<16 * (ks) * SV, 16 * (ks) * SV + 4 * SV>(vb); \
                acc[0] = __builtin_amdgcn_mfma_f32_32x32x16_bf16(row_frag(L + P4_P, SP, 0, ks, lane), bv, acc[0], 0, 0, 0); \
                acc[1] = __builtin_amdgcn_mfma_f32_32x32x16_bf16(row_frag(L + P4_P, SP, 32, ks, lane), bv, acc[1], 0, 0, 0); }
            P4_STEP(0) P4_STEP(1) P4_STEP(2) P4_STEP(3)
#undef P4_STEP
        }
        __syncthreads();
#pragma unroll
        for (int i = 0; i < 2; ++i)
#pragma unroll
            for (int r = 0; r < 16; ++r) { const int n = 32 * i + (r & 3) + 8 * (r >> 2) + 4 * hh; *(LAS float*)(L + P4_O + n * SO + (32 * w + (lane & 31)) * 4) = acc[i][r]; }
        __syncthreads();
        {
            const f32x4 gn = *(const GAS f32x4*)((gla ? gla_g : ret_g) + h * 256 + 4 * lane);
            const int gcol = (gla ? C_GR : C_RR) + h * 256 + 4 * lane, ocol = (gla ? 0 : 1024) + h * 256 + 4 * lane;
#pragma unroll 2
            for (int rr = 0; rr < 8; ++rr) { const int n = 8 * w + rr;
                f32x4 v = *(const LAS f32x4*)(L + P4_O + n * SO + lane * 16);
                if (!gla) { const float mu = wave_sum((v[0] + v[1]) + (v[2] + v[3])) * (1.0f / 256.0f); v = v - mu; }
                const float ss = wave_sum((v[0] * v[0] + v[1] * v[1]) + (v[2] * v[2] + v[3] * v[3]));
                const float rs = rsqrtf(ss * (1.0f / 256.0f) + LN_EPS);
                const v2u gw = *(const GAS v2u*)(prow + (size_t)n * NP + gcol);
                const float g0 = bflo(gw.x), g1 = bfhi(gw.x), g2 = bflo(gw.y), g3 = bfhi(gw.y);
                const float o0 = v[0] * rs * gn[0] * g0 / (1.0f + __expf(-g0)), o1 = v[1] * rs * gn[1] * g1 / (1.0f + __expf(-g1));
                const float o2 = v[2] * rs * gn[2] * g2 / (1.0f + __expf(-g2)), o3 = v[3] * rs * gn[3] * g3 / (1.0f + __expf(-g3));
                v2u ow; ow.x = pk2(o0, o1); ow.y = pk2(o2, o3);
                *(GAS v2u*)(O + (size_t)(t0 + n) * D + ocol) = ow; }
        }
        __syncthreads();
    }
}
__device__ __forceinline__ void scan_phase(const Frame& F, bf16_t* UT, const float* BC) {
    const size_t gtid = (size_t)F.vcu * (NWAVES * 64) + F.tid, gthreads = (size_t)F.G * (NWAVES * 64);
    constexpr size_t NG4 = (size_t)16 * 256 * 128 / 4, NR4 = (size_t)16 * 256 * 256 / 4;
    for (size_t it = gtid; it < NG4 + NR4; it += gthreads) {
        float s0 = 0.f, s1 = 0.f, s2 = 0.f, s3 = 0.f;
        if (it < NG4) {
            const size_t el = it * 4; const int bh = (int)(el >> 15), d = (int)(el & 127), b = bh >> 2, h = bh & 3;
            GAS v2u* p = (GAS v2u*)(UT + (size_t)bh * NCH * 32768 + (el & 32767));
            const GAS f32x4* bp = (const GAS f32x4*)(BC + (size_t)(b * SEQ + 63) * 512 + h * 128 + d);
#pragma unroll 4
            for (int i = 0; i < NCH; ++i) {
                const v2u u = p[(size_t)i * (32768 / 4)]; const f32x4 bl = bp[(size_t)i * (CH * 512 / 4)];
                v2u o; o.x = pk2(s0, s1); o.y = pk2(s2, s3); p[(size_t)i * (32768 / 4)] = o;
                s0 = fmaf(__expf(bl[0]), s0, bflo(u.x)); s1 = fmaf(__expf(bl[1]), s1, bfhi(u.x)); s2 = fmaf(__expf(bl[2]), s2, bflo(u.y)); s3 = fmaf(__expf(bl[3]), s3, bfhi(u.y));
            }
        } else {
            const size_t el = (it - NG4) * 4; const int bh = (int)(el >> 16), h = bh & 3;
            GAS v2u* p = (GAS v2u*)(UT + UT_RET_OFF + (size_t)bh * NCH * 65536 + (el & 65535));
            const float dec = __expf(gamma_log(h) * 64.0f);
#pragma unroll 4
            for (int i = 0; i < NCH; ++i) {
                const v2u u = p[(size_t)i * (65536 / 4)];
                v2u o; o.x = pk2(s0, s1); o.y = pk2(s2, s3); p[(size_t)i * (65536 / 4)] = o;
                s0 = fmaf(dec, s0, bflo(u.x)); s1 = fmaf(dec, s1, bfhi(u.x)); s2 = fmaf(dec, s2, bflo(u.y)); s3 = fmaf(dec, s3, bfhi(u.y));
            }
        }
    }
}

template <int N> __device__ __forceinline__ void topk16_joint(float (&v)[N], float (&out)[16]) {
#pragma unroll
    for (int r = 0; r < 16; ++r) {
        float m = v[0];
#pragma unroll
        for (int i = 1; i < N; ++i) m = fmaxf(m, v[i]);
        m = fmaxf(m, __shfl_xor(m, 32));
        out[r] = m;
#pragma unroll
        for (int i = 0; i < N; ++i) v[i] = (v[i] == m) ? -INFINITY : v[i];
    }
}
struct CandTab { int ci[50], cj[50]; };
constexpr CandTab make_cands() { CandTab t{}; int n = 0; for (int i = 0; i < 16; ++i) for (int j = 0; j < 16; ++j) if ((i + 1) * (j + 1) <= 16) { t.ci[n] = i; t.cj[n] = j; ++n; } return t; }
constexpr CandTab CANDS = make_cands();

template <int S> __device__ __forceinline__ float cand_slot(const float (&la)[16], const float (&lb)[16], int hh) {
    constexpr int i0 = CANDS.ci[2 * S], j0 = CANDS.cj[2 * S], i1 = CANDS.ci[2 * S + 1], j1 = CANDS.cj[2 * S + 1];
    const float sa = __uint_as_float(__float_as_uint(la[i0]) & ~127u) + __uint_as_float(__float_as_uint(lb[j0]) & ~127u);
    const float sb = __uint_as_float(__float_as_uint(la[i1]) & ~127u) + __uint_as_float(__float_as_uint(lb[j1]) & ~127u);
    const unsigned pa = (__float_as_uint(sa) & ~255u) | (unsigned)(i0 * 16 + j0);
    const unsigned pb = (__float_as_uint(sb) & ~255u) | (unsigned)(i1 * 16 + j1);
    return __uint_as_float(hh ? pb : pa);
}
template <int... S> __device__ __forceinline__ void cand_slots(float (&slot)[25], const float (&la)[16], const float (&lb)[16], int hh, std::integer_sequence<int, S...>) {
    ((slot[S] = cand_slot<S>(la, lb, hh)), ...);
}
__device__ __forceinline__ void peer_topk_phase(const Frame& F, const bf16_t* Q, const bf16_t* SKB, int* EXP, float* GATE) {
    const int lane = F.lane, tok = lane & 31, hh = lane >> 5, h = F.wave;
    for (int blk = F.vcu; blk < T / 32; blk += F.G) {
        const int t0 = blk * 32;
        float lab[2][16];
#pragma unroll
        for (int p = 0; p < 2; ++p) {
            f32x16 acc[4];
#pragma unroll
            for (int i = 0; i < 4; ++i)
#pragma unroll
                for (int r = 0; r < 16; ++r) acc[i][r] = 0.f;
            const bf16_t* qrow = Q + (size_t)(t0 + tok) * D + h * 256 + p * 128 + 8 * hh;
            const bf16_t* skrow = SKB + ((size_t)(h * 2 + p) * 128 + tok) * 128 + 8 * hh;
#pragma unroll 2
            for (int s = 0; s < 8; ++s) {
                const bf16x8 bq = *(const bf16x8*)(qrow + 16 * s);
#pragma unroll
                for (int i = 0; i < 4; ++i) { const bf16x8 ak = *(const bf16x8*)(skrow + (size_t)i * 32 * 128 + 16 * s);
                    acc[i] = __builtin_amdgcn_mfma_f32_32x32x16_bf16(ak, bq, acc[i], 0, 0, 0); }
            }
            float v[64];
#pragma unroll
            for (int i = 0; i < 4; ++i)
#pragma unroll
                for (int r = 0; r < 16; ++r) { const unsigned kb = 32u * i + (r & 3) + 8u * (r >> 2);
                    v[i * 16 + r] = __uint_as_float((__float_as_uint(acc[i][r]) & ~127u) | kb | ((unsigned)hh << 2)); }
            topk16_joint<64>(v, lab[p]);
        }
        float slot[25];
        cand_slots(slot, lab[0], lab[1], hh, std::make_integer_sequence<int, 25>{});
        float win[16];
        topk16_joint<25>(slot, win);
        float ex[16], esum = 0.f;
#pragma unroll
        for (int r = 0; r < 16; ++r) { ex[r] = __expf(win[r] - win[0]); esum += ex[r]; }
        const float inv = 1.0f / esum;
        int eid[8]; float gt[8];
#pragma unroll
        for (int r = 0; r < 8; ++r) {
            const unsigned wb = __float_as_uint(hh ? win[r + 8] : win[r]);
            const int ci = (wb >> 4) & 15, cj = wb & 15;
            unsigned ia = 0, ib = 0;
#pragma unroll
            for (int i = 0; i < 16; ++i) { ia = (ci == i) ? (__float_as_uint(lab[0][i]) & 127u) : ia; ib = (cj == i) ? (__float_as_uint(lab[1][i]) & 127u) : ib; }
            eid[r] = (int)(ia * 128u + ib);
            gt[r] = (hh ? ex[r + 8] : ex[r]) * inv;
        }
        const size_t o = (size_t)(t0 + tok) * 128 + h * 16 + hh * 8;
        *(GAS v4u*)(EXP + o) = (v4u){(unsigned)eid[0], (unsigned)eid[1], (unsigned)eid[2], (unsigned)eid[3]};
        *(GAS v4u*)(EXP + o + 4) = (v4u){(unsigned)eid[4], (unsigned)eid[5], (unsigned)eid[6], (unsigned)eid[7]};
        *(GAS f32x4*)(GATE + o) = (f32x4){gt[0], gt[1], gt[2], gt[3]};
        *(GAS f32x4*)(GATE + o + 4) = (f32x4){gt[4], gt[5], gt[6], gt[7]};
    }
}

typedef float f32x2 __attribute__((ext_vector_type(2)));
template <int CTRL> __device__ __forceinline__ float dppf(float x) { return __builtin_bit_cast(float, __builtin_amdgcn_mov_dpp(__builtin_bit_cast(int, x), CTRL, 0xf, 0xf, true)); }
__device__ __forceinline__ float wave_sum_dpp(float x) {
    x += dppf<0xB1>(x); x += dppf<0x4E>(x); x += dppf<0x141>(x); x += dppf<0x128>(x);
    auto s = __builtin_amdgcn_permlane16_swap(__float_as_uint(x), __float_as_uint(x), false, false);
    x = __uint_as_float(s[0]) + __uint_as_float(s[1]);
    auto t = __builtin_amdgcn_permlane32_swap(__float_as_uint(x), __float_as_uint(x), false, false);
    return __uint_as_float(t[0]) + __uint_as_float(t[1]);
}
__device__ __forceinline__ float wave_max_dpp(float x) {
    x = fmaxf(x, dppf<0xB1>(x)); x = fmaxf(x, dppf<0x4E>(x)); x = fmaxf(x, dppf<0x141>(x)); x = fmaxf(x, dppf<0x128>(x));
    auto s = __builtin_amdgcn_permlane16_swap(__float_as_uint(x), __float_as_uint(x), false, false);
    x = fmaxf(__uint_as_float(s[0]), __uint_as_float(s[1]));
    auto t = __builtin_amdgcn_permlane32_swap(__float_as_uint(x), __float_as_uint(x), false, false);
    return fmaxf(__uint_as_float(t[0]), __uint_as_float(t[1]));
}
__device__ __forceinline__ void p0_fp8_rows(const float* src, unsigned char* dst, float* inv_scale, int gw, int NGW, int lane) {
    for (int row = gw; row < 16384; row += NGW) {
        const GAS f32x4* sp = (const GAS f32x4*)(src + (size_t)row * D) + 4 * lane;
        f32x4 v[2][4]; float mx = 0.f;
#pragma unroll
        for (int j = 0; j < 2; ++j)
#pragma unroll
            for (int c = 0; c < 4; ++c) { v[j][c] = sp[256 * j + c]; mx = fmaxf(fmaxf(mx, fmaxf(fabsf(v[j][c][0]), fabsf(v[j][c][1]))), fmaxf(fabsf(v[j][c][2]), fabsf(v[j][c][3]))); }
        mx = wave_max_dpp(mx);
        const int e = (int)((__float_as_uint(mx) >> 23) & 255u) - 127;
        const bool ok = mx > 0.f && e > -100 && e < 100;
        const float sc = ok ? __uint_as_float((unsigned)(127 + 7 - e) << 23) : 1.f, isc = ok ? __uint_as_float((unsigned)(127 - 7 + e) << 23) : 1.f;
#pragma unroll
        for (int j = 0; j < 2; ++j) { v4u o;
#pragma unroll
            for (int c = 0; c < 4; ++c) { unsigned w = 0u; w = __builtin_amdgcn_cvt_pk_fp8_f32(v[j][c][0] * sc, v[j][c][1] * sc, w, false); w = __builtin_amdgcn_cvt_pk_fp8_f32(v[j][c][2] * sc, v[j][c][3] * sc, w, true); o[c] = w; }
            *(GAS v4u*)(dst + (size_t)row * 2048 + 16 * lane + 1024 * j) = o; }
        if (lane == 0) inv_scale[row] = isc;
    }
}
constexpr int PG_NB = 8;
__device__ __forceinline__ void peer_gather_phase(const Frame& F, const float* H1, const unsigned char* UB, const unsigned char* VB, const float* USC, const float* VSC,
                                                  const int* EXP, const float* GATE, const float* g2, const float* b2, float* out) {
    const int lane = F.lane, gw = F.vcu * NWAVES + F.wave, NGW = F.G * NWAVES;
    LAS unsigned* sid = (LAS unsigned*)(F.lds + F.wave * 1024);
    LAS float* sw = (LAS float*)(F.lds + F.wave * 1024 + 512);
    for (int t = gw; t < T; t += NGW) {
        const GAS f32x4* hrow = (const GAS f32x4*)(H1 + (size_t)t * D) + 4 * lane;
        f32x2 xr[16];
#pragma unroll
        for (int j = 0; j < 2; ++j)
#pragma unroll
            for (int c = 0; c < 4; ++c) { const f32x4 a = hrow[256 * j + c]; xr[8 * j + 2 * c] = (f32x2){a[0], a[1]}; xr[8 * j + 2 * c + 1] = (f32x2){a[2], a[3]}; }
        const unsigned id0 = ((const GAS unsigned*)EXP)[(size_t)t * 128 + lane], id1 = ((const GAS unsigned*)EXP)[(size_t)t * 128 + 64 + lane];
        const float gt0 = ((const GAS float*)GATE)[(size_t)t * 128 + lane], gt1 = ((const GAS float*)GATE)[(size_t)t * 128 + 64 + lane];
        const float us0 = ((const GAS float*)USC)[id0], us1 = ((const GAS float*)USC)[id1], vs0 = ((const GAS float*)VSC)[id0], vs1 = ((const GAS float*)VSC)[id1];
        sid[lane] = id0; sid[64 + lane] = id1;
        for (int kb = 0; kb < 128; kb += PG_NB) {
            v4u w[PG_NB][2];
#pragma unroll
            for (int q = 0; q < PG_NB; ++q) { const unsigned e = __builtin_amdgcn_readfirstlane(sid[kb + q]);
                const GAS v4u* rp = (const GAS v4u*)(UB + (size_t)e * 2048) + lane;
                w[q][0] = rp[0]; w[q][1] = rp[64]; }
#pragma unroll
            for (int q = 0; q < PG_NB; ++q) { f32x2 a0 = {0.f, 0.f}, a1 = {0.f, 0.f};
#pragma unroll
                for (int j = 0; j < 2; ++j)
#pragma unroll
                    for (int c = 0; c < 4; ++c) { const unsigned dw = w[q][j][c];
                        a0 = __builtin_amdgcn_cvt_pk_f32_fp8(dw, false) * xr[8 * j + 2 * c] + a0; a1 = __builtin_amdgcn_cvt_pk_f32_fp8(dw, true) * xr[8 * j + 2 * c + 1] + a1; }
                const float dsum = wave_sum_dpp((a0.x + a0.y) + (a1.x + a1.y));
                if (lane == 0) sw[kb + q] = dsum; }
        }
        {
            const float d0 = sw[lane] * us0, d1 = sw[64 + lane] * us1;
            const float w0 = gt0 * 0.5f * d0 * (1.0f + erff(d0 * 0.7071067811865476f)) * vs0, w1 = gt1 * 0.5f * d1 * (1.0f + erff(d1 * 0.7071067811865476f)) * vs1;
            sw[lane] = w0; sw[64 + lane] = w1;
        }
        f32x2 acc[16];
#pragma unroll
        for (int i = 0; i < 16; ++i) acc[i] = (f32x2){0.f, 0.f};
        for (int kb = 0; kb < 128; kb += PG_NB) {
            v4u w[PG_NB][2]; float wk[PG_NB];
#pragma unroll
            for (int q = 0; q < PG_NB; ++q) { const unsigned e = __builtin_amdgcn_readfirstlane(sid[kb + q]);
                wk[q] = __builtin_bit_cast(float, __builtin_amdgcn_readfirstlane(__builtin_bit_cast(unsigned, sw[kb + q])));
                const GAS v4u* rp = (const GAS v4u*)(VB + (size_t)e * 2048) + lane;
                w[q][0] = rp[0]; w[q][1] = rp[64]; }
#pragma unroll
            for (int q = 0; q < PG_NB; ++q) { const f32x2 wk2 = {wk[q], wk[q]};
#pragma unroll
                for (int j = 0; j < 2; ++j)
#pragma unroll
                    for (int c = 0; c < 4; ++c) { const unsigned dw = w[q][j][c];
                        acc[8 * j + 2 * c] = __builtin_amdgcn_cvt_pk_f32_fp8(dw, false) * wk2 + acc[8 * j + 2 * c]; acc[8 * j + 2 * c + 1] = __builtin_amdgcn_cvt_pk_f32_fp8(dw, true) * wk2 + acc[8 * j + 2 * c + 1]; } }
        }
        float s = 0.f;
#pragma unroll
        for (int i = 0; i < 16; ++i) { acc[i] = xr[i] * ALPHA + acc[i]; s += acc[i].x + acc[i].y; }
        const float mean = wave_sum_dpp(s) * (1.f / D); float s2 = 0.f;
#pragma unroll
        for (int i = 0; i < 16; ++i) { acc[i] = acc[i] - mean; s2 += acc[i].x * acc[i].x + acc[i].y * acc[i].y; }
        const float rstd = 1.f / sqrtf(wave_sum_dpp(s2) * (1.f / D) + LN_EPS);
        GAS f32x4* orow = (GAS f32x4*)(out + (size_t)t * D) + 4 * lane;
#pragma unroll
        for (int j = 0; j < 2; ++j)
#pragma unroll
            for (int c = 0; c < 4; ++c) { const f32x4 ga = ((const GAS f32x4*)g2)[256 * j + 4 * lane + c], ba = ((const GAS f32x4*)b2)[256 * j + 4 * lane + c];
                const f32x2 lo = acc[8 * j + 2 * c] * rstd, hi = acc[8 * j + 2 * c + 1] * rstd;
                orow[256 * j + c] = (f32x4){lo.x * ga[0] + ba[0], lo.y * ga[1] + ba[1], hi.x * ga[2] + ba[2], hi.y * ga[3] + ba[3]}; }
    }
}

template <bool WIN>
__device__ __forceinline__ void p0_transpose_item(const float* W, int K, int N, int nblk, bf16_t* WT, LAS float* scr, int item, int lane) {
    const int kb = item / nblk, nb = item % nblk, k0 = 64 * kb, n0 = 32 * nb;
    const int n = n0 + (lane & 31);
    int src = n; float sc = 1.f; bool ok = true;
    if (WIN) {
        ok = n < NPROJ;
        src = (n < 3072) ? n : (n < 7168 ? n + 16 : n - 7168 + 3072);
        sc = (n < 512) ? 0.08838834764831845f : ((n >= C_RK && n < C_RV) ? 0.0625f : 1.f);
    }
#pragma unroll 8
    for (int i = 0; i < 32; ++i) { const int kk = 2 * i + (lane >> 5); scr[kk * 33 + (lane & 31)] = ok ? W[(size_t)(k0 + kk) * N + src] * sc : 0.f; }
    LDS_WAIT(); asm volatile("" ::: "memory");
    const int c = lane & 7;
#pragma unroll
    for (int j = 0; j < 4; ++j) { const int nn = (lane >> 3) + 8 * j; const LAS float* s = scr + (8 * c) * 33 + nn;
        v4u o; o.x = pk2(s[0 * 33], s[1 * 33]); o.y = pk2(s[2 * 33], s[3 * 33]); o.z = pk2(s[4 * 33], s[5 * 33]); o.w = pk2(s[6 * 33], s[7 * 33]);
        *(GAS v4u*)(WT + (size_t)(n0 + nn) * K + k0 + 8 * c) = o; }
    LDS_WAIT(); asm volatile("" ::: "memory");
}
__device__ __forceinline__ void p0_cvt(const float* src, bf16_t* dst, size_t n8, size_t gtid, size_t gthreads) {
    for (size_t i = gtid; i < n8; i += gthreads) {
        const f32x4 a = ((const GAS f32x4*)src)[2 * i], b = ((const GAS f32x4*)src)[2 * i + 1];
        v4u o; o.x = pk2(a[0], a[1]); o.y = pk2(a[2], a[3]); o.z = pk2(b[0], b[1]); o.w = pk2(b[2], b[3]);
        ((GAS v4u*)dst)[i] = o;
    }
}
__device__ __forceinline__ void p0_prologue(const Frame& F, const Args& a) {
    unsigned char* ws = a.ws;
    LAS float* scr = (LAS float*)(F.lds + F.wave * 16384);
    const int gw = F.vcu * NWAVES + F.wave, NGW = F.G * NWAVES;
    constexpr int I_IN = (D / 64) * (NP / 32), I_SQ = (D / 64) * (D / 32);
    for (int it = gw; it < I_IN + 2 * I_SQ; it += NGW) {
        if (it < I_IN) p0_transpose_item<true>(a.in[1], D, NPROJ, NP / 32, (bf16_t*)(ws + WS_WIN), scr, it, F.lane);
        else if (it < I_IN + I_SQ) p0_transpose_item<false>(a.in[6], D, D, D / 32, (bf16_t*)(ws + WS_WOUT), scr, it - I_IN, F.lane);
        else p0_transpose_item<false>(a.in[9], D, D, D / 32, (bf16_t*)(ws + WS_WQ), scr, it - I_IN - I_SQ, F.lane);
    }
    const size_t gtid = (size_t)F.vcu * (NWAVES * 64) + F.tid, gthreads = (size_t)F.G * (NWAVES * 64);
    p0_cvt(a.in[0], (bf16_t*)(ws + WS_XB), (size_t)T * D / 8, gtid, gthreads);
    p0_fp8_rows(a.in[11], ws + WS_UB, (float*)(ws + WS_USC), gw, NGW, F.lane);
    p0_fp8_rows(a.in[12], ws + WS_VB, (float*)(ws + WS_VSC), gw, NGW, F.lane);
    p0_cvt(a.in[10], (bf16_t*)(ws + WS_SKB), (size_t)8 * 2 * 128 * 128 / 8, gtid, gthreads);
    float* rope = (float*)(ws + WS_ROPE);
    for (size_t idx = gtid; idx < (size_t)SEQ * 128; idx += gthreads) {
        const int pos = (int)(idx >> 7), i = (int)(idx & 127);
        const float inv = powf(10000.0f, -(float)i / 128.0f);
        const float ang = (float)pos * inv;
        const float n = rintf(ang * 0.15915494309189535f);
        float r = fmaf(-n, 6.28125f, ang); r = fmaf(-n, 0.0019353071795864769f, r);
        rope[2 * idx] = cosf(r); rope[2 * idx + 1] = sinf(r);
    }
}
__device__ __forceinline__ void ln_rows_phase(const Frame& F, float* Y, const float* g, const float* bta, bf16_t* Hb) {
    const int gw = F.vcu * NWAVES + F.wave, NGW = F.G * NWAVES;
    for (int row = gw; row < T; row += NGW) {
        GAS f32x4* yr = (GAS f32x4*)(Y + (size_t)row * D) + F.lane;
        f32x4 v[8]; float s = 0.f;
#pragma unroll
        for (int j = 0; j < 8; ++j) { v[j] = yr[64 * j]; s += (v[j][0] + v[j][1]) + (v[j][2] + v[j][3]); }
        const float mean = wave_sum(s) * (1.f / D); float s2 = 0.f;
#pragma unroll
        for (int j = 0; j < 8; ++j) { v[j] = v[j] - mean; s2 += (v[j][0] * v[j][0] + v[j][1] * v[j][1]) + (v[j][2] * v[j][2] + v[j][3] * v[j][3]); }
        const float rstd = 1.f / sqrtf(wave_sum(s2) * (1.f / D) + LN_EPS);
        GAS v2u* o8 = (GAS v2u*)(Hb + (size_t)row * D) + F.lane;
#pragma unroll
        for (int j = 0; j < 8; ++j) { const f32x4 gg = ((const GAS f32x4*)g)[64 * j + F.lane], bb = ((const GAS f32x4*)bta)[64 * j + F.lane];
            const f32x4 o = v[j] * rstd * gg + bb; yr[64 * j] = o; v2u w; w.x = pk2(o[0], o[1]); w.y = pk2(o[2], o[3]); o8[64 * j] = w; }
    }
}

constexpr int N_PHASES = 10;
__global__ void __launch_bounds__(NWAVES * 64, 2) mega_fwd(Args args) {
    extern __shared__ __attribute__((aligned(16))) unsigned char lds[];
    Frame F;
    F.lds = (LAS unsigned char*)lds;
    volatile LAS unsigned* MISC = (volatile LAS unsigned*)(F.lds + MISC_OFF);
    F.tid = threadIdx.x; F.lane = F.tid & 63; F.wave = __builtin_amdgcn_readfirstlane(F.tid >> 6);
    F.G = gridDim.x; { const int bx = blockIdx.x; F.vcu = (F.G % 8 == 0) ? (bx % 8) * (F.G / 8) + bx / 8 : bx; }
    unsigned char* ws = args.ws;
    gu32* ctl = (gu32*)(ws + WS_CTL);
    for (int u = F.tid; u < (LDS_BYTES - LDSCTL_OFF) / 4; u += NWAVES * 64) ((LAS unsigned*)(F.lds + LDSCTL_OFF))[u] = 0u;
    __syncthreads();
    const int lo = args.ph_lo, hi = args.ph_hi;
    XcdBarrier bar; bar.bar = (unsigned*)(ctl + CW_BAR) + args.li * XCD_BAR_WORDS; bar.x = 0; bar.st = nullptr;
    if (hi - lo > 1) bar = xcd_barrier_post((unsigned*)(ctl + CW_BAR) + args.li * XCD_BAR_WORDS, MISC + 8);
#define IN(k) (lo <= (k) && (k) < hi)
#define BOTH(k) (IN(k) && IN((k) + 1))
#define SEAM(k) do { if (BOTH(k)) xcd_barrier(bar); } while (0)
    bf16_t* WIN = (bf16_t*)(ws + WS_WIN); bf16_t* WOUT = (bf16_t*)(ws + WS_WOUT); bf16_t* WQ = (bf16_t*)(ws + WS_WQ);
    bf16_t* XB = (bf16_t*)(ws + WS_XB); bf16_t* PROJ = (bf16_t*)(ws + WS_PROJ); bf16_t* OB = (bf16_t*)(ws + WS_O);
    float* Y = (float*)(ws + WS_Y); bf16_t* H1B = (bf16_t*)(ws + WS_H1B); bf16_t* QB = (bf16_t*)(ws + WS_Q);
    const float* ROPE = (const float*)(ws + WS_ROPE);

    if (IN(0)) { p0_prologue(F, args); SEAM(0); }
    if (IN(1)) {
        pg8::Gemm g{XB, WIN, T, NP, D}; pg8::StaticOrder S; S.init(T, NP, F.G, (int)blockIdx.x);
        pg8::EpiBf16 E{PROJ, NP, ROPE, 12, 20};
        pg8::gemm_phase<pg8::EpiBf16, pg8::StaticOrder, true, true>(F.lds, g, S, E);
        SEAM(1);
    }
    if (IN(2)) { chunk_u_phase(F, PROJ, args.in[2], args.in[3], (float*)(ws + WS_BC), (bf16_t*)(ws + WS_UT)); SEAM(2); }
    if (IN(3)) { scan_phase(F, (bf16_t*)(ws + WS_UT), (const float*)(ws + WS_BC)); SEAM(3); }
    if (IN(4)) { chunk_o_phase(F, PROJ, (const float*)(ws + WS_BC), (const bf16_t*)(ws + WS_UT), args.in[4], args.in[5], OB); SEAM(4); }
    if (IN(5)) {
        pg8::Gemm g{OB, WOUT, T, D, D}; pg8::StaticOrder S; S.init(T, D, F.G, (int)blockIdx.x);
        pg8::EpiResF32 E{Y, args.in[0], D, ALPHA};
        pg8::gemm_phase<pg8::EpiResF32, pg8::StaticOrder, true, true>(F.lds, g, S, E);
        SEAM(5);
    }
    if (IN(6)) { ln_rows_phase(F, Y, args.in[7], args.in[8], H1B); SEAM(6); }
    if (IN(7)) {
        pg8::Gemm g{H1B, WQ, T, D, D}; pg8::StaticOrder S; S.init(T, D, F.G, (int)blockIdx.x);
        pg8::EpiBf16 E{QB, D, nullptr, 0, 0};
        pg8::gemm_phase<pg8::EpiBf16, pg8::StaticOrder, true, true>(F.lds, g, S, E);
        SEAM(7);
    }
    if (IN(8)) { peer_topk_phase(F, QB, (const bf16_t*)(ws + WS_SKB), (int*)(ws + WS_EXP), (float*)(ws + WS_GATE)); SEAM(8); }
    if (IN(9)) peer_gather_phase(F, Y, ws + WS_UB, ws + WS_VB, (const float*)(ws + WS_USC), (const float*)(ws + WS_VSC), (const int*)(ws + WS_EXP), (const float*)(ws + WS_GATE), args.in[13], args.in[14], args.out);
#undef IN
#undef BOTH
#undef SEAM
}

__global__ void __launch_bounds__(256) k_chunk_u(const bf16_t* __restrict__ proj, const float* __restrict__ wg, const float* __restrict__ bg,
                                                float* __restrict__ bc, bf16_t* __restrict__ ut) {
    __shared__ float sb[64][128];
    __shared__ bf16_t kt[64][256];
    const int unit = blockIdx.x, head = unit & 7, bchunk = unit >> 3, b = bchunk / NCH, ch = bchunk % NCH;
    const int t0 = b * SEQ + ch * CH, tid = threadIdx.x;
    if (head < 4) {
        const int h = head;
        for (int idx = tid; idx < 64 * 128; idx += 256) {
            const int c = idx >> 7, d = idx & 127;
            float z = bg[h * 128 + d];
            for (int r = 0; r < 16; ++r) z = fmaf(bf2f(proj[(size_t)(t0 + c) * NP + C_GLR + r]), wg[r * 512 + h * 128 + d], z);
            const float ls = fminf(z, 0.f) - log1pf(expf(-fabsf(z)));
            sb[c][d] = ls * (1.0f / 16.0f);
        }
        __syncthreads();
        if (tid < 128) { float s = 0.f; for (int c = 0; c < 64; ++c) { s += sb[c][tid]; sb[c][tid] = s; bc[(size_t)(t0 + c) * 512 + h * 128 + tid] = s; } }
        __syncthreads();
        for (int idx = tid; idx < 64 * 128; idx += 256) { const int c = idx >> 7, d = idx & 127;
            kt[c][d] = f2bf(bf2f(proj[(size_t)(t0 + c) * NP + C_GK + h * 128 + d]) * expf(sb[63][d] - sb[c][d])); }
        __syncthreads();
        bf16_t* o = ut + ((size_t)(b * 4 + h) * NCH + ch) * 256 * 128;
        for (int idx = tid; idx < 256 * 128; idx += 256) { const int e = idx >> 7, d = idx & 127; float s = 0.f;
            for (int c = 0; c < 64; ++c) s = fmaf(bf2f(proj[(size_t)(t0 + c) * NP + C_GV + h * 256 + e]), bf2f(kt[c][d]), s);
            o[idx] = f2bf(s); }
    } else {
        const int h = head - 4; const float lg = gamma_log(h);
        for (int idx = tid; idx < 64 * 256; idx += 256) { const int c = idx >> 8, d = idx & 255;
            kt[c][d] = f2bf(bf2f(proj[(size_t)(t0 + c) * NP + C_RK + h * 256 + d]) * expf(lg * (float)(63 - c))); }
        __syncthreads();
        bf16_t* o = ut + UT_RET_OFF + ((size_t)(b * 4 + h) * NCH + ch) * 256 * 256;
        for (int idx = tid; idx < 256 * 256; idx += 256) { const int e = idx >> 8, d = idx & 255; float s = 0.f;
            for (int c = 0; c < 64; ++c) s = fmaf(bf2f(proj[(size_t)(t0 + c) * NP + C_RV + h * 256 + e]), bf2f(kt[c][d]), s);
            o[idx] = f2bf(s); }
    }
}
__global__ void k_scan(bf16_t* __restrict__ ut, const float* __restrict__ bc) {
    const size_t idx = (size_t)blockIdx.x * blockDim.x + threadIdx.x;
    const size_t NG = (size_t)16 * 256 * 128, NR = (size_t)16 * 256 * 256;
    if (idx < NG) {
        const int bh = (int)(idx >> 15), d = (int)(idx & 127), b = bh >> 2, h = bh & 3;
        bf16_t* p = ut + (size_t)bh * NCH * 32768 + (idx & 32767);
        float s = 0.f;
        for (int i = 0; i < NCH; ++i) { const float u = bf2f(p[(size_t)i * 32768]); p[(size_t)i * 32768] = f2bf(s);
            const float dec = expf(bc[(size_t)(b * SEQ + i * CH + 63) * 512 + h * 128 + d]); s = fmaf(dec, s, u); }
    } else if (idx < NG + NR) {
        const size_t j = idx - NG; const int bh = (int)(j >> 16), h = bh & 3;
        bf16_t* p = ut + UT_RET_OFF + (size_t)bh * NCH * 65536 + (j & 65535);
        const float dec = expf(gamma_log(h) * 64.0f); float s = 0.f;
        for (int i = 0; i < NCH; ++i) { const float u = bf2f(p[(size_t)i * 65536]); p[(size_t)i * 65536] = f2bf(s); s = fmaf(dec, s, u); }
    }
}
__device__ __forceinline__ float block_sum256(float v, float* red) {
    v = wave_sum(v);
    __syncthreads();
    if ((threadIdx.x & 63) == 0) red[threadIdx.x >> 6] = v;
    __syncthreads();
    return red[0] + red[1] + red[2] + red[3];
}
__global__ void __launch_bounds__(256) k_chunk_o(const bf16_t* __restrict__ proj, const float* __restrict__ bc, const bf16_t* __restrict__ st,
                                                const float* __restrict__ gla_g, const float* __restrict__ ret_g, bf16_t* __restrict__ O) {
    __shared__ float sb[64][128];
    __shared__ float sa[64][65];
    __shared__ float red[4];
    const int unit = blockIdx.x, head = unit & 7, bchunk = unit >> 3, b = bchunk / NCH, ch = bchunk % NCH;
    const int t0 = b * SEQ + ch * CH, tid = threadIdx.x;
    if (head < 4) {
        const int h = head;
        for (int idx = tid; idx < 64 * 128; idx += 256) { const int c = idx >> 7, d = idx & 127; sb[c][d] = bc[(size_t)(t0 + c) * 512 + h * 128 + d]; }
        __syncthreads();
        for (int idx = tid; idx < 64 * 64; idx += 256) { const int n = idx >> 6, m = idx & 63; float s = 0.f;
            const bf16_t* qp = proj + (size_t)(t0 + n) * NP + C_GQ + h * 128; const bf16_t* kp = proj + (size_t)(t0 + m) * NP + C_GK + h * 128;
            for (int d = 0; d < 128; ++d) s = fmaf(bf2f(qp[d]) * bf2f(kp[d]), expf(-fabsf(sb[n][d] - sb[m][d])), s);
            sa[n][m] = s; }
        __syncthreads();
        const int e = tid; const bf16_t* sp = st + ((size_t)(b * 4 + h) * NCH + ch) * 256 * 128 + (size_t)e * 128;
        const float g = gla_g[h * 256 + e];
        for (int n = 0; n < 64; ++n) {
            float o = 0.f;
            for (int m = 0; m < 64; ++m) o = fmaf(sa[n][m], bf2f(proj[(size_t)(t0 + m) * NP + C_GV + h * 256 + e]), o);
            const bf16_t* qp = proj + (size_t)(t0 + n) * NP + C_GQ + h * 128;
            for (int d = 0; d < 128; ++d) o = fmaf(bf2f(qp[d]) * expf(sb[n][d]), bf2f(sp[d]), o);
            const float ss = block_sum256(o * o, red);
            const float y = o * rsqrtf(ss * (1.0f / 256.0f) + LN_EPS) * g;
            const float gt = bf2f(proj[(size_t)(t0 + n) * NP + C_GR + h * 256 + e]);
            O[(size_t)(t0 + n) * D + h * 256 + e] = f2bf(y * gt / (1.0f + expf(-gt)));
        }
    } else {
        const int h = head - 4; const float lg = gamma_log(h);
        for (int idx = tid; idx < 64 * 64; idx += 256) { const int n = idx >> 6, m = idx & 63; float s = 0.f;
            const bf16_t* qp = proj + (size_t)(t0 + n) * NP + C_RQ + h * 256; const bf16_t* kp = proj + (size_t)(t0 + m) * NP + C_RK + h * 256;
            for (int d = 0; d < 256; ++d) s = fmaf(bf2f(qp[d]), bf2f(kp[d]), s);
            sa[n][m] = s * expf(lg * fabsf((float)(n - m))); }
        __syncthreads();
        const int e = tid; const bf16_t* sp = st + UT_RET_OFF + ((size_t)(b * 4 + h) * NCH + ch) * 256 * 256 + (size_t)e * 256;
        const float g = ret_g[h * 256 + e];
        for (int n = 0; n < 64; ++n) {
            float o = 0.f, oi = 0.f;
            for (int m = 0; m < 64; ++m) o = fmaf(sa[n][m], bf2f(proj[(size_t)(t0 + m) * NP + C_RV + h * 256 + e]), o);
            const bf16_t* qp = proj + (size_t)(t0 + n) * NP + C_RQ + h * 256;
            for (int d = 0; d < 256; ++d) oi = fmaf(bf2f(qp[d]), bf2f(sp[d]), oi);
            o += oi * expf(lg * (float)(n + 1));
            const float mu = block_sum256(o, red) * (1.0f / 256.0f);
            const float oc = o - mu;
            const float ss = block_sum256(oc * oc, red);
            const float y = oc * rsqrtf(ss * (1.0f / 256.0f) + LN_EPS) * g;
            const float gt = bf2f(proj[(size_t)(t0 + n) * NP + C_RR + h * 256 + e]);
            O[(size_t)(t0 + n) * D + 1024 + h * 256 + e] = f2bf(y * gt / (1.0f + expf(-gt)));
        }
    }
}
__global__ void __launch_bounds__(32) k_peer_topk(const bf16_t* __restrict__ Q, const bf16_t* __restrict__ skb, int* __restrict__ ex, float* __restrict__ gate) {
    __shared__ float sc[32][129];
    __shared__ float tv[32][2][16];
    __shared__ int ti[32][2][16];
    __shared__ float cand[32][257];
    const int lt = threadIdx.x, gidx = blockIdx.x * 32 + lt, t = gidx >> 3, h = gidx & 7;
    for (int p = 0; p < 2; ++p) {
        const bf16_t* q = Q + (size_t)t * D + h * 256 + p * 128;
        const bf16_t* sk = skb + (size_t)(h * 2 + p) * 128 * 128;
        for (int k = 0; k < 128; ++k) { float s = 0.f; for (int d = 0; d < 128; ++d) s = fmaf(bf2f(q[d]), bf2f(sk[k * 128 + d]), s); sc[lt][k] = s; }
        for (int r = 0; r < 16; ++r) { float best = -INFINITY; int bi = 0;
            for (int k = 0; k < 128; ++k) { const float v = sc[lt][k]; if (v > best) { best = v; bi = k; } }
            tv[lt][p][r] = best; ti[lt][p][r] = bi; sc[lt][bi] = -INFINITY; }
    }
    for (int i = 0; i < 16; ++i) for (int j = 0; j < 16; ++j) cand[lt][i * 16 + j] = tv[lt][0][i] + tv[lt][1][j];
    float mx = 0.f, sum = 0.f;
    for (int r = 0; r < 16; ++r) { float best = -INFINITY; int bi = 0;
        for (int k = 0; k < 256; ++k) { const float v = cand[lt][k]; if (v > best) { best = v; bi = k; } }
        cand[lt][bi] = -INFINITY;
        if (r == 0) mx = best;
        const float e = expf(best - mx); sum += e;
        ex[(size_t)t * 128 + h * 16 + r] = ti[lt][0][bi >> 4] * 128 + ti[lt][1][bi & 15];
        gate[(size_t)t * 128 + h * 16 + r] = e; }
    const float inv = 1.0f / sum;
    for (int r = 0; r < 16; ++r) gate[(size_t)t * 128 + h * 16 + r] *= inv;
}
__global__ void __launch_bounds__(256) k_peer_gather(const float* __restrict__ H1, const bf16_t* __restrict__ ub, const bf16_t* __restrict__ vb,
                                                    const int* __restrict__ ex, const float* __restrict__ gate,
                                                    const float* __restrict__ g2, const float* __restrict__ b2, float* __restrict__ out) {
    const int t = blockIdx.x * 4 + (threadIdx.x >> 6), lane = threadIdx.x & 63;
    const float* hrow = H1 + (size_t)t * D;
    float x[32], acc[32];
#pragma unroll
    for (int j = 0; j < 32; ++j) { x[j] = hrow[j * 64 + lane]; acc[j] = 0.f; }
    for (int k = 0; k < 128; ++k) {
        const int e = ex[(size_t)t * 128 + k]; const float gt = gate[(size_t)t * 128 + k];
        const bf16_t* ur = ub + (size_t)e * D; const bf16_t* vr = vb + (size_t)e * D;
        float s = 0.f;
#pragma unroll
        for (int j = 0; j < 32; ++j) s = fmaf(bf2f(ur[j * 64 + lane]), x[j], s);
        s = wave_sum(s);
        const float w = gt * 0.5f * s * (1.0f + erff(s * 0.7071067811865476f));
#pragma unroll
        for (int j = 0; j < 32; ++j) acc[j] = fmaf(w, bf2f(vr[j * 64 + lane]), acc[j]);
    }
    float s = 0.f;
#pragma unroll
    for (int j = 0; j < 32; ++j) { acc[j] = ALPHA * x[j] + acc[j]; s += acc[j]; }
    const float mu = wave_sum(s) * (1.0f / D); float q = 0.f;
#pragma unroll
    for (int j = 0; j < 32; ++j) { acc[j] -= mu; q += acc[j] * acc[j]; }
    const float rstd = rsqrtf(wave_sum(q) * (1.0f / D) + LN_EPS);
#pragma unroll
    for (int j = 0; j < 32; ++j) { const int c = j * 64 + lane; out[(size_t)t * D + c] = acc[j] * rstd * g2[c] + b2[c]; }
}

extern "C" void kernel_launch(void* const* d_in, const int* in_sizes, int n_in, void* d_out, int out_size, void* d_ws, size_t ws_size, hipStream_t stream) {
    static int grid = 0;
    if (grid == 0) {
        if (n_in != 15 || in_sizes[0] != T * D || out_size != T * D || ws_size < WS_END) { fprintf(stderr, "kernel_launch: unexpected shapes / workspace (n_in %d, ws %zu)\n", n_in, ws_size); grid = -1; return; }
        int dev = 0, cus = 0, per_cu = 0;
        if (hipGetDevice(&dev) != hipSuccess || hipDeviceGetAttribute(&cus, hipDeviceAttributeMultiprocessorCount, dev) != hipSuccess) { grid = -1; return; }
        if (hipFuncSetAttribute((const void*)mega_fwd, hipFuncAttributeMaxDynamicSharedMemorySize, LDS_BYTES) != hipSuccess) { fprintf(stderr, "kernel_launch: hipFuncSetAttribute failed\n"); grid = -1; return; }
        if (hipOccupancyMaxActiveBlocksPerMultiprocessor(&per_cu, (const void*)mega_fwd, NWAVES * 64, LDS_BYTES) != hipSuccess || per_cu < 1)
            fprintf(stderr, "kernel_launch: occupancy query reports %d workgroups per CU\n", per_cu);
        (void)hipGetLastError();
        grid = cus;
    }
    if (grid < 0) return;
    hipMemsetAsync((char*)d_ws + WS_CTL, 0, CTL_ZERO_BYTES, stream);
    Args a{};
    for (int i = 0; i < 15; ++i) a.in[i] = (const float*)d_in[i];
    a.out = (float*)d_out; a.ws = (unsigned char*)d_ws;
    unsigned char* ws = (unsigned char*)d_ws;
    const float* wg = (const float*)d_in[2]; const float* bg = (const float*)d_in[3]; const float* gla_g = (const float*)d_in[4]; const float* ret_g = (const float*)d_in[5];
    const float* ln2_g = (const float*)d_in[13]; const float* ln2_b = (const float*)d_in[14];
    bf16_t* SKB = (bf16_t*)(ws + WS_SKB); bf16_t* UB = (bf16_t*)(ws + WS_UB); bf16_t* VB = (bf16_t*)(ws + WS_VB);
    bf16_t* PROJ = (bf16_t*)(ws + WS_PROJ); float* BC = (float*)(ws + WS_BC); bf16_t* UT = (bf16_t*)(ws + WS_UT); bf16_t* O = (bf16_t*)(ws + WS_O);
    float* Y = (float*)(ws + WS_Y); int* EXP = (int*)(ws + WS_EXP); float* GATE = (float*)(ws + WS_GATE); bf16_t* Q = (bf16_t*)(ws + WS_Q);
    a.ph_lo = 0; a.ph_hi = N_PHASES; a.li = 0;
    hipLaunchKernelGGL(mega_fwd, dim3(grid), dim3(NWAVES * 64), LDS_BYTES, stream, a);
}
```

```cpp
#include <hip/hip_runtime.h>
#include <stdint.h>
#include <math.h>
#include <cstdio>
#include <utility>

namespace pg8 {
#define PG8_LAS __attribute__((address_space(3)))
typedef unsigned short bf16_t;
typedef short bf16x8 __attribute__((ext_vector_type(8)));
typedef float f32x4 __attribute__((ext_vector_type(4)));
typedef unsigned u32x4 __attribute__((ext_vector_type(4)));
constexpr int BM = 256, BK = 64, HALF = 128, HTB = HALF * BK * 2  , STAGE_BYTES = 8 * HTB, NXCD = 8, WGM = 8;

__host__ __device__ __forceinline__ int lds_byte(int r, int c) { const int st = (r >> 4) * 2 + (c >> 5), rr = r & 15, cc = c & 31, ob = rr * 64 + cc * 2; return st * 1024 + (ob ^ (((ob >> 9) & 1) << 5)); }
__host__ __device__ __forceinline__ void stage_rc(int b, int& R, int& C) { const int st = b / 1024, sb = b % 1024, swz = sb ^ (((sb >> 9) & 1) << 5); R = (st >> 1) * 16 + swz / 64; C = (st & 1) * 32 + (swz % 64) / 2; }
__host__ __device__ __forceinline__ int perm32(int rho) { const int n = rho >> 4, i = rho & 15; return 8 * (i >> 2) + 4 * n + (i & 3); }

struct Unit { int pm, pn; };
struct Gemm { const bf16_t* A; const bf16_t* Bt; int M, N, K; };

struct StaticOrder {
    int nM, nN, nwg, G, c;
    __host__ __device__ void init(int M, int N, int G_, int c_) { nM = M / BM; nN = N / BM; nwg = nM * nN; G = G_; c = c_; }
    __host__ __device__ bool next(int i, Unit& u) const {
        const long L = (long)i * G + c; if (L >= nwg) return false;
        int wgid = (int)L; { const int q = nwg / NXCD, r = nwg % NXCD, xcd = wgid % NXCD, off = wgid / NXCD; wgid = (xcd < r ? xcd * (q + 1) : r * (q + 1) + (xcd - r) * q) + off; }
        const int nig = WGM * nN, gid = wgid / nig, fm = gid * WGM, gsz = (nM - fm) < WGM ? (nM - fm) : WGM;
        u.pm = fm + ((wgid % nig) % gsz); u.pn = (wgid % nig) / gsz; return true;
    }
    __device__ __forceinline__ void a_ready(const Unit&) const {}
    __device__ __forceinline__ void done(const Unit&) const {}
};

typedef unsigned u32x4 __attribute__((ext_vector_type(4)));
__device__ __forceinline__ unsigned cvt_pk_bf16(float lo, float hi) { unsigned r; asm volatile("v_cvt_pk_bf16_f32 %0, %1, %2" : "=v"(r) : "v"(lo), "v"(hi)); return r; }
struct EpiBf16 {
    static constexpr bool PERM = true, AFTER_DRAIN = false;
    bf16_t* O; int ldc; const float* rope; int rot_lo, rot_hi;
    __device__ __forceinline__ void operator()(const f32x4 (&acc)[2][2][4][2], const Unit& u, int wr, int wc, int fr, int fq) const {
        const int row0 = u.pm * BM + wr * 64 + fr, colw = wc * 32 + 8 * fq;
        const bool rot = (u.pn >= rot_lo && u.pn < rot_hi);
#pragma unroll
        for (int ai = 0; ai < 2; ++ai)
#pragma unroll
            for (int m = 0; m < 4; ++m) {
                const int row = row0 + ai * HALF + m * 16;
                f32x4 a0 = acc[ai][0][m][0], a1 = acc[ai][0][m][1], b0 = acc[ai][1][m][0], b1 = acc[ai][1][m][1];
                if (rot) {
                    const f32x4* rp = (const f32x4*)(rope + (size_t)((row & 2047) * 128 + colw) * 2);
                    const f32x4 r0 = rp[0], r1 = rp[1], r2 = rp[2], r3 = rp[3];
                    f32x4 x0, x1, y0, y1;
                    x0[0] = a0[0] * r0[0] - b0[0] * r0[1]; y0[0] = a0[0] * r0[1] + b0[0] * r0[0];
                    x0[1] = a0[1] * r0[2] - b0[1] * r0[3]; y0[1] = a0[1] * r0[3] + b0[1] * r0[2];
                    x0[2] = a0[2] * r1[0] - b0[2] * r1[1]; y0[2] = a0[2] * r1[1] + b0[2] * r1[0];
                    x0[3] = a0[3] * r1[2] - b0[3] * r1[3]; y0[3] = a0[3] * r1[3] + b0[3] * r1[2];
                    x1[0] = a1[0] * r2[0] - b1[0] * r2[1]; y1[0] = a1[0] * r2[1] + b1[0] * r2[0];
                    x1[1] = a1[1] * r2[2] - b1[1] * r2[3]; y1[1] = a1[1] * r2[3] + b1[1] * r2[2];
                    x1[2] = a1[2] * r3[0] - b1[2] * r3[1]; y1[2] = a1[2] * r3[1] + b1[2] * r3[0];
                    x1[3] = a1[3] * r3[2] - b1[3] * r3[3]; y1[3] = a1[3] * r3[3] + b1[3] * r3[2];
                    a0 = x0; a1 = x1; b0 = y0; b1 = y1;
                }
                bf16_t* rowp = O + (size_t)row * ldc + u.pn * BM + colw;
                u32x4 w; w.x = cvt_pk_bf16(a0[0], a0[1]); w.y = cvt_pk_bf16(a0[2], a0[3]); w.z = cvt_pk_bf16(a1[0], a1[1]); w.w = cvt_pk_bf16(a1[2], a1[3]);
                *(u32x4*)(rowp) = w;
                w.x = cvt_pk_bf16(b0[0], b0[1]); w.y = cvt_pk_bf16(b0[2], b0[3]); w.z = cvt_pk_bf16(b1[0], b1[1]); w.w = cvt_pk_bf16(b1[2], b1[3]);
                *(u32x4*)(rowp + HALF) = w;
            }
    }
};
struct EpiResF32 {
    static constexpr bool PERM = false, AFTER_DRAIN = false;
    float* Y; const float* X; int ldc; float alpha;
    __device__ __forceinline__ void operator()(const f32x4 (&acc)[2][2][4][2], const Unit& u, int wr, int wc, int fr, int fq) const {
        const int row0 = u.pm * BM + wr * 64 + fr, col0 = u.pn * BM + wc * 32 + 4 * fq;
#pragma unroll
        for (int ai = 0; ai < 2; ++ai)
#pragma unroll
            for (int m = 0; m < 4; ++m) { const size_t off = (size_t)(row0 + ai * HALF + m * 16) * ldc + col0;
#pragma unroll
                for (int bj = 0; bj < 2; ++bj)
#pragma unroll
                    for (int n = 0; n < 2; ++n) { const size_t o2 = off + bj * HALF + n * 16; const f32x4 xv = *(const f32x4*)(X + o2); *(f32x4*)(Y + o2) = xv * alpha + acc[ai][bj][m][n]; } }
    }
};

struct EpiResStats {
    static constexpr bool PERM = false, AFTER_DRAIN = false;
    bf16_t* Yb; const bf16_t* Xb; float* pstat; int ldc; float alpha;
    __device__ __forceinline__ void operator()(const f32x4 (&acc)[2][2][4][2], const Unit& u, int wr, int wc, int fr, int fq) const {
        typedef unsigned u32x2 __attribute__((ext_vector_type(2))); typedef float f32x2v __attribute__((ext_vector_type(2)));
        const int row0 = u.pm * BM + wr * 64 + fr, col0 = u.pn * BM + wc * 32 + 4 * fq;
#pragma unroll
        for (int ai = 0; ai < 2; ++ai)
#pragma unroll
            for (int m = 0; m < 4; ++m) { const int row = row0 + ai * HALF + m * 16; const size_t off = (size_t)row * ldc + col0; float s = 0.f, q = 0.f;
#pragma unroll
                for (int bj = 0; bj < 2; ++bj)
#pragma unroll
                    for (int n = 0; n < 2; ++n) { const size_t o2 = off + bj * HALF + n * 16; const u32x2 xw = *(const u32x2*)(Xb + o2);
                        const f32x4 xv = {__uint_as_float(xw.x << 16), __uint_as_float(xw.x & 0xffff0000u), __uint_as_float(xw.y << 16), __uint_as_float(xw.y & 0xffff0000u)};
                        const f32x4 y = xv * alpha + acc[ai][bj][m][n];
                        u32x2 w; w.x = cvt_pk_bf16(y[0], y[1]); w.y = cvt_pk_bf16(y[2], y[3]); *(u32x2*)(Yb + o2) = w;
                        const float y0 = __uint_as_float(w.x << 16), y1 = __uint_as_float(w.x & 0xffff0000u), y2 = __uint_as_float(w.y << 16), y3 = __uint_as_float(w.y & 0xffff0000u);
                        s += (y0 + y1) + (y2 + y3); q += (y0 * y0 + y1 * y1) + (y2 * y2 + y3 * y3); }
                { auto a_ = __builtin_amdgcn_permlane16_swap(__float_as_uint(s), __float_as_uint(s), false, false); s = __uint_as_float(a_[0]) + __uint_as_float(a_[1]);
                  auto b_ = __builtin_amdgcn_permlane32_swap(__float_as_uint(s), __float_as_uint(s), false, false); s = __uint_as_float(b_[0]) + __uint_as_float(b_[1]);
                  auto c_ = __builtin_amdgcn_permlane16_swap(__float_as_uint(q), __float_as_uint(q), false, false); q = __uint_as_float(c_[0]) + __uint_as_float(c_[1]);
                  auto d_ = __builtin_amdgcn_permlane32_swap(__float_as_uint(q), __float_as_uint(q), false, false); q = __uint_as_float(d_[0]) + __uint_as_float(d_[1]); }
                if (fq == 0) *(f32x2v*)(pstat + ((size_t)row * 32 + u.pn * 4 + wc) * 2) = (f32x2v){s, q}; }
    }
};
struct EpiLnBf16 {
    static constexpr bool PERM = true, AFTER_DRAIN = false;
    bf16_t* O; int ldc; const float* c1; const float* c0; const PG8_LAS float* stat; int pm0;
    const float* pstat; float eps; int ncols;
    __device__ __forceinline__ void operator()(const f32x4 (&acc)[2][2][4][2], const Unit& u, int wr, int wc, int fr, int fq) const {
        const int rl0 = wr * 64 + fr, colw = u.pn * BM + wc * 32 + 8 * fq;
        f32x4 k1[2][2], k0[2][2];
#pragma unroll
        for (int bj = 0; bj < 2; ++bj)
#pragma unroll
            for (int n = 0; n < 2; ++n) { k1[bj][n] = *(const f32x4*)(c1 + colw + bj * HALF + 4 * n); k0[bj][n] = *(const f32x4*)(c0 + colw + bj * HALF + 4 * n); }
#pragma unroll
        for (int ai = 0; ai < 2; ++ai)
#pragma unroll
            for (int m = 0; m < 4; ++m) { const int rl = rl0 + ai * HALF + m * 16, row = u.pm * BM + rl;
                float mu, rs;
                if (u.pm == pm0) { mu = stat[2 * rl]; rs = stat[2 * rl + 1]; }
                else { float s = 0.f, q = 0.f; for (int i = 0; i < 32; ++i) { s += pstat[((size_t)row * 32 + i) * 2]; q += pstat[((size_t)row * 32 + i) * 2 + 1]; }
                    mu = s / (float)ncols; rs = 1.0f / sqrtf(q / (float)ncols - mu * mu + eps); }
                bf16_t* rowp = O + (size_t)row * ldc + colw;
#pragma unroll
                for (int bj = 0; bj < 2; ++bj) { const f32x4 a = (acc[ai][bj][m][0] - k1[bj][0] * mu) * rs + k0[bj][0], b = (acc[ai][bj][m][1] - k1[bj][1] * mu) * rs + k0[bj][1];
                    u32x4 w; w.x = cvt_pk_bf16(a[0], a[1]); w.y = cvt_pk_bf16(a[2], a[3]); w.z = cvt_pk_bf16(b[0], b[1]); w.w = cvt_pk_bf16(b[2], b[3]);
                    *(u32x4*)(rowp + bj * HALF) = w; } }
    }
};
template <class Epi, class Sched, bool ALIGN_EPI = false, bool SP2 = false>
__device__ __forceinline__ void gemm_phase(PG8_LAS unsigned char* lds, const Gemm g, const Sched& S, const Epi& E) {
    const int tid = threadIdx.x, wid = __builtin_amdgcn_readfirstlane(tid >> 6), lane = tid & 63, wr = wid >> 2, wc = wid & 3, fr = lane & 15, fq = lane >> 4;
    const int K = g.K, nt = K / BK;
    unsigned voffA[2], voffB[2];
#pragma unroll
    for (int i = 0; i < 2; ++i) { int R, C; stage_rc(tid * 16 + i * 8192, R, C); const int Rb = Epi::PERM ? ((R & ~31) + perm32(R & 31)) : R;
        voffA[i] = (unsigned)(R * K + C) * 2u; voffB[i] = (unsigned)(Rb * K + C) * 2u; }
    const size_t kstep = (size_t)(BK * 2);
    const size_t hstep = (size_t)HALF * K * 2;
    const size_t tstep = 2 * hstep;
    const unsigned ldsw = (unsigned)wid * 1024u;
    const int aoff = lds_byte(wr * 64 + fr, fq * 8), boff = lds_byte(wc * 32 + fr, fq * 8);
#define PG8_SA(b, h) (((b) * 2 + (h)) * HTB)
#define PG8_SB(b, h) ((4 + (b) * 2 + (h)) * HTB)
#define PG8_STAGE(bufoff, gbase, voff) do { _Pragma("unroll") for (int _i = 0; _i < 2; ++_i) \
        __builtin_amdgcn_global_load_lds((const unsigned*)((const char*)(gbase) + (voff)[_i]), (PG8_LAS unsigned*)(lds + (bufoff) + ldsw + _i * 8192), 16, 0, 0); } while (0)
#define PG8_LDA(dst, b, h) do { _Pragma("unroll") for (int m = 0; m < 4; ++m) _Pragma("unroll") for (int k = 0; k < 2; ++k) dst[m][k] = *(const PG8_LAS bf16x8*)(lds + PG8_SA(b, h) + aoff + m * 2048 + k * 1024); } while (0)
#define PG8_LDB(dst, b, h) do { _Pragma("unroll") for (int n = 0; n < 2; ++n) _Pragma("unroll") for (int k = 0; k < 2; ++k) dst[n][k] = *(const PG8_LAS bf16x8*)(lds + PG8_SB(b, h) + boff + n * 2048 + k * 1024); } while (0)
#define PG8_MMA(ai, bj, At, Bt) do { __builtin_amdgcn_s_setprio(1); _Pragma("unroll") for (int m = 0; m < 4; ++m) _Pragma("unroll") for (int n = 0; n < 2; ++n) _Pragma("unroll") for (int k = 0; k < 2; ++k) \
        acc[ai][bj][m][n] = __builtin_amdgcn_mfma_f32_16x16x32_bf16(Bt[n][k], At[m][k], acc[ai][bj][m][n], 0, 0, 0); __builtin_amdgcn_s_setprio(0); } while (0)
#define PG8_WAIT_V(n) asm volatile("s_waitcnt vmcnt(" #n ")" ::: "memory")
#define PG8_WAIT_L(n) asm volatile("s_waitcnt lgkmcnt(" #n ")" ::: "memory")
#define PG8_BAR __builtin_amdgcn_s_barrier()
#define PG8_SCHED __builtin_amdgcn_sched_barrier(0)
    Unit cur, nxt; int ui = 0;
    if (!S.next(0, cur)) return;
    f32x4 acc[2][2][4][2];
#pragma unroll
    for (int a = 0; a < 2; ++a)
#pragma unroll
        for (int b = 0; b < 2; ++b)
#pragma unroll
            for (int m = 0; m < 4; ++m)
#pragma unroll
                for (int n = 0; n < 2; ++n) acc[a][b][m][n] = (f32x4){0.f, 0.f, 0.f, 0.f};
    bf16x8 At[4][2], B0[2][2], B1[2][2];
    const char* cA = (const char*)g.A + (size_t)cur.pm * tstep; const char* cB = (const char*)g.Bt + (size_t)cur.pn * tstep;
    S.a_ready(cur);
    if constexpr (SP2) {
        PG8_STAGE(PG8_SB(0, 0), cB, voffB); PG8_STAGE(PG8_SB(0, 1), cB + hstep, voffB); PG8_STAGE(PG8_SA(0, 0), cA, voffA); PG8_STAGE(PG8_SA(0, 1), cA + hstep, voffA);
        if (wr == 1) PG8_BAR;
        PG8_WAIT_V(2); PG8_BAR;
        PG8_STAGE(PG8_SB(1, 0), cB + kstep, voffB); PG8_STAGE(PG8_SA(1, 0), cA + kstep, voffA); PG8_STAGE(PG8_SB(1, 1), cB + hstep + kstep, voffB);
        PG8_WAIT_V(6); PG8_BAR;
    } else {
        PG8_STAGE(PG8_SB(0, 0), cB, voffB); PG8_STAGE(PG8_SA(0, 0), cA, voffA); PG8_STAGE(PG8_SB(0, 1), cB + hstep, voffB); PG8_STAGE(PG8_SA(0, 1), cA + hstep, voffA);
        if (wr == 1) PG8_BAR;
        PG8_WAIT_V(4); PG8_BAR;
        PG8_STAGE(PG8_SB(1, 0), cB + kstep, voffB); PG8_STAGE(PG8_SA(1, 0), cA + kstep, voffA); PG8_STAGE(PG8_SB(1, 1), cB + hstep + kstep, voffB);
        PG8_WAIT_V(6); PG8_BAR;
    }
    for (;;) {
        const bool has_next = S.next(ui + 1, nxt);
        const char* nA = has_next ? (const char*)g.A + (size_t)nxt.pm * tstep : cA; const char* nB = has_next ? (const char*)g.Bt + (size_t)nxt.pn * tstep : cB;
        for (int t = 0; t < nt; t += 2) {
            const bool last = (t == nt - 2);
            const char* a1 = cA + (size_t)(t + 1) * kstep;
            const char* a2 = last ? nA : cA + (size_t)(t + 2) * kstep; const char* b2 = last ? nB : cB + (size_t)(t + 2) * kstep;
            const char* a3 = a2 + kstep; const char* b3 = b2 + kstep;
            if (last && has_next) S.a_ready(nxt);
            if constexpr (SP2) {
            PG8_LDB(B0, 0, 0); PG8_LDB(B1, 0, 1); PG8_SCHED; PG8_LDA(At, 0, 0); PG8_STAGE(PG8_SA(1, 1), a1 + hstep, voffA);
            PG8_WAIT_V(8); PG8_WAIT_L(0); PG8_BAR; PG8_MMA(0, 0, At, B0); PG8_MMA(0, 1, At, B1); PG8_BAR; PG8_SCHED;
            PG8_LDA(At, 0, 1); PG8_STAGE(PG8_SB(0, 0), b2, voffB); PG8_STAGE(PG8_SB(0, 1), b2 + hstep, voffB); PG8_STAGE(PG8_SA(0, 0), a2, voffA);
            PG8_WAIT_V(8); PG8_WAIT_L(0); PG8_BAR; PG8_MMA(1, 0, At, B0); PG8_MMA(1, 1, At, B1); PG8_BAR; PG8_SCHED;
            PG8_LDB(B0, 1, 0); PG8_LDB(B1, 1, 1); PG8_SCHED; PG8_LDA(At, 1, 0); PG8_STAGE(PG8_SA(0, 1), a2 + hstep, voffA);
            PG8_WAIT_V(8); PG8_WAIT_L(0); PG8_BAR; PG8_MMA(0, 0, At, B0); PG8_MMA(0, 1, At, B1); PG8_BAR; PG8_SCHED;
            PG8_LDA(At, 1, 1); PG8_STAGE(PG8_SB(1, 0), b3, voffB); PG8_STAGE(PG8_SB(1, 1), b3 + hstep, voffB); PG8_STAGE(PG8_SA(1, 0), a3, voffA);
            PG8_WAIT_V(8); PG8_WAIT_L(0); PG8_BAR; PG8_MMA(1, 0, At, B0); PG8_MMA(1, 1, At, B1); PG8_BAR; PG8_SCHED;
            } else {
            PG8_LDB(B0, 0, 0); PG8_SCHED; PG8_LDA(At, 0, 0); PG8_STAGE(PG8_SA(1, 1), a1 + hstep, voffA);
            PG8_WAIT_L(8); PG8_BAR; PG8_WAIT_L(0); PG8_MMA(0, 0, At, B0); PG8_BAR; PG8_SCHED;
            PG8_LDB(B1, 0, 1); PG8_STAGE(PG8_SB(0, 0), b2, voffB);
            PG8_BAR; PG8_WAIT_L(0); PG8_MMA(0, 1, At, B1); PG8_BAR;
            PG8_LDA(At, 0, 1); PG8_STAGE(PG8_SA(0, 0), a2, voffA);
            PG8_BAR; PG8_WAIT_L(0); PG8_MMA(1, 0, At, B0); PG8_BAR; PG8_SCHED;
            PG8_STAGE(PG8_SB(0, 1), b2 + hstep, voffB);
            PG8_WAIT_V(6); PG8_BAR; PG8_MMA(1, 1, At, B1); PG8_BAR;
            PG8_LDB(B0, 1, 0); PG8_SCHED; PG8_LDA(At, 1, 0); PG8_STAGE(PG8_SA(0, 1), a2 + hstep, voffA);
            PG8_WAIT_L(8); PG8_BAR; PG8_WAIT_L(0); PG8_MMA(0, 0, At, B0); PG8_BAR; PG8_SCHED;
            PG8_LDB(B1, 1, 1); PG8_STAGE(PG8_SB(1, 0), b3, voffB);
            PG8_BAR; PG8_WAIT_L(0); PG8_MMA(0, 1, At, B1); PG8_BAR;
            PG8_LDA(At, 1, 1); PG8_STAGE(PG8_SA(1, 0), a3, voffA);
            PG8_BAR; PG8_WAIT_L(0); PG8_MMA(1, 0, At, B0); PG8_BAR; PG8_SCHED;
            PG8_STAGE(PG8_SB(1, 1), b3 + hstep, voffB);
            PG8_WAIT_V(6); PG8_BAR; PG8_MMA(1, 1, At, B1); PG8_BAR;
            }
        }
        if constexpr (ALIGN_EPI) { if (wr == 0) PG8_BAR; }
        if constexpr (!Epi::AFTER_DRAIN) { E(acc, cur, wr, wc, fr, fq); S.done(cur); }
        if (!has_next) break;
#pragma unroll
        for (int a = 0; a < 2; ++a)
#pragma unroll
            for (int b = 0; b < 2; ++b)
#pragma unroll
                for (int m = 0; m < 4; ++m)
#pragma unroll
                    for (int n = 0; n < 2; ++n) acc[a][b][m][n] = (f32x4){0.f, 0.f, 0.f, 0.f};
        cur = nxt; cA = nA; cB = nB; ++ui;
        if constexpr (ALIGN_EPI) { if (wr == 1) PG8_BAR; }
    }
    PG8_WAIT_V(0);
    if constexpr (!ALIGN_EPI) { if (wr == 0) PG8_BAR; }
    PG8_BAR;
    if constexpr (Epi::AFTER_DRAIN) { E.fused(acc, cur, wr, wc, fr, fq, lds, wid, lane); S.done(cur); }
#undef PG8_SA
#undef PG8_SB
#undef PG8_STAGE
#undef PG8_LDA
#undef PG8_LDB
#undef PG8_MMA
#undef PG8_WAIT_V
#undef PG8_WAIT_L
#undef PG8_BAR
#undef PG8_SCHED
}
}
typedef unsigned short bf16_t;
constexpr int D = 2048, BATCH = 4, SEQ = 2048, T = BATCH * SEQ;
constexpr int NPROJ = 7184, NP = 7424;
constexpr int C_GQ = 0, C_GK = 512, C_GV = 1024, C_GR = 2048, C_RQ = 3072, C_RK = 4096, C_RV = 5120, C_RR = 6144, C_GLR = 7168;
constexpr int NCH = 32, CH = 64;
constexpr float ALPHA = 1.189207115002721f;
constexpr float LN_EPS = 1e-5f;
constexpr size_t MiB = 1u << 20;
constexpr size_t WS_CTL = 0, CTL_ZERO_BYTES = 65536, WS_WIN = 1 * MiB, WS_WOUT = 31 * MiB, WS_WQ = 39 * MiB, WS_SKB = 47 * MiB, WS_ROPE = 48 * MiB,
                 WS_UB = 50 * MiB, WS_VB = 114 * MiB, WS_XB = 178 * MiB, WS_PROJ = 210 * MiB, WS_BC = 326 * MiB, WS_UT = 342 * MiB,
                 WS_O = 438 * MiB, WS_END = 475 * MiB;
constexpr size_t WS_Y = 210 * MiB, WS_H1B = 274 * MiB, WS_EXP = 306 * MiB, WS_GATE = 310 * MiB;
constexpr size_t WS_Q = 442 * MiB;
constexpr size_t WS_USC = 47 * MiB + 512 * 1024, WS_VSC = WS_USC + 65536;
constexpr size_t WS_PSTAT = 314 * MiB;
constexpr size_t WS_PD = 342 * MiB, WS_W = 374 * MiB, WS_FFN = 378 * MiB, WS_MURS = 316 * MiB;
constexpr size_t WS_US1 = 47 * MiB + 768 * 1024, WS_US0 = WS_US1 + 65536;
constexpr size_t WS_CPART = 474 * MiB, WS_CFIN = WS_CPART + 512 * 1024;
constexpr size_t UT_RET_OFF = (size_t)16 * 32 * 256 * 128;
constexpr int CW_BAR = 4096;
constexpr int NWAVES = 8;
constexpr int RING_BYTES = 131072, LDSCTL_OFF = RING_BYTES, MISC_OFF = LDSCTL_OFF + 320, LDS_BYTES = 147456;

#define GAS __attribute__((address_space(1)))
#define LAS __attribute__((address_space(3)))
typedef unsigned v4u __attribute__((ext_vector_type(4)));
typedef unsigned v2u __attribute__((ext_vector_type(2)));
typedef float f32x4 __attribute__((ext_vector_type(4)));
typedef float f32x16 __attribute__((ext_vector_type(16)));
typedef short bf16x8 __attribute__((ext_vector_type(8)));
typedef short bf16x4 __attribute__((ext_vector_type(4)));
typedef GAS unsigned gu32;
#define RLX_AGENT __ATOMIC_RELAXED, __HIP_MEMORY_SCOPE_AGENT
#define LDS_WAIT() asm volatile("s_waitcnt lgkmcnt(0)" ::: "memory")
#define VM_WAIT() asm volatile("s_waitcnt vmcnt(0)" ::: "memory")
__device__ __forceinline__ float bf2f(bf16_t v) { return __uint_as_float(((unsigned)v) << 16); }
__device__ __forceinline__ unsigned f2bfu(float f) { unsigned u = __float_as_uint(f); return (u + 0x7fffu + ((u >> 16) & 1u)) >> 16; }
__device__ __forceinline__ bf16_t f2bf(float f) { return (bf16_t)f2bfu(f); }
__device__ __forceinline__ unsigned pk2(float lo, float hi) { return f2bfu(lo) | (f2bfu(hi) << 16); }
__device__ __forceinline__ float bflo(unsigned w) { return __uint_as_float(w << 16); }
__device__ __forceinline__ float bfhi(unsigned w) { return __uint_as_float(w & 0xffff0000u); }
__device__ __forceinline__ float wave_sum(float v) {
#pragma unroll
    for (int o = 1; o < 64; o <<= 1) v += __shfl_xor(v, o);
    return v;
}
__device__ __forceinline__ float gamma_log(int h) { return logf(1.0f - exp2f(-5.0f - (float)h)); }

#define XB_TMO      128
#define XB_XCNT(j)  (256  + 64 * (j))
#define XB_XSUB(j)  (1280 + 64 * (j))
#define XB_XGEN(j)  (2304 + 64 * (j))
#define XB_TOP      3328
#define XB_TOPGEN   3392
#define XCD_BAR_WORDS 3456
#define XB_SPIN_CAP (1u << 18)

__device__ __forceinline__ unsigned xb_ld(unsigned* p)              { return __hip_atomic_load(p, __ATOMIC_RELAXED, __HIP_MEMORY_SCOPE_AGENT); }
__device__ __forceinline__ unsigned xb_add(unsigned* p, unsigned v) { return __hip_atomic_fetch_add(p, v, __ATOMIC_RELAXED, __HIP_MEMORY_SCOPE_AGENT); }
__device__ __forceinline__ unsigned xb_xcc_id() { return (unsigned)__builtin_amdgcn_s_getreg((3 << 11) | 20) & 0xFu; }
#define XB_SPIN(cond, bar) do { unsigned _sp = 0; while (cond) { __builtin_amdgcn_s_sleep(1); \
    if ((++_sp & 255u) == 0u) { if (xb_ld(&(bar)[XB_TMO])) break; if (_sp > XB_SPIN_CAP) { atomicAdd(&(bar)[XB_TMO], 1u); break; } } } } while (0)

struct XcdBarrier {
    unsigned* bar; unsigned x;
    volatile LAS unsigned* st;
};

__device__ __forceinline__ XcdBarrier xcd_barrier_post(unsigned* bar, volatile LAS unsigned* st) {
    XcdBarrier b; b.bar = bar; b.x = xb_xcc_id(); b.st = st;
    if (threadIdx.x == 0) (void)xb_add(&bar[XB_XCNT(b.x)], 1u);
    return b;
}
__device__ __forceinline__ void xcd_barrier_complete(unsigned* bar, unsigned x, unsigned& nloc, unsigned& nx) {
    const unsigned G = gridDim.x * gridDim.y * gridDim.z;
    unsigned sum, cnt, mine, sp = 0u;
    for (;;) {
        sum = 0u; cnt = 0u; mine = 0u;
#pragma unroll
        for (unsigned j = 0; j < 16; ++j) { const unsigned c = xb_ld(&bar[XB_XCNT(j)]); sum += c; cnt += (c > 0u) ? 1u : 0u; mine = (j == x) ? c : mine; }
        if (sum == G) break;
        __builtin_amdgcn_s_sleep(1);
        if ((++sp & 255u) == 0u) { if (xb_ld(&bar[XB_TMO])) break; if (sp > XB_SPIN_CAP) { atomicAdd(&bar[XB_TMO], 1u); break; } }
    }
    nloc = mine > 0u ? mine : 1u; nx = cnt > 0u ? cnt : 1u;
}

__device__ __forceinline__ void xcd_barrier(const XcdBarrier& b) {
    asm volatile("s_waitcnt vmcnt(0)" ::: "memory");
    __syncthreads();
    if (threadIdx.x == 0) {
        unsigned* bar = b.bar;
        __builtin_amdgcn_s_waitcnt(0);
        unsigned nloc = b.st[0], nx = b.st[1];
        if (nloc == 0u) { xcd_barrier_complete(bar, b.x, nloc, nx); b.st[0] = nloc; b.st[1] = nx; }
        const unsigned old = xb_add(&bar[XB_XSUB(b.x)], 1u);
        const unsigned gen = old / nloc;
        if (old + 1u == (gen + 1u) * nloc) {
            __builtin_amdgcn_fence(__ATOMIC_RELEASE, "agent");
            asm volatile("s_waitcnt vmcnt(0)" ::: "memory");
            const unsigned og = xb_add(&bar[XB_TOP], 1u);
            const unsigned tg = og / nx;
            if (og + 1u == (tg + 1u) * nx) xb_add(&bar[XB_TOPGEN], 1u);
            else XB_SPIN(xb_ld(&bar[XB_TOPGEN]) == tg, bar);
            __builtin_amdgcn_fence(__ATOMIC_ACQUIRE, "agent");
            xb_add(&bar[XB_XGEN(b.x)], 1u);
            asm volatile("s_waitcnt vmcnt(0)" ::: "memory");
        } else {
            XB_SPIN(xb_ld(&bar[XB_XGEN(b.x)]) == gen, bar);
            __builtin_amdgcn_fence(__ATOMIC_ACQUIRE, "agent");
            asm volatile("s_waitcnt vmcnt(0)" ::: "memory");
        }
    }
    __syncthreads();
}
struct Frame {
    LAS unsigned char* lds;
    int tid, lane, wave, vcu, G;
};
struct Args { const float* in[15]; float* out; unsigned char* ws; int ph_lo, ph_hi, li, pad; };

template <int CTRL> __device__ __forceinline__ float dppf(float x) { return __builtin_bit_cast(float, __builtin_amdgcn_mov_dpp(__builtin_bit_cast(int, x), CTRL, 0xf, 0xf, true)); }
__device__ __forceinline__ float wave_sum_dpp(float x) {
    x += dppf<0xB1>(x); x += dppf<0x4E>(x); x += dppf<0x141>(x); x += dppf<0x128>(x);
    auto s = __builtin_amdgcn_permlane16_swap(__float_as_uint(x), __float_as_uint(x), false, false);
    x = __uint_as_float(s[0]) + __uint_as_float(s[1]);
    auto t = __builtin_amdgcn_permlane32_swap(__float_as_uint(x), __float_as_uint(x), false, false);
    return __uint_as_float(t[0]) + __uint_as_float(t[1]);
}
__device__ __forceinline__ float wave_max_dpp(float x) {
    x = fmaxf(x, dppf<0xB1>(x)); x = fmaxf(x, dppf<0x4E>(x)); x = fmaxf(x, dppf<0x141>(x)); x = fmaxf(x, dppf<0x128>(x));
    auto s = __builtin_amdgcn_permlane16_swap(__float_as_uint(x), __float_as_uint(x), false, false);
    x = fmaxf(__uint_as_float(s[0]), __uint_as_float(s[1]));
    auto t = __builtin_amdgcn_permlane32_swap(__float_as_uint(x), __float_as_uint(x), false, false);
    return fmaxf(__uint_as_float(t[0]), __uint_as_float(t[1]));
}

__device__ __forceinline__ unsigned lds_addr(const LAS unsigned char* p) { return (unsigned)(unsigned long)p; }
__device__ __forceinline__ unsigned tr_lane_off(int lane, int S) { const int h = lane >> 5, blk = (lane >> 4) & 1, q = (lane & 15) >> 2, p = lane & 3; return (unsigned)((8 * h + q) * S + 32 * blk + 8 * p); }
template <int OFF0, int OFF1> __device__ __forceinline__ bf16x8 tr_frag(unsigned base) {
    bf16x4 lo, hi;
    asm volatile("ds_read_b64_tr_b16 %0, %2 offset:%3\n\tds_read_b64_tr_b16 %1, %2 offset:%4\n\ts_waitcnt lgkmcnt(0)" : "=&v"(lo), "=&v"(hi) : "v"(base), "i"(OFF0), "i"(OFF1) : "memory");
    return __builtin_shufflevector(lo, hi, 0, 1, 2, 3, 4, 5, 6, 7);
}
__device__ __forceinline__ bf16x8 row_frag(const LAS unsigned char* tile, int S, int row0, int s, int lane) {
    return *(const LAS bf16x8*)(tile + (row0 + (lane & 31)) * S + 32 * s + 16 * (lane >> 5));
}
template <int W, int S> __device__ __forceinline__ void stage_tile(LAS unsigned char* dst, const bf16_t* src, int tid) {
    constexpr int PPR = W / 8;
#pragma unroll
    for (int i = 0; i < 64 * PPR / 512; ++i) { const int pi = tid + 512 * i, r = pi / PPR, c = pi % PPR;
        const v4u v = *(const GAS v4u*)(src + (size_t)r * NP + c * 8); *(LAS v4u*)(dst + r * S + c * 16) = v; }
}
__device__ __forceinline__ void unit_head(int item, int& bchunk, int& head) { bchunk = item >> 3; head = ((item & 7) + 4 * ((item >> 8) & 1)) & 7; }
constexpr int SV = 576, SK128 = 320, SQ128 = 272, SQ256 = 528, SP = 144, SO = 1040;

constexpr int P2_V = 0, P2_K = 36864, P2_SB = 73728, P2_GLR = 106496, P2_GTOT = 110592;
__device__ __forceinline__ void chunk_u_phase(const Frame& F, const bf16_t* PROJ, const float* wg, const float* bg, float* BC, bf16_t* UT) {
    const int tid = F.tid, lane = F.lane, w = F.wave;
    LAS unsigned char* L = F.lds;
    for (int item = F.vcu; item < BATCH * NCH * 8; item += F.G) {
        int bchunk, head; unit_head(item, bchunk, head);
        const int b = bchunk / NCH, ch = bchunk % NCH, t0 = b * SEQ + ch * CH;
        const bf16_t* prow = PROJ + (size_t)t0 * NP;
        if (head < 4) {
            const int h = head;
            stage_tile<256, SV>(L + P2_V, prow + C_GV + h * 256, tid);
            for (int i = tid; i < 64 * 16; i += 512) ((LAS float*)(L + P2_GLR))[i] = bf2f(prow[(size_t)(i >> 4) * NP + C_GLR + (i & 15)]);
            const int d = tid & 127, cg = tid >> 7;
            float wc[16];
#pragma unroll
            for (int r = 0; r < 16; ++r) wc[r] = wg[r * 512 + h * 128 + d];
            const float bias = bg[h * 128 + d];
            __syncthreads();
            float run = 0.f;
            LAS float* sb = (LAS float*)(L + P2_SB);
#pragma unroll 4
            for (int cc = 0; cc < 16; ++cc) { const int c = cg * 16 + cc; const LAS f32x4* gp = (const LAS f32x4*)(L + P2_GLR + c * 64);
                float z = bias;
#pragma unroll
                for (int r4 = 0; r4 < 4; ++r4) { const f32x4 gv = gp[r4]; z = fmaf(gv[0], wc[4 * r4], z); z = fmaf(gv[1], wc[4 * r4 + 1], z); z = fmaf(gv[2], wc[4 * r4 + 2], z); z = fmaf(gv[3], wc[4 * r4 + 3], z); }
                const float ls = fminf(z, 0.f) - __logf(1.0f + __expf(-fabsf(z)));
                run += ls * (1.0f / 16.0f); sb[c * 128 + d] = run; }
            ((LAS float*)(L + P2_GTOT))[cg * 128 + d] = run;
            __syncthreads();
            float off = 0.f;
#pragma unroll
            for (int g = 0; g < 3; ++g) off += (g < cg) ? ((LAS float*)(L + P2_GTOT))[g * 128 + d] : 0.f;
#pragma unroll 4
            for (int cc = 0; cc < 16; ++cc) { const int c = cg * 16 + cc; const float v = sb[c * 128 + d] + off; sb[c * 128 + d] = v; BC[(size_t)(t0 + c) * 512 + h * 128 + d] = v; }
            __syncthreads();
#pragma unroll
            for (int i = 0; i < 2; ++i) { const int pi = tid + 512 * i, c = pi >> 4, d0 = (pi & 15) * 8;
                const v4u kv = *(const GAS v4u*)(prow + (size_t)c * NP + C_GK + h * 128 + d0);
                const f32x4 b0 = *(const LAS f32x4*)(sb + c * 128 + d0), b1 = *(const LAS f32x4*)(sb + c * 128 + d0 + 4);
                const f32x4 l0 = *(const LAS f32x4*)(sb + 63 * 128 + d0), l1 = *(const LAS f32x4*)(sb + 63 * 128 + d0 + 4);
                v4u o;
                o.x = pk2(bflo(kv.x) * __expf(l0[0] - b0[0]), bfhi(kv.x) * __expf(l0[1] - b0[1])); o.y = pk2(bflo(kv.y) * __expf(l0[2] - b0[2]), bfhi(kv.y) * __expf(l0[3] - b0[3]));
                o.z = pk2(bflo(kv.z) * __expf(l1[0] - b1[0]), bfhi(kv.z) * __expf(l1[1] - b1[1])); o.w = pk2(bflo(kv.w) * __expf(l1[2] - b1[2]), bfhi(kv.w) * __expf(l1[3] - b1[3]));
                *(LAS v4u*)(L + P2_K + c * SK128 + d0 * 2) = o; }
            __syncthreads();
            f32x16 acc[4];
#pragma unroll
            for (int i = 0; i < 4; ++i)
#pragma unroll
                for (int r = 0; r < 16; ++r) acc[i][r] = 0.f;
            const unsigned vb = lds_addr(L + P2_V) + tr_lane_off(lane, SV) + 64 * w, kb = lds_addr(L + P2_K) + tr_lane_off(lane, SK128);
#define P2G_STEP(ks) { const bf16x8 a = tr_frag<16 * (ks) * SV, 16 * (ks) * SV + 4 * SV>(vb); \
                acc[0] = __builtin_amdgcn_mfma_f32_32x32x16_bf16(a, tr_frag<16 * (ks) * SK128 + 0, 16 * (ks) * SK128 + 0 + 4 * SK128>(kb), acc[0], 0, 0, 0); \
                acc[1] = __builtin_amdgcn_mfma_f32_32x32x16_bf16(a, tr_frag<16 * (ks) * SK128 + 64, 16 * (ks) * SK128 + 64 + 4 * SK128>(kb), acc[1], 0, 0, 0); \
                acc[2] = __builtin_amdgcn_mfma_f32_32x32x16_bf16(a, tr_frag<16 * (ks) * SK128 + 128, 16 * (ks) * SK128 + 128 + 4 * SK128>(kb), acc[2], 0, 0, 0); \
                acc[3] = __builtin_amdgcn_mfma_f32_32x32x16_bf16(a, tr_frag<16 * (ks) * SK128 + 192, 16 * (ks) * SK128 + 192 + 4 * SK128>(kb), acc[3], 0, 0, 0); }
            P2G_STEP(0) P2G_STEP(1) P2G_STEP(2) P2G_STEP(3)
#undef P2G_STEP
            bf16_t* o = UT + ((size_t)(b * 4 + h) * NCH + ch) * 256 * 128;
#pragma unroll
            for (int rg = 0; rg < 4; ++rg) { bf16_t* pr = o + (size_t)(32 * w + 8 * rg + 4 * (lane >> 5)) * 128 + (lane & 31);
#pragma unroll
                for (int r3 = 0; r3 < 4; ++r3)
#pragma unroll
                    for (int i = 0; i < 4; ++i) pr[r3 * 128 + 32 * i] = (bf16_t)pg8::cvt_pk_bf16(acc[i][rg * 4 + r3], 0.f);
                asm volatile("" ::: "memory"); }
        } else {
            const int h = head - 4; const float lg2 = gamma_log(h) * 1.4426950408889634f;
            stage_tile<256, SV>(L + P2_V, prow + C_RV + h * 256, tid);
#pragma unroll
            for (int i = 0; i < 4; ++i) { const int pi = tid + 512 * i, c = pi >> 5, d0 = (pi & 31) * 8;
                const v4u kv = *(const GAS v4u*)(prow + (size_t)c * NP + C_RK + h * 256 + d0);
                const float sc = exp2f(lg2 * (float)(63 - c));
                v4u o; o.x = pk2(bflo(kv.x) * sc, bfhi(kv.x) * sc); o.y = pk2(bflo(kv.y) * sc, bfhi(kv.y) * sc); o.z = pk2(bflo(kv.z) * sc, bfhi(kv.z) * sc); o.w = pk2(bflo(kv.w) * sc, bfhi(kv.w) * sc);
                *(LAS v4u*)(L + P2_K + c * SV + d0 * 2) = o; }
            __syncthreads();
            f32x16 acc[8];
#pragma unroll
            for (int i = 0; i < 8; ++i)
#pragma unroll
                for (int r = 0; r < 16; ++r) acc[i][r] = 0.f;
            const unsigned vb = lds_addr(L + P2_V) + tr_lane_off(lane, SV) + 64 * w, kb = lds_addr(L + P2_K) + tr_lane_off(lane, SV);
#define P2R_MM(ks, dt) acc[dt] = __builtin_amdgcn_mfma_f32_32x32x16_bf16(a, tr_frag<16 * (ks) * SV + 64 * (dt), 16 * (ks) * SV + 64 * (dt) + 4 * SV>(kb), acc[dt], 0, 0, 0);
#define P2R_STEP(ks) { const bf16x8 a = tr_frag<16 * (ks) * SV, 16 * (ks) * SV + 4 * SV>(vb); P2R_MM(ks, 0) P2R_MM(ks, 1) P2R_MM(ks, 2) P2R_MM(ks, 3) P2R_MM(ks, 4) P2R_MM(ks, 5) P2R_MM(ks, 6) P2R_MM(ks, 7) }
            P2R_STEP(0) P2R_STEP(1) P2R_STEP(2) P2R_STEP(3)
#undef P2R_STEP
#undef P2R_MM
            bf16_t* o = UT + UT_RET_OFF + ((size_t)(b * 4 + h) * NCH + ch) * 256 * 256;
#pragma unroll
            for (int rg = 0; rg < 4; ++rg) { bf16_t* pr = o + (size_t)(32 * w + 8 * rg + 4 * (lane >> 5)) * 256 + (lane & 31);
#pragma unroll
                for (int r3 = 0; r3 < 4; ++r3)
#pragma unroll
                    for (int i = 0; i < 8; ++i) pr[r3 * 256 + 32 * i] = (bf16_t)pg8::cvt_pk_bf16(acc[i][rg * 4 + r3], 0.f);
                asm volatile("" ::: "memory"); }
        }
        __syncthreads();
    }
}

constexpr int P4_QP = 0, P4_QM = 17408, P4_KP = 34816, P4_KM = 52224, P4_RQ = 0, P4_RK = 33792, P4_V = 69632, P4_P = 106496, P4_O = 0;
__device__ __forceinline__ void chunk_o_phase(const Frame& F, const bf16_t* PROJ, const float* BC, const bf16_t* ST, const float* gla_g, const float* ret_g, bf16_t* O) {
    const int tid = F.tid, lane = F.lane, w = F.wave, hh = lane >> 5;
    LAS unsigned char* L = F.lds;
    v4u pf[12];
#define P4_PREFETCH(item_) do { int bc_, hd_; unit_head((item_), bc_, hd_); const int t0_ = (bc_ / NCH) * SEQ + (bc_ % NCH) * CH, h_ = hd_ & 3; const bf16_t* pr_ = PROJ + (size_t)t0_ * NP; \
        if (hd_ < 4) { _Pragma("unroll") for (int i_ = 0; i_ < 4; ++i_) { const int pi_ = tid + 512 * i_, r_ = pi_ >> 5, c_ = pi_ & 31; pf[i_] = *(const GAS v4u*)(pr_ + (size_t)r_ * NP + C_GV + h_ * 256 + c_ * 8); } \
            _Pragma("unroll") for (int i_ = 0; i_ < 2; ++i_) { const int pi_ = tid + 512 * i_, c_ = pi_ >> 4, d0_ = (pi_ & 15) * 8; \
                pf[4 + i_] = *(const GAS v4u*)(pr_ + (size_t)c_ * NP + C_GQ + h_ * 128 + d0_); pf[6 + i_] = *(const GAS v4u*)(pr_ + (size_t)c_ * NP + C_GK + h_ * 128 + d0_); \
                const GAS v4u* bp_ = (const GAS v4u*)(BC + (size_t)(t0_ + c_) * 512 + h_ * 128 + d0_); pf[8 + 2 * i_] = bp_[0]; pf[9 + 2 * i_] = bp_[1]; } } \
        else { _Pragma("unroll") for (int i_ = 0; i_ < 4; ++i_) { const int pi_ = tid + 512 * i_, r_ = pi_ >> 5, c_ = pi_ & 31; const bf16_t* p_ = pr_ + (size_t)r_ * NP + h_ * 256 + c_ * 8; \
                pf[i_] = *(const GAS v4u*)(p_ + C_RV); pf[4 + i_] = *(const GAS v4u*)(p_ + C_RQ); pf[8 + i_] = *(const GAS v4u*)(p_ + C_RK); } } } while (0)
    if (F.vcu < BATCH * NCH * 8) P4_PREFETCH(F.vcu);
    for (int item = F.vcu; item < BATCH * NCH * 8; item += F.G) {
        int bchunk, head; unit_head(item, bchunk, head);
        const int b = bchunk / NCH, ch = bchunk % NCH, t0 = b * SEQ + ch * CH;
        const bf16_t* prow = PROJ + (size_t)t0 * NP;
        f32x16 acc[2];
#pragma unroll
        for (int i = 0; i < 2; ++i)
#pragma unroll
            for (int r = 0; r < 16; ++r) acc[i][r] = 0.f;
        const bool gla = head < 4; const int h = head & 3;
        if (gla) {
#pragma unroll
            for (int i = 0; i < 4; ++i) { const int pi = tid + 512 * i, r = pi >> 5, c = pi & 31; *(LAS v4u*)(L + P4_V + r * SV + c * 16) = pf[i]; }
#pragma unroll
            for (int i = 0; i < 2; ++i) { const int pi = tid + 512 * i, c = pi >> 4, d0 = (pi & 15) * 8;
                const v4u qv = pf[4 + i], kv = pf[6 + i];
                const f32x4 b0 = __builtin_bit_cast(f32x4, pf[8 + 2 * i]), b1 = __builtin_bit_cast(f32x4, pf[9 + 2 * i]);
                float eb[8], em[8];
#pragma unroll
                for (int j = 0; j < 4; ++j) { eb[j] = __expf(b0[j]); eb[4 + j] = __expf(b1[j]); em[j] = __expf(-b0[j]); em[4 + j] = __expf(-b1[j]); }
                const unsigned qa[4] = {qv.x, qv.y, qv.z, qv.w}, ka[4] = {kv.x, kv.y, kv.z, kv.w};
                v4u qp, qm, kp, km;
#pragma unroll
                for (int j = 0; j < 4; ++j) { const float q0 = bflo(qa[j]), q1 = bfhi(qa[j]), k0 = bflo(ka[j]), k1 = bfhi(ka[j]);
                    qp[j] = pk2(q0 * eb[2 * j], q1 * eb[2 * j + 1]); qm[j] = pk2(q0 * em[2 * j], q1 * em[2 * j + 1]);
                    kp[j] = pk2(k0 * eb[2 * j], k1 * eb[2 * j + 1]); km[j] = pk2(k0 * em[2 * j], k1 * em[2 * j + 1]); }
                const int lo = c * SQ128 + d0 * 2;
                *(LAS v4u*)(L + P4_QP + lo) = qp; *(LAS v4u*)(L + P4_QM + lo) = qm; *(LAS v4u*)(L + P4_KP + lo) = kp; *(LAS v4u*)(L + P4_KM + lo) = km; }
            __syncthreads();
            if (item + F.G < BATCH * NCH * 8) P4_PREFETCH(item + F.G);
            if (w < 4) {
                const int ti = w >> 1, tj = w & 1;
                f32x16 s1, s2;
#pragma unroll
                for (int r = 0; r < 16; ++r) { s1[r] = 0.f; s2[r] = 0.f; }
                if (ti >= tj) {
#pragma unroll
                    for (int s = 0; s < 8; ++s) s1 = __builtin_amdgcn_mfma_f32_32x32x16_bf16(row_frag(L + P4_QP, SQ128, 32 * ti, s, lane), row_frag(L + P4_KM, SQ128, 32 * tj, s, lane), s1, 0, 0, 0);
                }
                if (ti <= tj) {
#pragma unroll
                    for (int s = 0; s < 8; ++s) s2 = __builtin_amdgcn_mfma_f32_32x32x16_bf16(row_frag(L + P4_QM, SQ128, 32 * ti, s, lane), row_frag(L + P4_KP, SQ128, 32 * tj, s, lane), s2, 0, 0, 0);
                }
                const int m = 32 * tj + (lane & 31);
#pragma unroll
                for (int r = 0; r < 16; ++r) { const int n = 32 * ti + (r & 3) + 8 * (r >> 2) + 4 * hh;
                    *(LAS bf16_t*)(L + P4_P + n * SP + m * 2) = f2bf(n >= m ? s1[r] : s2[r]); }
            }
            {
                const bf16_t* sp = ST + ((size_t)(b * 4 + h) * NCH + ch) * 256 * 128 + (size_t)(32 * w + (lane & 31)) * 128 + 8 * hh;
#pragma unroll
                for (int s = 0; s < 8; ++s) { const bf16x8 bs = *(const GAS bf16x8*)(sp + 16 * s);
                    acc[0] = __builtin_amdgcn_mfma_f32_32x32x16_bf16(row_frag(L + P4_QP, SQ128, 0, s, lane), bs, acc[0], 0, 0, 0);
                    acc[1] = __builtin_amdgcn_mfma_f32_32x32x16_bf16(row_frag(L + P4_QP, SQ128, 32, s, lane), bs, acc[1], 0, 0, 0); }
            }
        } else {
#pragma unroll
            for (int i = 0; i < 4; ++i) { const int pi = tid + 512 * i, r = pi >> 5, c = pi & 31;
                *(LAS v4u*)(L + P4_V + r * SV + c * 16) = pf[i]; *(LAS v4u*)(L + P4_RQ + r * SQ256 + c * 16) = pf[4 + i]; *(LAS v4u*)(L + P4_RK + r * SQ256 + c * 16) = pf[8 + i]; }
            __syncthreads();
            if (item + F.G < BATCH * NCH * 8) P4_PREFETCH(item + F.G);
            const float lg2 = gamma_log(h) * 1.4426950408889634f;
            if (w < 4) {
                const int ti = w >> 1, tj = w & 1;
                f32x16 s1;
#pragma unroll
                for (int r = 0; r < 16; ++r) s1[r] = 0.f;
#pragma unroll
                for (int s = 0; s < 16; ++s) s1 = __builtin_amdgcn_mfma_f32_32x32x16_bf16(row_frag(L + P4_RQ, SQ256, 32 * ti, s, lane), row_frag(L + P4_RK, SQ256, 32 * tj, s, lane), s1, 0, 0, 0);
                const int m = 32 * tj + (lane & 31);
#pragma unroll
                for (int r = 0; r < 16; ++r) { const int n = 32 * ti + (r & 3) + 8 * (r >> 2) + 4 * hh; const int dn = n > m ? n - m : m - n;
                    *(LAS bf16_t*)(L + P4_P + n * SP + m * 2) = f2bf(s1[r] * exp2f(lg2 * (float)dn)); }
            }
            {
                const bf16_t* sp = ST + UT_RET_OFF + ((size_t)(b * 4 + h) * NCH + ch) * 256 * 256 + (size_t)(32 * w + (lane & 31)) * 256 + 8 * hh;
#pragma unroll 4
                for (int s = 0; s < 16; ++s) { const bf16x8 bs = *(const GAS bf16x8*)(sp + 16 * s);
                    acc[0] = __builtin_amdgcn_mfma_f32_32x32x16_bf16(row_frag(L + P4_RQ, SQ256, 0, s, lane), bs, acc[0], 0, 0, 0);
                    acc[1] = __builtin_amdgcn_mfma_f32_32x32x16_bf16(row_frag(L + P4_RQ, SQ256, 32, s, lane), bs, acc[1], 0, 0, 0); }
#pragma unroll
                for (int i = 0; i < 2; ++i)
#pragma unroll
                    for (int r = 0; r < 16; ++r) { const int n = 32 * i + (r & 3) + 8 * (r >> 2) + 4 * hh; acc[i][r] *= exp2f(lg2 * (float)(n + 1)); }
            }
        }
        __syncthreads();
        {
            const unsigned vb = lds_addr(L + P4_V) + tr_lane_off(lane, SV) + 64 * w;
#define P4_STEP(ks) { const bf16x8 bv = tr_frag<16 * (ks) * SV, 16 * (ks) * SV + 4 * SV>(vb); \
                acc[0] = __builtin_amdgcn_mfma_f32_32x32x16_bf16(row_frag(L + P4_P, SP, 0, ks, lane), bv, acc[0], 0, 0, 0); \
                acc[1] = __builtin_amdgcn_mfma_f32_32x32x16_bf16(row_frag(L + P4_P, SP, 32, ks, lane), bv, acc[1], 0, 0, 0); }
            P4_STEP(0) P4_STEP(1) P4_STEP(2) P4_STEP(3)
#undef P4_STEP
        }
        __syncthreads();
#pragma unroll
        for (int i = 0; i < 2; ++i)
#pragma unroll
            for (int r = 0; r < 16; ++r) { const int n = 32 * i + (r & 3) + 8 * (r >> 2) + 4 * hh; *(LAS float*)(L + P4_O + n * SO + (32 * w + (lane & 31)) * 4) = acc[i][r]; }
        __syncthreads();
        {
            const f32x4 gn = *(const GAS f32x4*)((gla ? gla_g : ret_g) + h * 256 + 4 * lane);
            const int gcol = (gla ? C_GR : C_RR) + h * 256 + 4 * lane, ocol = (gla ? 0 : 1024) + h * 256 + 4 * lane;
#pragma unroll 2
            for (int rr = 0; rr < 8; ++rr) { const int n = 8 * w + rr;
                f32x4 v = *(const LAS f32x4*)(L + P4_O + n * SO + lane * 16);
                if (!gla) { const float mu = wave_sum_dpp((v[0] + v[1]) + (v[2] + v[3])) * (1.0f / 256.0f); v = v - mu; }
                const float ss = wave_sum_dpp((v[0] * v[0] + v[1] * v[1]) + (v[2] * v[2] + v[3] * v[3]));
                const float rs = rsqrtf(ss * (1.0f / 256.0f) + LN_EPS);
                const v2u gw = *(const GAS v2u*)(prow + (size_t)n * NP + gcol);
                const float g0 = bflo(gw.x), g1 = bfhi(gw.x), g2 = bflo(gw.y), g3 = bfhi(gw.y);
                const float o0 = v[0] * rs * gn[0] * g0 / (1.0f + __expf(-g0)), o1 = v[1] * rs * gn[1] * g1 / (1.0f + __expf(-g1));
                const float o2 = v[2] * rs * gn[2] * g2 / (1.0f + __expf(-g2)), o3 = v[3] * rs * gn[3] * g3 / (1.0f + __expf(-g3));
                v2u ow; ow.x = pk2(o0, o1); ow.y = pk2(o2, o3);
                *(GAS v2u*)(O + (size_t)(t0 + n) * D + ocol) = ow; }
        }
        __syncthreads();
    }
#undef P4_PREFETCH
}
__device__ __forceinline__ void scan_phase(const Frame& F, bf16_t* UT, const float* BC) {
    const size_t gtid = (size_t)F.vcu * (NWAVES * 64) + F.tid, gthreads = (size_t)F.G * (NWAVES * 64);
    constexpr size_t NG4 = (size_t)16 * 256 * 128 / 4, NR4 = (size_t)16 * 256 * 256 / 4;
    for (size_t it = gtid; it < NG4 + NR4; it += gthreads) {
        float s0 = 0.f, s1 = 0.f, s2 = 0.f, s3 = 0.f;
        if (it < NG4) {
            const size_t el = it * 4; const int bh = (int)(el >> 15), d = (int)(el & 127), b = bh >> 2, h = bh & 3;
            GAS v2u* p = (GAS v2u*)(UT + (size_t)bh * NCH * 32768 + (el & 32767));
            const GAS f32x4* bp = (const GAS f32x4*)(BC + (size_t)(b * SEQ + 63) * 512 + h * 128 + d);
#pragma unroll 4
            for (int i = 0; i < NCH; ++i) {
                const v2u u = p[(size_t)i * (32768 / 4)]; const f32x4 bl = bp[(size_t)i * (CH * 512 / 4)];
                v2u o; o.x = pk2(s0, s1); o.y = pk2(s2, s3); p[(size_t)i * (32768 / 4)] = o;
                s0 = fmaf(__expf(bl[0]), s0, bflo(u.x)); s1 = fmaf(__expf(bl[1]), s1, bfhi(u.x)); s2 = fmaf(__expf(bl[2]), s2, bflo(u.y)); s3 = fmaf(__expf(bl[3]), s3, bfhi(u.y));
            }
        } else {
            const size_t el = (it - NG4) * 4; const int bh = (int)(el >> 16), h = bh & 3;
            GAS v2u* p = (GAS v2u*)(UT + UT_RET_OFF + (size_t)bh * NCH * 65536 + (el & 65535));
            const float dec = __expf(gamma_log(h) * 64.0f);
#pragma unroll 4
            for (int i = 0; i < NCH; ++i) {
                const v2u u = p[(size_t)i * (65536 / 4)];
                v2u o; o.x = pk2(s0, s1); o.y = pk2(s2, s3); p[(size_t)i * (65536 / 4)] = o;
                s0 = fmaf(dec, s0, bflo(u.x)); s1 = fmaf(dec, s1, bfhi(u.x)); s2 = fmaf(dec, s2, bflo(u.y)); s3 = fmaf(dec, s3, bfhi(u.y));
            }
        }
    }
}

template <int N> __device__ __forceinline__ void bitonic_sort_desc(float (&v)[N]) {
#pragma unroll
    for (int k = 2; k <= N; k <<= 1)
#pragma unroll
        for (int j = k >> 1; j > 0; j >>= 1)
#pragma unroll
            for (int i = 0; i < N; ++i) { const int l = i ^ j;
                if (l > i) { const bool desc = (i & k) == 0; const float hi = fmaxf(v[i], v[l]), lo = fminf(v[i], v[l]); v[i] = desc ? hi : lo; v[l] = desc ? lo : hi; } }
}
__device__ __forceinline__ void merge_top16(float (&a)[16], const float (&b)[16]) {
#pragma unroll
    for (int i = 0; i < 16; ++i) a[i] = fmaxf(a[i], b[15 - i]);
#pragma unroll
    for (int j = 8; j > 0; j >>= 1)
#pragma unroll
        for (int i = 0; i < 16; ++i) { const int l = i ^ j; if (l > i) { const float hi = fmaxf(a[i], a[l]), lo = fminf(a[i], a[l]); a[i] = hi; a[l] = lo; } }
}
__device__ __forceinline__ void merge_partner16(float (&a)[16]) {
    float b[16];
#pragma unroll
    for (int i = 0; i < 16; ++i) b[i] = __shfl_xor(a[i], 32);
    merge_top16(a, b);
}
template <int N> __device__ __forceinline__ void topk16_joint(float (&v)[N], float (&out)[16]);
template <> __device__ __forceinline__ void topk16_joint<64>(float (&v)[64], float (&out)[16]) {
    float g[4][16];
#pragma unroll
    for (int q = 0; q < 4; ++q) {
#pragma unroll
        for (int i = 0; i < 16; ++i) g[q][i] = v[16 * q + i];
        bitonic_sort_desc<16>(g[q]); }
    merge_top16(g[0], g[1]); merge_top16(g[2], g[3]); merge_top16(g[0], g[2]);
    merge_partner16(g[0]);
#pragma unroll
    for (int i = 0; i < 16; ++i) out[i] = g[0][i];
}
template <> __device__ __forceinline__ void topk16_joint<25>(float (&v)[25], float (&out)[16]) {
    float w[32];
#pragma unroll
    for (int i = 0; i < 32; ++i) w[i] = i < 25 ? v[i] : -INFINITY;
    bitonic_sort_desc<32>(w);
#pragma unroll
    for (int i = 0; i < 16; ++i) out[i] = w[i];
    merge_partner16(out);
}
struct CandTab { int ci[50], cj[50]; };
constexpr CandTab make_cands() { CandTab t{}; int n = 0; for (int i = 0; i < 16; ++i) for (int j = 0; j < 16; ++j) if ((i + 1) * (j + 1) <= 16) { t.ci[n] = i; t.cj[n] = j; ++n; } return t; }
constexpr CandTab CANDS = make_cands();

template <int S> __device__ __forceinline__ float cand_slot(const float (&la)[16], const float (&lb)[16], int hh) {
    constexpr int i0 = CANDS.ci[2 * S], j0 = CANDS.cj[2 * S], i1 = CANDS.ci[2 * S + 1], j1 = CANDS.cj[2 * S + 1];
    const float sa = __uint_as_float(__float_as_uint(la[i0]) & ~127u) + __uint_as_float(__float_as_uint(lb[j0]) & ~127u);
    const float sb = __uint_as_float(__float_as_uint(la[i1]) & ~127u) + __uint_as_float(__float_as_uint(lb[j1]) & ~127u);
    const unsigned pa = (__float_as_uint(sa) & ~255u) | (unsigned)(i0 * 16 + j0);
    const unsigned pb = (__float_as_uint(sb) & ~255u) | (unsigned)(i1 * 16 + j1);
    return __uint_as_float(hh ? pb : pa);
}
template <int... S> __device__ __forceinline__ void cand_slots(float (&slot)[25], const float (&la)[16], const float (&lb)[16], int hh, std::integer_sequence<int, S...>) {
    ((slot[S] = cand_slot<S>(la, lb, hh)), ...);
}
struct QFromGlobal { const bf16_t* qrow;
    __device__ __forceinline__ bf16x8 operator()(int p, int s) const { return *(const bf16x8*)(qrow + p * 128 + 16 * s); } };
struct QFromLds { const LAS unsigned char* tile; int row, hh;
    __device__ __forceinline__ bf16x8 operator()(int p, int s) const { const int chunk = 16 * p + 2 * s + hh; return *(const LAS bf16x8*)(tile + row * 512 + ((chunk ^ (row & 31)) * 16)); } };
template <class QL> __device__ __forceinline__ void peer_topk_wave(const QL& ql, const bf16_t* skh, int lane, int* eo, float* go) {
    const int tok = lane & 31, hh = lane >> 5;
    float lab[2][16];
#pragma unroll
    for (int p = 0; p < 2; ++p) {
        f32x16 acc[4];
#pragma unroll
        for (int i = 0; i < 4; ++i)
#pragma unroll
            for (int r = 0; r < 16; ++r) acc[i][r] = 0.f;
        const bf16_t* skrow = skh + ((size_t)p * 128 + tok) * 128 + 8 * hh;
#pragma unroll 2
        for (int s = 0; s < 8; ++s) {
            const bf16x8 bq = ql(p, s);
#pragma unroll
            for (int i = 0; i < 4; ++i) { const bf16x8 ak = *(const bf16x8*)(skrow + (size_t)i * 32 * 128 + 16 * s);
                acc[i] = __builtin_amdgcn_mfma_f32_32x32x16_bf16(ak, bq, acc[i], 0, 0, 0); }
        }
        float v[64];
#pragma unroll
        for (int i = 0; i < 4; ++i)
#pragma unroll
            for (int r = 0; r < 16; ++r) { const unsigned kb = 32u * i + (r & 3) + 8u * (r >> 2);
                v[i * 16 + r] = __uint_as_float((__float_as_uint(acc[i][r]) & ~127u) | kb | ((unsigned)hh << 2)); }
        topk16_joint<64>(v, lab[p]);
    }
    float slot[25];
    cand_slots(slot, lab[0], lab[1], hh, std::make_integer_sequence<int, 25>{});
    float win[16];
    topk16_joint<25>(slot, win);
    float ex[16], esum = 0.f;
#pragma unroll
    for (int r = 0; r < 16; ++r) { ex[r] = __expf(win[r] - win[0]); esum += ex[r]; }
    const float inv = 1.0f / esum;
    int eid[8]; float gt[8];
    const unsigned hm = 0u - (unsigned)hh;
#pragma unroll
    for (int r = 0; r < 8; ++r) {
        const unsigned wb = (__float_as_uint(win[r]) & ~hm) | (__float_as_uint(win[r + 8]) & hm);
        const int ci = (wb >> 4) & 15, cj = wb & 15;
        unsigned ia = 0, ib = 0;
#pragma unroll
        for (int i = 0; i < 16; ++i) { ia = (ci == i) ? (__float_as_uint(lab[0][i]) & 127u) : ia; ib = (cj == i) ? (__float_as_uint(lab[1][i]) & 127u) : ib; }
        eid[r] = (int)(ia * 128u + ib);
        gt[r] = __uint_as_float((__float_as_uint(ex[r]) & ~hm) | (__float_as_uint(ex[r + 8]) & hm)) * inv;
    }
    *(GAS v4u*)(eo) = (v4u){(unsigned)eid[0], (unsigned)eid[1], (unsigned)eid[2], (unsigned)eid[3]};
    *(GAS v4u*)(eo + 4) = (v4u){(unsigned)eid[4], (unsigned)eid[5], (unsigned)eid[6], (unsigned)eid[7]};
    *(GAS f32x4*)(go) = (f32x4){gt[0], gt[1], gt[2], gt[3]};
    *(GAS f32x4*)(go + 4) = (f32x4){gt[4], gt[5], gt[6], gt[7]};
}
__device__ __forceinline__ void peer_topk_phase(const Frame& F, const bf16_t* Q, const bf16_t* SKB, int* EXP, float* GATE) {
    const int lane = F.lane, tok = lane & 31, hh = lane >> 5, h = F.wave;
    for (int blk = F.vcu; blk < T / 32; blk += F.G) {
        const int t0 = blk * 32; const size_t o = (size_t)(t0 + tok) * 128 + h * 16 + hh * 8;
        peer_topk_wave(QFromGlobal{Q + (size_t)(t0 + tok) * D + h * 256 + 8 * hh}, SKB + (size_t)h * 2 * 128 * 128, lane, EXP + o, GATE + o);
    }
}

typedef float f32x2 __attribute__((ext_vector_type(2)));
typedef unsigned v6u __attribute__((ext_vector_type(6)));
typedef unsigned v3u __attribute__((ext_vector_type(3)));
typedef float v32f __attribute__((ext_vector_type(32)));
typedef float v16f __attribute__((ext_vector_type(16)));
__device__ __forceinline__ unsigned fp6_code(float x) {
    const float a = fminf(fabsf(x), 7.5f); const unsigned b = __float_as_uint(a);
    const unsigned norm = ((b + 0x7FFFFu + ((b >> 20) & 1u)) >> 20) - 1008u;
    const unsigned code = (a < 1.0f) ? (unsigned)__builtin_rintf(a * 8.0f) : (norm > 31u ? 31u : norm);
    return code | ((__float_as_uint(x) >> 26) & 32u);
}
template <bool ISU>
__device__ __forceinline__ void p0_fp8_rows(const float* src, unsigned char* dst, float* inv_scale, float* s1q, float* s0, const float* g1, const float* b1, int row_lo, int row_hi, int step, int lane) {
    f32x4 gl[2][4], bl[2][4];
    if (ISU) {
#pragma unroll
        for (int j = 0; j < 2; ++j)
#pragma unroll
            for (int c = 0; c < 4; ++c) { gl[j][c] = ((const GAS f32x4*)g1)[4 * lane + 256 * j + c]; bl[j][c] = ((const GAS f32x4*)b1)[4 * lane + 256 * j + c]; }
    }
    constexpr int NR = ISU ? 2 : 4;
    for (int row = row_lo; row < row_hi; row += NR * step) {
        f32x4 v[NR][2][4];
#pragma unroll
        for (int r = 0; r < NR; ++r) { const int rr = (row + r * step < row_hi) ? row + r * step : row; const GAS f32x4* sp = (const GAS f32x4*)(src + (size_t)rr * D) + 4 * lane;
#pragma unroll
            for (int j = 0; j < 2; ++j)
#pragma unroll
                for (int c = 0; c < 4; ++c) v[r][j][c] = sp[256 * j + c]; }
#pragma unroll
        for (int r = 0; r < NR; ++r) { const int rr = row + r * step; float mx = 0.f, sb = 0.f;
#pragma unroll
            for (int j = 0; j < 2; ++j)
#pragma unroll
                for (int c = 0; c < 4; ++c) {
                    if (ISU) { const f32x4 gg = gl[j][c], bb = bl[j][c];
                        sb += (v[r][j][c][0] * bb[0] + v[r][j][c][1] * bb[1]) + (v[r][j][c][2] * bb[2] + v[r][j][c][3] * bb[3]); v[r][j][c] = v[r][j][c] * gg; }
                    mx = fmaxf(fmaxf(mx, fmaxf(fabsf(v[r][j][c][0]), fabsf(v[r][j][c][1]))), fmaxf(fabsf(v[r][j][c][2]), fabsf(v[r][j][c][3]))); }
            mx = wave_max_dpp(mx);
            const bool ok = mx > 1e-30f && mx < 1e30f;
            const float sc = ok ? 7.5f / mx : 1.f, isc = ok ? mx * (1.0f / 7.5f) : 1.f;
            float sq = 0.f;
#pragma unroll
            for (int j = 0; j < 2; ++j) {
                v16f ea, eb;
#pragma unroll
                for (int i = 0; i < 8; ++i) { const int e0 = 2 * i, e1 = 2 * i + 1; ea[i] = v[r][j][e0 >> 2][e0 & 3] * sc; eb[i] = v[r][j][e1 >> 2][e1 & 3] * sc; ea[8 + i] = 0.f; eb[8 + i] = 0.f; }
                const v6u pk = __builtin_amdgcn_cvt_scalef32_2xpk16_fp6_f32(ea, eb, 1.0f);
                v3u o; o.x = pk[0]; o.y = pk[1]; o.z = pk[2];
                if (ISU) { const v32f dq = __builtin_amdgcn_cvt_scalef32_pk32_f32_fp6((v6u){o.x, o.y, o.z, 0u, 0u, 0u}, 1.0f);
#pragma unroll
                    for (int i = 0; i < 16; ++i) sq += dq[i]; }
                if (rr < row_hi) { unsigned char* q = dst + ((size_t)((lane >> 4) + 4 * j) * 16384 + rr) * 192 + 24 * ((lane & 15) >> 1) + 12 * (lane & 1);
                    *(GAS unsigned*)q = o.x; *(GAS unsigned*)(q + 4) = o.y; *(GAS unsigned*)(q + 8) = o.z; } }
            if (ISU) { sq = wave_sum_dpp(sq); sb = wave_sum_dpp(sb); }
            if (lane == 0 && rr < row_hi) { inv_scale[rr] = isc; if (ISU) { s1q[rr] = sq; s0[rr] = sb; } } }
    }
}
constexpr int PG_GB = 4;
struct PgBatch { v6u w[PG_GB]; };
__device__ __forceinline__ void pg_issue(PgBatch& b, const unsigned char* tslice, const LAS unsigned* sid, int ib, int g8) {
#pragma unroll
    for (int q = 0; q < PG_GB; ++q) { const unsigned e = sid[8 * (ib + q) + g8]; const GAS v2u* p = (const GAS v2u*)(tslice + (size_t)e * 192); const v2u p0 = p[0], p1 = p[1], p2 = p[2]; b.w[q] = (v6u){p0.x, p0.y, p1.x, p1.y, p2.x, p2.y}; }
}
__device__ __forceinline__ v32f pg_unpack(const PgBatch& b, int q) { return __builtin_amdgcn_cvt_scalef32_pk32_f32_fp6(b.w[q], 1.0f); }
struct PgHead { unsigned id0, id1; v4u y[4]; float w0, w1; };
template <bool DOTS> __device__ __forceinline__ void pg_head_load(PgHead& h, const bf16_t* Y, const int* EXP, const float* W, int t, int lane, int col0) {
    h.id0 = ((const GAS unsigned*)EXP)[(size_t)t * 128 + lane]; h.id1 = ((const GAS unsigned*)EXP)[(size_t)t * 128 + 64 + lane];
    if (DOTS) {
#pragma unroll
        for (int i = 0; i < 4; ++i) h.y[i] = *(const GAS v4u*)(Y + (size_t)t * D + col0 + 8 * i);
    } else { h.w0 = ((const GAS float*)W)[(size_t)t * 128 + lane]; h.w1 = ((const GAS float*)W)[(size_t)t * 128 + 64 + lane]; }
}
template <int IB> __device__ __forceinline__ void pg_dots(const PgBatch& b, const f32x2 (&xs)[16], float (&dp)[16]) {
#pragma unroll
    for (int q = 0; q < PG_GB; ++q) { const v32f u = pg_unpack(b, q); f32x2 a0 = {0.f, 0.f}, a1 = {0.f, 0.f};
#pragma unroll
        for (int j = 0; j < 16; j += 2) { a0 = (f32x2){u[2 * j], u[2 * j + 1]} * xs[j] + a0; a1 = (f32x2){u[2 * j + 2], u[2 * j + 3]} * xs[j + 1] + a1; }
        dp[IB + q] = (a0.x + a0.y) + (a1.x + a1.y);
        if (q & 1) __builtin_amdgcn_sched_barrier(0); }
}
__device__ __forceinline__ void peer_dots_phase(const Frame& F, const bf16_t* Y, const unsigned char* TU, const int* EXP, float* PD) {
    const int lane = F.lane, g8 = lane >> 3, c8 = lane & 7;
    const int cls = (int)(blockIdx.x & 7), gwc = (int)(blockIdx.x >> 3) * NWAVES + F.wave, NW = (F.G >> 3) * NWAVES, col0 = cls * 256 + 32 * c8;
    LAS unsigned* sid = (LAS unsigned*)(F.lds + F.wave * 2048);
    LAS float* red = (LAS float*)(F.lds + 16384 + F.wave * 4096);
    const unsigned char* tslice = TU + (size_t)cls * 16384 * 192 + 24 * c8;
    if (gwc >= T) return;
    PgHead H; pg_head_load<true>(H, Y, EXP, nullptr, gwc, lane, col0);
    for (int t = gwc; t < T; t += NW) {
        f32x2 xs[16];
        sid[lane] = H.id0; sid[64 + lane] = H.id1;
#pragma unroll
        for (int j = 0; j < 16; ++j) { const unsigned wv = H.y[j >> 2][j & 3]; xs[j] = (f32x2){bflo(wv), bfhi(wv)}; }
        PgBatch A, B;
        pg_issue(A, tslice, sid, 0, g8);
        pg_head_load<true>(H, Y, EXP, nullptr, (t + NW < T) ? t + NW : t, lane, col0);
        float dp[16];
        pg_issue(B, tslice, sid, 4, g8); pg_dots<0>(A, xs, dp);
        pg_issue(A, tslice, sid, 8, g8); pg_dots<4>(B, xs, dp);
        pg_issue(B, tslice, sid, 12, g8); pg_dots<8>(A, xs, dp);
        pg_dots<12>(B, xs, dp);
#pragma unroll
        for (int i = 0; i < 16; ++i) red[i * 64 + lane] = dp[i];
        float d[2];
#pragma unroll
        for (int h = 0; h < 2; ++h) { const int k = 64 * h + lane; const LAS f32x4* p = (const LAS f32x4*)(red + (k >> 3) * 64 + (k & 7) * 8); const f32x4 a = p[0], b = p[1];
            d[h] = ((a[0] + a[1]) + (a[2] + a[3])) + ((b[0] + b[1]) + (b[2] + b[3])); }
        float* pd = PD + ((size_t)cls * T + t) * 128;
        pd[lane] = d[0]; pd[64 + lane] = d[1];
    }
}
__device__ __forceinline__ void peer_w_phase(const Frame& F, const float* PD, const float* MURS, const int* EXP, const float* GATE, const float* USC, const float* US1, const float* US0, const float* VSC, float* W) {
    const int lane = F.lane, gw = F.vcu * NWAVES + F.wave, NGW = F.G * NWAVES;
    for (int t = gw; t < T; t += NGW) {
        float d0 = 0.f, d1 = 0.f;
#pragma unroll
        for (int x = 0; x < 8; ++x) { d0 += PD[((size_t)x * T + t) * 128 + lane]; d1 += PD[((size_t)x * T + t) * 128 + 64 + lane]; }
        const f32x2 murs = *(const GAS f32x2*)(MURS + (size_t)t * 2);
        const unsigned i0 = ((const GAS unsigned*)EXP)[(size_t)t * 128 + lane], i1 = ((const GAS unsigned*)EXP)[(size_t)t * 128 + 64 + lane];
        const float gt0 = ((const GAS float*)GATE)[(size_t)t * 128 + lane], gt1 = ((const GAS float*)GATE)[(size_t)t * 128 + 64 + lane];
        const float us0 = ((const GAS float*)USC)[i0], us1 = ((const GAS float*)USC)[i1], vs0 = ((const GAS float*)VSC)[i0], vs1 = ((const GAS float*)VSC)[i1];
        const float q0 = ((const GAS float*)US1)[i0], q1 = ((const GAS float*)US1)[i1], c0 = ((const GAS float*)US0)[i0], c1 = ((const GAS float*)US0)[i1];
        d0 = murs.y * us0 * (d0 - murs.x * q0) + c0; d1 = murs.y * us1 * (d1 - murs.x * q1) + c1;
        W[(size_t)t * 128 + lane] = gt0 * 0.5f * d0 * (1.0f + erff(d0 * 0.7071067811865476f)) * vs0;
        W[(size_t)t * 128 + 64 + lane] = gt1 * 0.5f * d1 * (1.0f + erff(d1 * 0.7071067811865476f)) * vs1;
    }
}
__device__ __forceinline__ void pg_axpy(const PgBatch& b, f32x2 (&acc)[16], const LAS float* sw, int ib, int g8) {
#pragma unroll
    for (int q = 0; q < PG_GB; ++q) { const float wk = sw[8 * (ib + q) + g8]; const f32x2 wk2 = {wk, wk}; const v32f u = pg_unpack(b, q);
#pragma unroll
        for (int j = 0; j < 16; ++j) acc[j] = (f32x2){u[2 * j], u[2 * j + 1]} * wk2 + acc[j];
        if (q & 1) __builtin_amdgcn_sched_barrier(0); }
}
__device__ __forceinline__ float xgrp_sum(float x) {
    x += dppf<0x128>(x);
    auto s = __builtin_amdgcn_permlane16_swap(__float_as_uint(x), __float_as_uint(x), false, false);
    x = __uint_as_float(s[0]) + __uint_as_float(s[1]);
    auto t = __builtin_amdgcn_permlane32_swap(__float_as_uint(x), __float_as_uint(x), false, false);
    return __uint_as_float(t[0]) + __uint_as_float(t[1]);
}
__device__ __forceinline__ void peer_mix_phase(const Frame& F, const unsigned char* TV, const int* EXP, const float* W, bf16_t* FFN) {
    const int lane = F.lane, g8 = lane >> 3, c8 = lane & 7;
    const int cls = (int)(blockIdx.x & 7), gwc = (int)(blockIdx.x >> 3) * NWAVES + F.wave, NW = (F.G >> 3) * NWAVES, col0 = cls * 256 + 32 * c8;
    LAS unsigned* sid = (LAS unsigned*)(F.lds + F.wave * 2048);
    LAS float* sw = (LAS float*)(F.lds + F.wave * 2048 + 1024);
    const unsigned char* tslice = TV + (size_t)cls * 16384 * 192 + 24 * c8;
    if (gwc >= T) return;
    PgHead H; pg_head_load<false>(H, nullptr, EXP, W, gwc, lane, col0);
    for (int t = gwc; t < T; t += NW) {
        sid[lane] = H.id0; sid[64 + lane] = H.id1; sw[lane] = H.w0; sw[64 + lane] = H.w1;
        PgBatch A, B;
        pg_issue(A, tslice, sid, 0, g8);
        pg_head_load<false>(H, nullptr, EXP, W, (t + NW < T) ? t + NW : t, lane, col0);
        f32x2 acc[16];
#pragma unroll
        for (int j = 0; j < 16; ++j) acc[j] = (f32x2){0.f, 0.f};
        pg_issue(B, tslice, sid, 4, g8); pg_axpy(A, acc, sw, 0, g8);
        pg_issue(A, tslice, sid, 8, g8); pg_axpy(B, acc, sw, 4, g8);
        pg_issue(B, tslice, sid, 12, g8); pg_axpy(A, acc, sw, 8, g8);
        pg_axpy(B, acc, sw, 12, g8);
        {   LAS unsigned char* red = F.lds + 16384 + F.wave * 9216;
#pragma unroll
            for (int i = 0; i < 8; ++i) *(LAS f32x4*)(red + g8 * 1152 + c8 * 144 + 16 * i) = (f32x4){acc[2 * i].x, acc[2 * i].y, acc[2 * i + 1].x, acc[2 * i + 1].y};
            f32x4 tot = *(const LAS f32x4*)(red + (lane >> 3) * 144 + (lane & 7) * 16);
#pragma unroll
            for (int g = 1; g < 8; ++g) tot = tot + *(const LAS f32x4*)(red + g * 1152 + (lane >> 3) * 144 + (lane & 7) * 16);
            *(GAS v2u*)(FFN + (size_t)t * D + cls * 256 + 4 * lane) = (v2u){pk2(tot[0], tot[1]), pk2(tot[2], tot[3])};
        }
    }
}
__device__ __forceinline__ void ln2_phase(const Frame& F, const bf16_t* Y, const bf16_t* FFN, const float* MURS, const float* g1, const float* b1, const float* g2, const float* b2, float* out) {
    const int gw = F.vcu * NWAVES + F.wave, NGW = F.G * NWAVES, lane = F.lane;
    for (int row0 = gw; row0 < T; row0 += 2 * NGW) {
        v2u yw[2][8], fw[2][8]; f32x2 murs[2];
#pragma unroll
        for (int k = 0; k < 2; ++k) { const int row = (row0 + k * NGW < T) ? row0 + k * NGW : row0;
            const GAS v2u* yr = (const GAS v2u*)(Y + (size_t)row * D) + lane; const GAS v2u* fr = (const GAS v2u*)(FFN + (size_t)row * D) + lane;
            murs[k] = *(const GAS f32x2*)(MURS + (size_t)row * 2);
#pragma unroll
            for (int j = 0; j < 8; ++j) { yw[k][j] = yr[64 * j]; fw[k][j] = fr[64 * j]; } }
#pragma unroll
        for (int k = 0; k < 2; ++k) { const int row = row0 + k * NGW;
            f32x4 v[8]; float s = 0.f;
#pragma unroll
            for (int j = 0; j < 8; ++j) { const f32x4 y = {bflo(yw[k][j].x), bfhi(yw[k][j].x), bflo(yw[k][j].y), bfhi(yw[k][j].y)}, f = {bflo(fw[k][j].x), bfhi(fw[k][j].x), bflo(fw[k][j].y), bfhi(fw[k][j].y)},
                    gg = ((const GAS f32x4*)g1)[64 * j + lane], bb = ((const GAS f32x4*)b1)[64 * j + lane];
                v[j] = ((y - murs[k].x) * murs[k].y * gg + bb) * ALPHA + f; s += (v[j][0] + v[j][1]) + (v[j][2] + v[j][3]); }
            const float mean = wave_sum_dpp(s) * (1.0f / D); float s2 = 0.f;
#pragma unroll
            for (int j = 0; j < 8; ++j) { v[j] = v[j] - mean; s2 += (v[j][0] * v[j][0] + v[j][1] * v[j][1]) + (v[j][2] * v[j][2] + v[j][3] * v[j][3]); }
            const float rstd = 1.0f / sqrtf(wave_sum_dpp(s2) * (1.0f / D) + LN_EPS);
            if (row < T) { GAS f32x4* orow = (GAS f32x4*)(out + (size_t)row * D) + lane;
#pragma unroll
                for (int j = 0; j < 8; ++j) { const f32x4 gg = ((const GAS f32x4*)g2)[64 * j + lane], bb = ((const GAS f32x4*)b2)[64 * j + lane]; orow[64 * j] = v[j] * rstd * gg + bb; } } }
    }
}

template <int MODE>
__device__ __forceinline__ void p0_transpose_item(const float* W, int K, int N, int nblk, bf16_t* WT, LAS float* scr, int item, int lane, const float* g, const float* beta, float* cpart) {
    const int kb = item / nblk, nb = item % nblk, k0 = 64 * kb, n0 = 32 * nb;
    const int n = n0 + (lane & 31);
    int src = n; float sc = 1.f; bool ok = true;
    if (MODE == 1) {
        ok = n < NPROJ;
        src = (n < 3072) ? n : (n < 7168 ? n + 16 : n - 7168 + 3072);
        sc = (n < 512) ? 0.08838834764831845f : ((n >= C_RK && n < C_RV) ? 0.0625f : 1.f);
    }
#pragma unroll
    for (int i = 0; i < 32; ++i) { const int kk = 2 * i + (lane >> 5); scr[kk * 33 + (lane & 31)] = ok ? W[(size_t)(k0 + kk) * N + src] * sc : 0.f; }
    LDS_WAIT(); asm volatile("" ::: "memory");
    LAS float* cg = scr + 64 * 33;
    if (MODE == 2) {
        cg[lane] = g[k0 + lane]; cg[64 + lane] = beta[k0 + lane];
        LDS_WAIT(); asm volatile("" ::: "memory");
        float s = 0.f, s1 = 0.f, s2 = 0.f, s3 = 0.f; const bool isg = lane < 32; const LAS float* coef = cg + (isg ? 0 : 64); const int col = lane & 31;
#pragma unroll 4
        for (int kk = 0; kk < 64; kk += 4) { float v0 = scr[kk * 33 + col] * coef[kk], v1 = scr[(kk + 1) * 33 + col] * coef[kk + 1], v2 = scr[(kk + 2) * 33 + col] * coef[kk + 2], v3 = scr[(kk + 3) * 33 + col] * coef[kk + 3];
            if (isg) { v0 = bf2f(f2bf(v0)); v1 = bf2f(f2bf(v1)); v2 = bf2f(f2bf(v2)); v3 = bf2f(f2bf(v3)); }
            s += v0; s1 += v1; s2 += v2; s3 += v3; }
        cpart[((size_t)kb * 2 + (isg ? 0 : 1)) * N + n0 + col] = (s + s1) + (s2 + s3);
    }
    const int c = lane & 7;
    float gs[8];
#pragma unroll
    for (int i = 0; i < 8; ++i) gs[i] = (MODE == 2) ? cg[8 * c + i] : 1.f;
#pragma unroll
    for (int j = 0; j < 4; ++j) { const int nn = (lane >> 3) + 8 * j; const LAS float* s = scr + (8 * c) * 33 + nn;
        v4u o; o.x = pk2(s[0 * 33] * gs[0], s[1 * 33] * gs[1]); o.y = pk2(s[2 * 33] * gs[2], s[3 * 33] * gs[3]); o.z = pk2(s[4 * 33] * gs[4], s[5 * 33] * gs[5]); o.w = pk2(s[6 * 33] * gs[6], s[7 * 33] * gs[7]);
        *(GAS v4u*)(WT + (size_t)(n0 + nn) * K + k0 + 8 * c) = o; }
    LDS_WAIT(); asm volatile("" ::: "memory");
}
__device__ __forceinline__ void p0_cvt(const float* src, bf16_t* dst, size_t n8, size_t gtid, size_t gthreads) {
    size_t i = gtid;
    for (; i + 3 * gthreads < n8; i += 4 * gthreads) {
        f32x4 a[4], b[4];
#pragma unroll
        for (int q = 0; q < 4; ++q) { a[q] = __builtin_nontemporal_load((const GAS f32x4*)src + 2 * (i + q * gthreads)); b[q] = __builtin_nontemporal_load((const GAS f32x4*)src + 2 * (i + q * gthreads) + 1); }
#pragma unroll
        for (int q = 0; q < 4; ++q) { v4u o; o.x = pk2(a[q][0], a[q][1]); o.y = pk2(a[q][2], a[q][3]); o.z = pk2(b[q][0], b[q][1]); o.w = pk2(b[q][2], b[q][3]); ((GAS v4u*)dst)[i + q * gthreads] = o; }
    }
    for (; i < n8; i += gthreads) {
        const f32x4 a = ((const GAS f32x4*)src)[2 * i], b = ((const GAS f32x4*)src)[2 * i + 1];
        v4u o; o.x = pk2(a[0], a[1]); o.y = pk2(a[2], a[3]); o.z = pk2(b[0], b[1]); o.w = pk2(b[2], b[3]);
        ((GAS v4u*)dst)[i] = o;
    }
}
__device__ __forceinline__ void p0_prologue(const Frame& F, const Args& a) {
    unsigned char* ws = a.ws;
    LAS float* scr = (LAS float*)(F.lds + F.wave * 16384);
    const int gw = F.vcu * NWAVES + F.wave, NGW = F.G * NWAVES;
    constexpr int I_IN = (D / 64) * (NP / 32);
    for (int it = gw; it < I_IN; it += NGW) p0_transpose_item<1>(a.in[1], D, NPROJ, NP / 32, (bf16_t*)(ws + WS_WIN), scr, it, F.lane, nullptr, nullptr, nullptr);
    const size_t gtid = (size_t)F.vcu * (NWAVES * 64) + F.tid, gthreads = (size_t)F.G * (NWAVES * 64);
    p0_cvt(a.in[0], (bf16_t*)(ws + WS_XB), (size_t)T * D / 8, gtid, gthreads);
    p0_cvt(a.in[10], (bf16_t*)(ws + WS_SKB), (size_t)8 * 2 * 128 * 128 / 8, gtid, gthreads);
    float* rope = (float*)(ws + WS_ROPE);
    for (size_t idx = gtid; idx < (size_t)SEQ * 128; idx += gthreads) {
        const int pos = (int)(idx >> 7), i = (int)(idx & 127);
        const float inv = powf(10000.0f, -(float)i / 128.0f);
        const float ang = (float)pos * inv;
        const float n = rintf(ang * 0.15915494309189535f);
        float r = fmaf(-n, 6.28125f, ang); r = fmaf(-n, 0.0019353071795864769f, r);
        rope[2 * idx] = cosf(r); rope[2 * idx + 1] = sinf(r);
    }
}
__device__ __forceinline__ void ln_rows_phase(const Frame& F, float* Y, const float* g, const float* bta, bf16_t* Hb) {
    const int gw = F.vcu * NWAVES + F.wave, NGW = F.G * NWAVES;
    for (int row = gw; row < T; row += NGW) {
        GAS f32x4* yr = (GAS f32x4*)(Y + (size_t)row * D) + F.lane;
        f32x4 v[8]; float s = 0.f;
#pragma unroll
        for (int j = 0; j < 8; ++j) { v[j] = yr[64 * j]; s += (v[j][0] + v[j][1]) + (v[j][2] + v[j][3]); }
        const float mean = wave_sum(s) * (1.f / D); float s2 = 0.f;
#pragma unroll
        for (int j = 0; j < 8; ++j) { v[j] = v[j] - mean; s2 += (v[j][0] * v[j][0] + v[j][1] * v[j][1]) + (v[j][2] * v[j][2] + v[j][3] * v[j][3]); }
        const float rstd = 1.f / sqrtf(wave_sum(s2) * (1.f / D) + LN_EPS);
        GAS v2u* o8 = (GAS v2u*)(Hb + (size_t)row * D) + F.lane;
#pragma unroll
        for (int j = 0; j < 8; ++j) { const f32x4 gg = ((const GAS f32x4*)g)[64 * j + F.lane], bb = ((const GAS f32x4*)bta)[64 * j + F.lane];
            const f32x4 o = v[j] * rstd * gg + bb; yr[64 * j] = o; v2u w; w.x = pk2(o[0], o[1]); w.y = pk2(o[2], o[3]); o8[64 * j] = w; }
    }
}


constexpr int CW_QUEUE = 2048;
constexpr int BGQ_TAB = 512, BGQ_TR = 256, BGQ_N = BGQ_TAB + 2 * BGQ_TR;
__device__ __forceinline__ void bg_queue_drain(const Frame& F, const Args& a, gu32* ctl) {
    unsigned char* ws = a.ws;
    LAS float* scr = (LAS float*)(F.lds + F.wave * 16384);
    const int shard = (int)(blockIdx.x & 7);
    gu32* ctr = ctl + CW_QUEUE + 64 * shard;
    for (;;) {
        unsigned it = 0;
        if (F.lane == 0) it = __hip_atomic_fetch_add(ctr, 1u, __ATOMIC_RELAXED, __HIP_MEMORY_SCOPE_AGENT);
        it = __builtin_amdgcn_readfirstlane(it);
        if (it >= (unsigned)BGQ_N) break;
        if (it < (unsigned)BGQ_TAB) {
            const int grp = (int)it * 8 + shard;
            const bool isv = grp >= 2048; const int r0 = (grp & 2047) * 8;
            if (isv) p0_fp8_rows<false>(a.in[12], ws + WS_VB, (float*)(ws + WS_VSC), nullptr, nullptr, nullptr, nullptr, r0, r0 + 8, 1, F.lane);
            else p0_fp8_rows<true>(a.in[11], ws + WS_UB, (float*)(ws + WS_USC), (float*)(ws + WS_US1), (float*)(ws + WS_US0), a.in[7], a.in[8], r0, r0 + 8, 1, F.lane);
        } else {
            const int j = (int)it - BGQ_TAB; const bool isq = j >= BGQ_TR; const int item = (isq ? j - BGQ_TR : j) * 8 + shard;
            if (isq) p0_transpose_item<2>(a.in[9], D, D, D / 32, (bf16_t*)(ws + WS_WQ), scr, item, F.lane, a.in[7], a.in[8], (float*)(ws + WS_CPART));
            else p0_transpose_item<0>(a.in[6], D, D, D / 32, (bf16_t*)(ws + WS_WOUT), scr, item, F.lane, nullptr, nullptr, nullptr);
        }
    }
}

struct EpiLnTopk {
    static constexpr bool PERM = true, AFTER_DRAIN = true;
    const float* c1; const float* c0; const LAS float* stat; const bf16_t* SKB; int* EXP; float* GATE;
    __device__ __forceinline__ void fused(pg8::f32x4 (&acc)[2][2][4][2], const pg8::Unit& u, int wr, int wc, int fr, int fq, LAS unsigned char* lds, int wid, int lane) const {
        const int colw = wc * 32 + 8 * fq;
        f32x4 k1[2][2], k0[2][2];
#pragma unroll
        for (int bj = 0; bj < 2; ++bj)
#pragma unroll
            for (int n = 0; n < 2; ++n) { k1[bj][n] = *(const f32x4*)(c1 + u.pn * 256 + colw + bj * 128 + 4 * n); k0[bj][n] = *(const f32x4*)(c0 + u.pn * 256 + colw + bj * 128 + 4 * n); }
#pragma unroll
        for (int ai = 0; ai < 2; ++ai)
#pragma unroll
            for (int m = 0; m < 4; ++m) { const int rl = wr * 64 + fr + ai * 128 + m * 16; const float mu = stat[2 * rl], rs = stat[2 * rl + 1];
#pragma unroll
                for (int bj = 0; bj < 2; ++bj) { const f32x4 a = (acc[ai][bj][m][0] - k1[bj][0] * mu) * rs + k0[bj][0], b = (acc[ai][bj][m][1] - k1[bj][1] * mu) * rs + k0[bj][1];
                    v4u w; w.x = pg8::cvt_pk_bf16(a[0], a[1]); w.y = pg8::cvt_pk_bf16(a[2], a[3]); w.z = pg8::cvt_pk_bf16(b[0], b[1]); w.w = pg8::cvt_pk_bf16(b[2], b[3]);
                    const int chunk = wc * 4 + fq + 16 * bj;
                    *(LAS v4u*)(lds + rl * 512 + ((chunk ^ (rl & 31)) * 16)) = w; } }
        asm volatile("s_waitcnt lgkmcnt(0)" ::: "memory"); __builtin_amdgcn_s_barrier(); asm volatile("" ::: "memory");
        const int tok = lane & 31, hh = lane >> 5, h = u.pn, row = 32 * wid + tok;
        const size_t o = (size_t)(u.pm * 256 + row) * 128 + h * 16 + hh * 8;
        peer_topk_wave(QFromLds{lds, row, hh}, SKB + (size_t)h * 2 * 128 * 128, lane, EXP + o, GATE + o);
    }
};
constexpr int N_PHASES = 13;
#ifndef REPMASK
#define REPMASK 0
#endif
#ifndef TSA
#define TSA -1
#define TSB -1
#endif
#define REP(k) for (int rep_ = 0; rep_ < (((REPMASK) >> (k)) & 1) + 1; ++rep_)
__global__ void __launch_bounds__(NWAVES * 64, 2) mega_fwd(Args args) {
    extern __shared__ __attribute__((aligned(16))) unsigned char lds[];
    Frame F;
    F.lds = (LAS unsigned char*)lds;
    volatile LAS unsigned* MISC = (volatile LAS unsigned*)(F.lds + MISC_OFF);
    F.tid = threadIdx.x; F.lane = F.tid & 63; F.wave = __builtin_amdgcn_readfirstlane(F.tid >> 6);
    F.G = gridDim.x; { const int bx = blockIdx.x; F.vcu = (F.G % 8 == 0) ? (bx % 8) * (F.G / 8) + bx / 8 : bx; }
    unsigned char* ws = args.ws;
    gu32* ctl = (gu32*)(ws + WS_CTL);
    for (int u = F.tid; u < (LDS_BYTES - LDSCTL_OFF) / 4; u += NWAVES * 64) ((LAS unsigned*)(F.lds + LDSCTL_OFF))[u] = 0u;
    __syncthreads();
    const int lo = args.ph_lo, hi = args.ph_hi;
    unsigned long long ts_a = 0, ts_b = 0;
#define STAMP(k) do { if (TSA >= 0) { if ((k) == TSA) ts_a = __builtin_amdgcn_s_memrealtime(); if ((k) == TSB) ts_b = __builtin_amdgcn_s_memrealtime(); } } while (0)
    STAMP(0);
    XcdBarrier bar; bar.bar = (unsigned*)(ctl + CW_BAR) + args.li * XCD_BAR_WORDS; bar.x = 0; bar.st = nullptr;
    if (hi - lo > 1) bar = xcd_barrier_post((unsigned*)(ctl + CW_BAR) + args.li * XCD_BAR_WORDS, MISC + 8);
#define IN(k) (lo <= (k) && (k) < hi)
#define BOTH(k) (IN(k) && IN((k) == 5 ? 7 : (k) + 1))
#define SEAM(k) do { if (BOTH(k)) xcd_barrier(bar); STAMP((k) + 1); } while (0)
    bf16_t* WIN = (bf16_t*)(ws + WS_WIN); bf16_t* WOUT = (bf16_t*)(ws + WS_WOUT); bf16_t* WQ = (bf16_t*)(ws + WS_WQ);
    bf16_t* XB = (bf16_t*)(ws + WS_XB); bf16_t* PROJ = (bf16_t*)(ws + WS_PROJ); bf16_t* OB = (bf16_t*)(ws + WS_O);
    float* Y = (float*)(ws + WS_Y); bf16_t* H1B = (bf16_t*)(ws + WS_H1B); bf16_t* QB = (bf16_t*)(ws + WS_Q);
    const float* ROPE = (const float*)(ws + WS_ROPE);

    if (IN(0)) { REP(0) p0_prologue(F, args); SEAM(0); }
    if (IN(1)) {
        pg8::Gemm g{XB, WIN, T, NP, D}; pg8::StaticOrder S; S.init(T, NP, F.G, (int)blockIdx.x);
        pg8::EpiBf16 E{PROJ, NP, ROPE, 12, 20};
        REP(1) pg8::gemm_phase<pg8::EpiBf16, pg8::StaticOrder, true, true>(F.lds, g, S, E);
        bg_queue_drain(F, args, ctl);
        SEAM(1);
    }
    if (IN(2)) { REP(2) chunk_u_phase(F, PROJ, args.in[2], args.in[3], (float*)(ws + WS_BC), (bf16_t*)(ws + WS_UT)); SEAM(2); }
    if (IN(3)) { scan_phase(F, (bf16_t*)(ws + WS_UT), (const float*)(ws + WS_BC)); SEAM(3); }
    if (IN(4)) { REP(4) chunk_o_phase(F, PROJ, (const float*)(ws + WS_BC), (const bf16_t*)(ws + WS_UT), args.in[4], args.in[5], OB); SEAM(4); }
    if (IN(5)) {
        {   const int n = F.vcu * 8 + (F.tid & 7), which = (F.tid >> 3) & 1;
            if (F.tid < 16 && F.vcu * 8 < D) { const float* cp = (const float*)(ws + WS_CPART); float s = 0.f; for (int kb = 0; kb < 32; ++kb) s += cp[((size_t)kb * 2 + which) * D + n]; ((float*)(ws + WS_CFIN))[which * D + n] = s; } }
        pg8::Gemm g{OB, WOUT, T, D, D}; pg8::StaticOrder S; S.init(T, D, F.G, (int)blockIdx.x);
        pg8::EpiResStats E{H1B, XB, (float*)(ws + WS_PSTAT), D, ALPHA};
        REP(5) pg8::gemm_phase<pg8::EpiResStats, pg8::StaticOrder, true, true>(F.lds, g, S, E);
        SEAM(5);
    }
    if (IN(7)) {
        pg8::Gemm g{H1B, WQ, T, D, D}; pg8::StaticOrder S; S.init(T, D, F.G, (int)blockIdx.x);
        pg8::Unit u0; const bool has = S.next(0, u0);
        LAS float* stat = (LAS float*)(F.lds + LDSCTL_OFF + 1024);
        if (has && F.tid < 256) { const float* ps = (const float*)(ws + WS_PSTAT) + (size_t)(u0.pm * 256 + F.tid) * 64; float s = 0.f, q = 0.f;
            for (int i = 0; i < 32; ++i) { s += ps[2 * i]; q += ps[2 * i + 1]; }
            const float mu = s * (1.0f / D), rs = 1.0f / sqrtf(q * (1.0f / D) - mu * mu + LN_EPS); stat[2 * F.tid] = mu; stat[2 * F.tid + 1] = rs;
            if (u0.pn == 0) *(GAS f32x2*)((float*)(ws + WS_MURS) + (size_t)(u0.pm * 256 + F.tid) * 2) = (f32x2){mu, rs}; }
        __syncthreads();
        if (F.G == 256) {
            EpiLnTopk E{(const float*)(ws + WS_CFIN), (const float*)(ws + WS_CFIN) + D, stat, (const bf16_t*)(ws + WS_SKB), (int*)(ws + WS_EXP), (float*)(ws + WS_GATE)};
            pg8::gemm_phase<EpiLnTopk, pg8::StaticOrder, true, true>(F.lds, g, S, E);
        } else {
            pg8::EpiLnBf16 E{QB, D, (const float*)(ws + WS_CFIN), (const float*)(ws + WS_CFIN) + D, stat, has ? u0.pm : -1, (const float*)(ws + WS_PSTAT), LN_EPS, D};
            pg8::gemm_phase<pg8::EpiLnBf16, pg8::StaticOrder, true, true>(F.lds, g, S, E);
        }
        if (IN(8)) xcd_barrier(bar);
        STAMP(8);
    }
    if (IN(8) && F.G != 256) { REP(8) peer_topk_phase(F, QB, (const bf16_t*)(ws + WS_SKB), (int*)(ws + WS_EXP), (float*)(ws + WS_GATE)); if (IN(9)) xcd_barrier(bar); }
    STAMP(9);
    if (IN(9)) { peer_dots_phase(F, H1B, ws + WS_UB, (const int*)(ws + WS_EXP), (float*)(ws + WS_PD)); SEAM(9); }
    if (IN(10)) { peer_w_phase(F, (const float*)(ws + WS_PD), (const float*)(ws + WS_MURS), (const int*)(ws + WS_EXP), (const float*)(ws + WS_GATE), (const float*)(ws + WS_USC), (const float*)(ws + WS_US1), (const float*)(ws + WS_US0), (const float*)(ws + WS_VSC), (float*)(ws + WS_W)); SEAM(10); }
    if (IN(11)) { peer_mix_phase(F, ws + WS_VB, (const int*)(ws + WS_EXP), (const float*)(ws + WS_W), (bf16_t*)(ws + WS_FFN)); SEAM(11); }
    if (IN(12)) ln2_phase(F, H1B, (const bf16_t*)(ws + WS_FFN), (const float*)(ws + WS_MURS), args.in[7], args.in[8], args.in[13], args.in[14], args.out);
    STAMP(13);
    if (TSA >= 0) { const unsigned long long t_end = __builtin_amdgcn_s_memrealtime(), dt = ts_b - ts_a; while (__builtin_amdgcn_s_memrealtime() - t_end < dt) __builtin_amdgcn_s_sleep(8); }
#undef IN
#undef BOTH
#undef SEAM
}

extern "C" void kernel_launch(void* const* d_in, const int* in_sizes, int n_in, void* d_out, int out_size, void* d_ws, size_t ws_size, hipStream_t stream) {
    static int grid = 0;
    if (grid == 0) {
        if (n_in != 15 || in_sizes[0] != T * D || out_size != T * D || ws_size < WS_END) { fprintf(stderr, "kernel_launch: unexpected shapes / workspace (n_in %d, ws %zu)\n", n_in, ws_size); grid = -1; return; }
        int dev = 0, cus = 0, per_cu = 0;
        if (hipGetDevice(&dev) != hipSuccess || hipDeviceGetAttribute(&cus, hipDeviceAttributeMultiprocessorCount, dev) != hipSuccess) { grid = -1; return; }
        if (hipFuncSetAttribute((const void*)mega_fwd, hipFuncAttributeMaxDynamicSharedMemorySize, LDS_BYTES) != hipSuccess) { fprintf(stderr, "kernel_launch: hipFuncSetAttribute failed\n"); grid = -1; return; }
        if (hipOccupancyMaxActiveBlocksPerMultiprocessor(&per_cu, (const void*)mega_fwd, NWAVES * 64, LDS_BYTES) != hipSuccess || per_cu < 1)
            fprintf(stderr, "kernel_launch: occupancy query reports %d workgroups per CU\n", per_cu);
        (void)hipGetLastError();
        grid = cus & ~7;
    }
    if (grid < 0) return;
    (void)hipMemsetAsync((char*)d_ws + WS_CTL, 0, CTL_ZERO_BYTES, stream);
    Args a{};
    for (int i = 0; i < 15; ++i) a.in[i] = (const float*)d_in[i];
    a.out = (float*)d_out; a.ws = (unsigned char*)d_ws;
    a.ph_lo = 0; a.ph_hi = N_PHASES; a.li = 0;
    hipLaunchKernelGGL(mega_fwd, dim3(grid), dim3(NWAVES * 64), LDS_BYTES, stream, a);
}
```

```cpp
#include <hip/hip_runtime.h>
#include <stdint.h>
#include <math.h>
#include <cstdio>
#include <utility>

namespace pg8 {
#define PG8_LAS __attribute__((address_space(3)))
typedef unsigned short bf16_t;
typedef short bf16x8 __attribute__((ext_vector_type(8)));
typedef float f32x4 __attribute__((ext_vector_type(4)));
typedef unsigned u32x4 __attribute__((ext_vector_type(4)));
constexpr int BM = 256, BK = 64, HALF = 128, HTB = HALF * BK * 2  , STAGE_BYTES = 8 * HTB, NXCD = 8, WGM = 8;

__host__ __device__ __forceinline__ int lds_byte(int r, int c) { const int st = (r >> 4) * 2 + (c >> 5), rr = r & 15, cc = c & 31, ob = rr * 64 + cc * 2; return st * 1024 + (ob ^ (((ob >> 9) & 1) << 5)); }
__host__ __device__ __forceinline__ void stage_rc(int b, int& R, int& C) { const int st = b / 1024, sb = b % 1024, swz = sb ^ (((sb >> 9) & 1) << 5); R = (st >> 1) * 16 + swz / 64; C = (st & 1) * 32 + (swz % 64) / 2; }
__host__ __device__ __forceinline__ int perm32(int rho) { const int n = rho >> 4, i = rho & 15; return 8 * (i >> 2) + 4 * n + (i & 3); }

struct Unit { int pm, pn; };
struct Gemm { const bf16_t* A; const bf16_t* Bt; int M, N, K; int sw = 0x7F7F7F7F; };
typedef int v8i __attribute__((ext_vector_type(8)));
__device__ __forceinline__ v8i cat8(bf16x8 a, bf16x8 b) { typedef int v4i __attribute__((ext_vector_type(4))); const v4i x = __builtin_bit_cast(v4i, a), y = __builtin_bit_cast(v4i, b); return __builtin_shufflevector(x, y, 0, 1, 2, 3, 4, 5, 6, 7); }

struct StaticOrder {
    int nM, nN, nwg, G, c;
    __host__ __device__ void init(int M, int N, int G_, int c_) { nM = M / BM; nN = N / BM; nwg = nM * nN; G = G_; c = c_; }
    __host__ __device__ bool next(int i, Unit& u) const {
        const long L = (long)i * G + c; if (L >= nwg) return false;
        int wgid = (int)L; { const int q = nwg / NXCD, r = nwg % NXCD, xcd = wgid % NXCD, off = wgid / NXCD; wgid = (xcd < r ? xcd * (q + 1) : r * (q + 1) + (xcd - r) * q) + off; }
        const int nig = WGM * nN, gid = wgid / nig, fm = gid * WGM, gsz = (nM - fm) < WGM ? (nM - fm) : WGM;
        u.pm = fm + ((wgid % nig) % gsz); u.pn = (wgid % nig) / gsz; return true;
    }
    __device__ __forceinline__ void a_ready(const Unit&) const {}
    __device__ __forceinline__ void done(const Unit&) const {}
};

typedef unsigned u32x4 __attribute__((ext_vector_type(4)));
__device__ __forceinline__ unsigned cvt_pk_bf16(float lo, float hi) { unsigned r; asm volatile("v_cvt_pk_bf16_f32 %0, %1, %2" : "=v"(r) : "v"(lo), "v"(hi)); return r; }
struct EpiBf16 {
    static constexpr bool PERM = true, AFTER_DRAIN = false;
    bf16_t* O; int ldc; const float* rope; int rot_lo, rot_hi; float osc = 1.f;
    __device__ __forceinline__ void operator()(const f32x4 (&acc)[2][2][4][2], const Unit& u, int wr, int wc, int fr, int fq) const {
        const int row0 = u.pm * BM + wr * 64 + fr, colw = wc * 32 + 8 * fq;
        const bool rot = (u.pn >= rot_lo && u.pn < rot_hi);
#pragma unroll
        for (int ai = 0; ai < 2; ++ai)
#pragma unroll
            for (int m = 0; m < 4; ++m) {
                const int row = row0 + ai * HALF + m * 16;
                f32x4 a0 = acc[ai][0][m][0] * osc, a1 = acc[ai][0][m][1] * osc, b0 = acc[ai][1][m][0] * osc, b1 = acc[ai][1][m][1] * osc;
                if (rot) {
                    const f32x4* rp = (const f32x4*)(rope + (size_t)((row & 2047) * 128 + colw) * 2);
                    const f32x4 r0 = rp[0], r1 = rp[1], r2 = rp[2], r3 = rp[3];
                    f32x4 x0, x1, y0, y1;
                    x0[0] = a0[0] * r0[0] - b0[0] * r0[1]; y0[0] = a0[0] * r0[1] + b0[0] * r0[0];
                    x0[1] = a0[1] * r0[2] - b0[1] * r0[3]; y0[1] = a0[1] * r0[3] + b0[1] * r0[2];
                    x0[2] = a0[2] * r1[0] - b0[2] * r1[1]; y0[2] = a0[2] * r1[1] + b0[2] * r1[0];
                    x0[3] = a0[3] * r1[2] - b0[3] * r1[3]; y0[3] = a0[3] * r1[3] + b0[3] * r1[2];
                    x1[0] = a1[0] * r2[0] - b1[0] * r2[1]; y1[0] = a1[0] * r2[1] + b1[0] * r2[0];
                    x1[1] = a1[1] * r2[2] - b1[1] * r2[3]; y1[1] = a1[1] * r2[3] + b1[1] * r2[2];
                    x1[2] = a1[2] * r3[0] - b1[2] * r3[1]; y1[2] = a1[2] * r3[1] + b1[2] * r3[0];
                    x1[3] = a1[3] * r3[2] - b1[3] * r3[3]; y1[3] = a1[3] * r3[3] + b1[3] * r3[2];
                    a0 = x0; a1 = x1; b0 = y0; b1 = y1;
                }
                bf16_t* rowp = O + (size_t)row * ldc + u.pn * BM + colw;
                u32x4 w; w.x = cvt_pk_bf16(a0[0], a0[1]); w.y = cvt_pk_bf16(a0[2], a0[3]); w.z = cvt_pk_bf16(a1[0], a1[1]); w.w = cvt_pk_bf16(a1[2], a1[3]);
                *(u32x4*)(rowp) = w;
                w.x = cvt_pk_bf16(b0[0], b0[1]); w.y = cvt_pk_bf16(b0[2], b0[3]); w.z = cvt_pk_bf16(b1[0], b1[1]); w.w = cvt_pk_bf16(b1[2], b1[3]);
                *(u32x4*)(rowp + HALF) = w;
            }
    }
};
struct EpiResF32 {
    static constexpr bool PERM = false, AFTER_DRAIN = false;
    float* Y; const float* X; int ldc; float alpha;
    __device__ __forceinline__ void operator()(const f32x4 (&acc)[2][2][4][2], const Unit& u, int wr, int wc, int fr, int fq) const {
        const int row0 = u.pm * BM + wr * 64 + fr, col0 = u.pn * BM + wc * 32 + 4 * fq;
#pragma unroll
        for (int ai = 0; ai < 2; ++ai)
#pragma unroll
            for (int m = 0; m < 4; ++m) { const size_t off = (size_t)(row0 + ai * HALF + m * 16) * ldc + col0;
#pragma unroll
                for (int bj = 0; bj < 2; ++bj)
#pragma unroll
                    for (int n = 0; n < 2; ++n) { const size_t o2 = off + bj * HALF + n * 16; const f32x4 xv = *(const f32x4*)(X + o2); *(f32x4*)(Y + o2) = xv * alpha + acc[ai][bj][m][n]; } }
    }
};

struct EpiResStats {
    static constexpr bool PERM = false, AFTER_DRAIN = false;
    bf16_t* Yb; const float* Xf; float* pstat; int ldc; float alpha; float osc = 1.f;
    __device__ __forceinline__ void operator()(const f32x4 (&acc)[2][2][4][2], const Unit& u, int wr, int wc, int fr, int fq) const {
        typedef unsigned u32x2 __attribute__((ext_vector_type(2))); typedef float f32x2v __attribute__((ext_vector_type(2)));
        const int row0 = u.pm * BM + wr * 64 + fr, col0 = u.pn * BM + wc * 32 + 4 * fq;
#pragma unroll
        for (int ai = 0; ai < 2; ++ai) {
            f32x4 xall[4][2][2];
#pragma unroll
            for (int m = 0; m < 4; ++m)
#pragma unroll
                for (int bj = 0; bj < 2; ++bj)
#pragma unroll
                    for (int n = 0; n < 2; ++n) xall[m][bj][n] = *(const f32x4*)(Xf + (size_t)(row0 + ai * HALF + m * 16) * ldc + col0 + bj * HALF + n * 16);
#pragma unroll
            for (int m = 0; m < 4; ++m) { const int row = row0 + ai * HALF + m * 16; const size_t off = (size_t)row * ldc + col0; float s = 0.f, q = 0.f;
#pragma unroll
                for (int bj = 0; bj < 2; ++bj)
#pragma unroll
                    for (int n = 0; n < 2; ++n) { const size_t o2 = off + bj * HALF + n * 16; const f32x4 xv = xall[m][bj][n];
                        const f32x4 y = xv * alpha + acc[ai][bj][m][n] * osc;
                        u32x2 w; w.x = cvt_pk_bf16(y[0], y[1]); w.y = cvt_pk_bf16(y[2], y[3]); *(u32x2*)(Yb + o2) = w;
                        const float y0 = __uint_as_float(w.x << 16), y1 = __uint_as_float(w.x & 0xffff0000u), y2 = __uint_as_float(w.y << 16), y3 = __uint_as_float(w.y & 0xffff0000u);
                        s += (y0 + y1) + (y2 + y3); q += (y0 * y0 + y1 * y1) + (y2 * y2 + y3 * y3); }
                { auto a_ = __builtin_amdgcn_permlane16_swap(__float_as_uint(s), __float_as_uint(s), false, false); s = __uint_as_float(a_[0]) + __uint_as_float(a_[1]);
                  auto b_ = __builtin_amdgcn_permlane32_swap(__float_as_uint(s), __float_as_uint(s), false, false); s = __uint_as_float(b_[0]) + __uint_as_float(b_[1]);
                  auto c_ = __builtin_amdgcn_permlane16_swap(__float_as_uint(q), __float_as_uint(q), false, false); q = __uint_as_float(c_[0]) + __uint_as_float(c_[1]);
                  auto d_ = __builtin_amdgcn_permlane32_swap(__float_as_uint(q), __float_as_uint(q), false, false); q = __uint_as_float(d_[0]) + __uint_as_float(d_[1]); }
                if (fq == 0) *(f32x2v*)(pstat + ((size_t)row * 32 + u.pn * 4 + wc) * 2) = (f32x2v){s, q}; } }
    }
};
struct EpiLnBf16 {
    static constexpr bool PERM = true, AFTER_DRAIN = false;
    bf16_t* O; int ldc; const float* c1; const float* c0; const PG8_LAS float* stat; int pm0;
    const float* pstat; float eps; int ncols;
    __device__ __forceinline__ void operator()(const f32x4 (&acc)[2][2][4][2], const Unit& u, int wr, int wc, int fr, int fq) const {
        const int rl0 = wr * 64 + fr, colw = u.pn * BM + wc * 32 + 8 * fq;
        f32x4 k1[2][2], k0[2][2];
#pragma unroll
        for (int bj = 0; bj < 2; ++bj)
#pragma unroll
            for (int n = 0; n < 2; ++n) { k1[bj][n] = *(const f32x4*)(c1 + colw + bj * HALF + 4 * n); k0[bj][n] = *(const f32x4*)(c0 + colw + bj * HALF + 4 * n); }
#pragma unroll
        for (int ai = 0; ai < 2; ++ai)
#pragma unroll
            for (int m = 0; m < 4; ++m) { const int rl = rl0 + ai * HALF + m * 16, row = u.pm * BM + rl;
                float mu, rs;
                if (u.pm == pm0) { mu = stat[2 * rl]; rs = stat[2 * rl + 1]; }
                else { float s = 0.f, q = 0.f; for (int i = 0; i < 32; ++i) { s += pstat[((size_t)row * 32 + i) * 2]; q += pstat[((size_t)row * 32 + i) * 2 + 1]; }
                    mu = s / (float)ncols; rs = 1.0f / sqrtf(q / (float)ncols - mu * mu + eps); }
                bf16_t* rowp = O + (size_t)row * ldc + colw;
#pragma unroll
                for (int bj = 0; bj < 2; ++bj) { const f32x4 a = (acc[ai][bj][m][0] - k1[bj][0] * mu) * rs + k0[bj][0], b = (acc[ai][bj][m][1] - k1[bj][1] * mu) * rs + k0[bj][1];
                    u32x4 w; w.x = cvt_pk_bf16(a[0], a[1]); w.y = cvt_pk_bf16(a[2], a[3]); w.z = cvt_pk_bf16(b[0], b[1]); w.w = cvt_pk_bf16(b[2], b[3]);
                    *(u32x4*)(rowp + bj * HALF) = w; } }
    }
};
template <class Epi, class Sched, bool ALIGN_EPI = false, bool SP2 = false, bool FP8 = false>
__device__ __forceinline__ void gemm_phase(PG8_LAS unsigned char* lds, const Gemm g, const Sched& S, const Epi& E) {
    const int tid = threadIdx.x, wid = __builtin_amdgcn_readfirstlane(tid >> 6), lane = tid & 63, wr = wid >> 2, wc = wid & 3, fr = lane & 15, fq = lane >> 4;
    const int K = g.K, nt = K / (FP8 ? 2 * BK : BK);
    unsigned voffA[2], voffB[2];
#pragma unroll
    for (int i = 0; i < 2; ++i) { int R, C; stage_rc(tid * 16 + i * 8192, R, C); const int Rb = Epi::PERM ? ((R & ~31) + perm32(R & 31)) : R;
        voffA[i] = FP8 ? (unsigned)(R * K + C * 2) : (unsigned)(R * K + C) * 2u; voffB[i] = FP8 ? (unsigned)(Rb * K + C * 2) : (unsigned)(Rb * K + C) * 2u; }
    const char* const voffA_base = (const char*)g.A; const char* const voffB_base = (const char*)g.Bt;
    const __amdgpu_buffer_rsrc_t voffA_rs = __builtin_amdgcn_make_buffer_rsrc((void*)g.A, 0, 0x7fffffff, 0x00020000), voffB_rs = __builtin_amdgcn_make_buffer_rsrc((void*)g.Bt, 0, 0x7fffffff, 0x00020000);
    const size_t kstep = (size_t)(BK * 2);
    const size_t hstep = (size_t)HALF * K * (FP8 ? 1 : 2);
    const size_t tstep = 2 * hstep;
    const unsigned ldsw = (unsigned)wid * 1024u;
    const int aoff = lds_byte(wr * 64 + fr, fq * 8), boff = lds_byte(wc * 32 + fr, fq * 8);
#define PG8_SA(b, h) (((b) * 2 + (h)) * HTB)
#define PG8_SB(b, h) ((4 + (b) * 2 + (h)) * HTB)
#define PG8_STAGE(bufoff, gbase, voff) do { const unsigned _so = (unsigned)((const char*)(gbase) - voff##_base); _Pragma("unroll") for (int _i = 0; _i < 2; ++_i) \
        __builtin_amdgcn_raw_ptr_buffer_load_lds(voff##_rs, (PG8_LAS void*)(lds + (bufoff) + ldsw + _i * 8192), 16, (int)(voff)[_i], (int)_so, 0, 0); } while (0)
#define PG8_LDA(dst, b, h) do { _Pragma("unroll") for (int m = 0; m < 4; ++m) _Pragma("unroll") for (int k = 0; k < 2; ++k) dst[m][k] = *(const PG8_LAS bf16x8*)(lds + PG8_SA(b, h) + aoff + m * 2048 + k * 1024); } while (0)
#define PG8_LDB(dst, b, h) do { _Pragma("unroll") for (int n = 0; n < 2; ++n) _Pragma("unroll") for (int k = 0; k < 2; ++k) dst[n][k] = *(const PG8_LAS bf16x8*)(lds + PG8_SB(b, h) + boff + n * 2048 + k * 1024); } while (0)
#define PG8_MMA(ai, bj, At, Bt) do { __builtin_amdgcn_s_setprio(1); _Pragma("unroll") for (int m = 0; m < 4; ++m) _Pragma("unroll") for (int n = 0; n < 2; ++n) { \
        if constexpr (FP8) acc[ai][bj][m][n] = __builtin_amdgcn_mfma_scale_f32_16x16x128_f8f6f4(cat8(Bt[n][0], Bt[n][1]), cat8(At[m][0], At[m][1]), acc[ai][bj][m][n], 0, 0, 0, 0, 0, 0); \
        else { _Pragma("unroll") for (int k = 0; k < 2; ++k) acc[ai][bj][m][n] = __builtin_amdgcn_mfma_f32_16x16x32_bf16(Bt[n][k], At[m][k], acc[ai][bj][m][n], 0, 0, 0); } } __builtin_amdgcn_s_setprio(0); } while (0)
#define PG8_WAIT_V(n) asm volatile("s_waitcnt vmcnt(" #n ")" ::: "memory")
#define PG8_WAIT_L(n) asm volatile("s_waitcnt lgkmcnt(" #n ")" ::: "memory")
#define PG8_BAR __builtin_amdgcn_s_barrier()
#define PG8_SCHED __builtin_amdgcn_sched_barrier(0)
    Unit cur, nxt; int ui = 0;
    if (!S.next(0, cur)) return;
    f32x4 acc[2][2][4][2];
#pragma unroll
    for (int a = 0; a < 2; ++a)
#pragma unroll
        for (int b = 0; b < 2; ++b)
#pragma unroll
            for (int m = 0; m < 4; ++m)
#pragma unroll
                for (int n = 0; n < 2; ++n) acc[a][b][m][n] = (f32x4){0.f, 0.f, 0.f, 0.f};
    bf16x8 At[4][2], B0[2][2], B1[2][2];
    const char* cA = (const char*)g.A + (size_t)cur.pm * tstep; const char* cB = (const char*)g.Bt + (size_t)cur.pn * tstep;
    S.a_ready(cur);
    if constexpr (SP2) {
        PG8_STAGE(PG8_SB(0, 0), cB, voffB); PG8_STAGE(PG8_SB(0, 1), cB + hstep, voffB); PG8_STAGE(PG8_SA(0, 0), cA, voffA); PG8_STAGE(PG8_SA(0, 1), cA + hstep, voffA);
        if (wr == 1) PG8_BAR;
        PG8_WAIT_V(2); PG8_BAR;
        PG8_STAGE(PG8_SB(1, 0), cB + kstep, voffB); PG8_STAGE(PG8_SA(1, 0), cA + kstep, voffA); PG8_STAGE(PG8_SB(1, 1), cB + hstep + kstep, voffB);
        PG8_WAIT_V(6); PG8_BAR;
    } else {
        PG8_STAGE(PG8_SB(0, 0), cB, voffB); PG8_STAGE(PG8_SA(0, 0), cA, voffA); PG8_STAGE(PG8_SB(0, 1), cB + hstep, voffB); PG8_STAGE(PG8_SA(0, 1), cA + hstep, voffA);
        if (wr == 1) PG8_BAR;
        PG8_WAIT_V(4); PG8_BAR;
        PG8_STAGE(PG8_SB(1, 0), cB + kstep, voffB); PG8_STAGE(PG8_SA(1, 0), cA + kstep, voffA); PG8_STAGE(PG8_SB(1, 1), cB + hstep + kstep, voffB);
        PG8_WAIT_V(6); PG8_BAR;
    }
    for (;;) {
        const bool has_next = S.next(ui + 1, nxt);
        const char* nA = has_next ? (const char*)g.A + (size_t)nxt.pm * tstep : cA; const char* nB = has_next ? (const char*)g.Bt + (size_t)nxt.pn * tstep : cB;
        for (int t = 0; t < nt; t += 2) {
            const bool last = (t == nt - 2);
            const char* a1 = cA + (size_t)(t + 1) * kstep;
            const char* a2 = last ? nA : cA + (size_t)(t + 2) * kstep; const char* b2 = last ? nB : cB + (size_t)(t + 2) * kstep;
            const char* a3 = a2 + kstep; const char* b3 = b2 + kstep;
            if (last && has_next) S.a_ready(nxt);
            if constexpr (SP2) {
            PG8_LDB(B0, 0, 0); PG8_LDB(B1, 0, 1); PG8_SCHED; PG8_LDA(At, 0, 0); PG8_STAGE(PG8_SA(1, 1), a1 + hstep, voffA);
            PG8_WAIT_V(8); PG8_WAIT_L(0); PG8_BAR; PG8_MMA(0, 0, At, B0); PG8_MMA(0, 1, At, B1); PG8_BAR; PG8_SCHED;
            PG8_LDA(At, 0, 1); PG8_STAGE(PG8_SB(0, 0), b2, voffB); PG8_STAGE(PG8_SB(0, 1), b2 + hstep, voffB); PG8_STAGE(PG8_SA(0, 0), a2, voffA);
            PG8_WAIT_V(8); PG8_WAIT_L(0); PG8_BAR; PG8_MMA(1, 0, At, B0); PG8_MMA(1, 1, At, B1); PG8_BAR; PG8_SCHED;
            PG8_LDB(B0, 1, 0); PG8_LDB(B1, 1, 1); PG8_SCHED; PG8_LDA(At, 1, 0); PG8_STAGE(PG8_SA(0, 1), a2 + hstep, voffA);
            PG8_WAIT_V(8); PG8_WAIT_L(0); PG8_BAR; PG8_MMA(0, 0, At, B0); PG8_MMA(0, 1, At, B1); PG8_BAR; PG8_SCHED;
            PG8_LDA(At, 1, 1); PG8_STAGE(PG8_SB(1, 0), b3, voffB); PG8_STAGE(PG8_SB(1, 1), b3 + hstep, voffB); PG8_STAGE(PG8_SA(1, 0), a3, voffA);
            PG8_WAIT_V(8); PG8_WAIT_L(0); PG8_BAR; PG8_MMA(1, 0, At, B0); PG8_MMA(1, 1, At, B1); PG8_BAR; PG8_SCHED;
            } else {
            PG8_LDB(B0, 0, 0); PG8_SCHED; PG8_LDA(At, 0, 0); PG8_STAGE(PG8_SA(1, 1), a1 + hstep, voffA);
            PG8_WAIT_L(8); PG8_BAR; PG8_WAIT_L(0); PG8_MMA(0, 0, At, B0); PG8_BAR; PG8_SCHED;
            PG8_LDB(B1, 0, 1); PG8_STAGE(PG8_SB(0, 0), b2, voffB);
            PG8_BAR; PG8_WAIT_L(0); PG8_MMA(0, 1, At, B1); PG8_BAR;
            PG8_LDA(At, 0, 1); PG8_STAGE(PG8_SA(0, 0), a2, voffA);
            PG8_BAR; PG8_WAIT_L(0); PG8_MMA(1, 0, At, B0); PG8_BAR; PG8_SCHED;
            PG8_STAGE(PG8_SB(0, 1), b2 + hstep, voffB);
            PG8_WAIT_V(6); PG8_BAR; PG8_MMA(1, 1, At, B1); PG8_BAR;
            PG8_LDB(B0, 1, 0); PG8_SCHED; PG8_LDA(At, 1, 0); PG8_STAGE(PG8_SA(0, 1), a2 + hstep, voffA);
            PG8_WAIT_L(8); PG8_BAR; PG8_WAIT_L(0); PG8_MMA(0, 0, At, B0); PG8_BAR; PG8_SCHED;
            PG8_LDB(B1, 1, 1); PG8_STAGE(PG8_SB(1, 0), b3, voffB);
            PG8_BAR; PG8_WAIT_L(0); PG8_MMA(0, 1, At, B1); PG8_BAR;
            PG8_LDA(At, 1, 1); PG8_STAGE(PG8_SA(1, 0), a3, voffA);
            PG8_BAR; PG8_WAIT_L(0); PG8_MMA(1, 0, At, B0); PG8_BAR; PG8_SCHED;
            PG8_STAGE(PG8_SB(1, 1), b3 + hstep, voffB);
            PG8_WAIT_V(6); PG8_BAR; PG8_MMA(1, 1, At, B1); PG8_BAR;
            }
        }
        if constexpr (ALIGN_EPI) { if (wr == 0) PG8_BAR; }
        if constexpr (!Epi::AFTER_DRAIN) { E(acc, cur, wr, wc, fr, fq); S.done(cur); }
        if (!has_next) break;
#pragma unroll
        for (int a = 0; a < 2; ++a)
#pragma unroll
            for (int b = 0; b < 2; ++b)
#pragma unroll
                for (int m = 0; m < 4; ++m)
#pragma unroll
                    for (int n = 0; n < 2; ++n) acc[a][b][m][n] = (f32x4){0.f, 0.f, 0.f, 0.f};
        cur = nxt; cA = nA; cB = nB; ++ui;
        if constexpr (ALIGN_EPI) { if (wr == 1) PG8_BAR; }
    }
    PG8_WAIT_V(0);
    if constexpr (!ALIGN_EPI) { if (wr == 0) PG8_BAR; }
    PG8_BAR;
    if constexpr (Epi::AFTER_DRAIN) { E.fused(acc, cur, wr, wc, fr, fq, lds, wid, lane); S.done(cur); }
#undef PG8_SA
#undef PG8_SB
#undef PG8_STAGE
#undef PG8_LDA
#undef PG8_LDB
#undef PG8_MMA
#undef PG8_WAIT_V
#undef PG8_WAIT_L
#undef PG8_BAR
#undef PG8_SCHED
}
}
typedef unsigned short bf16_t;
constexpr int D = 2048, BATCH = 4, SEQ = 2048, T = BATCH * SEQ;
constexpr int NPROJ = 7184, NP = 7424;
constexpr int C_GQ = 0, C_GK = 512, C_GV = 1024, C_GR = 2048, C_RQ = 3072, C_RK = 4096, C_RV = 5120, C_RR = 6144, C_GLR = 7168;
constexpr int NCH = 32, CH = 64;
constexpr float ALPHA = 1.189207115002721f;
constexpr float LN_EPS = 1e-5f;
constexpr size_t MiB = 1u << 20;
constexpr size_t WS_CTL = 0, CTL_ZERO_BYTES = 65536, WS_WIN = 1 * MiB, WS_WOUT = 31 * MiB, WS_WQ = 39 * MiB, WS_SKB = 47 * MiB, WS_ROPE = 48 * MiB,
                 WS_UB = 50 * MiB, WS_VB = 114 * MiB, WS_XB = 178 * MiB, WS_PROJ = 210 * MiB, WS_BC = 326 * MiB, WS_UT = 342 * MiB,
                 WS_O = 438 * MiB, WS_X8 = 476 * MiB, WS_END = 492 * MiB;
constexpr size_t WS_Y = 210 * MiB, WS_H1B = 274 * MiB, WS_EXP = 306 * MiB, WS_GATE = 310 * MiB;
constexpr size_t WS_Q = 442 * MiB;
constexpr size_t WS_USC = 47 * MiB + 512 * 1024, WS_VSC = WS_USC + 65536;
constexpr size_t WS_PSTAT = 314 * MiB;
constexpr size_t WS_PD = 342 * MiB, WS_W = 374 * MiB, WS_FFN = 378 * MiB, WS_MURS = 316 * MiB;
constexpr size_t WS_US1 = 47 * MiB + 768 * 1024, WS_US0 = WS_US1 + 65536;
constexpr size_t WS_CPART = 474 * MiB, WS_CFIN = WS_CPART + 512 * 1024;
constexpr size_t UT_RET_OFF = (size_t)16 * 32 * 256 * 128;
constexpr int CW_BAR = 4096;
constexpr int NWAVES = 8;
constexpr int RING_BYTES = 131072, LDSCTL_OFF = RING_BYTES, MISC_OFF = LDSCTL_OFF + 320, LDS_BYTES = 147456;

#define GAS __attribute__((address_space(1)))
#define LAS __attribute__((address_space(3)))
typedef unsigned v4u __attribute__((ext_vector_type(4)));
typedef unsigned v2u __attribute__((ext_vector_type(2)));
typedef float f32x4 __attribute__((ext_vector_type(4)));
typedef float f32x16 __attribute__((ext_vector_type(16)));
typedef short bf16x8 __attribute__((ext_vector_type(8)));
typedef short bf16x4 __attribute__((ext_vector_type(4)));
typedef GAS unsigned gu32;
#define RLX_AGENT __ATOMIC_RELAXED, __HIP_MEMORY_SCOPE_AGENT
#define LDS_WAIT() asm volatile("s_waitcnt lgkmcnt(0)" ::: "memory")
#define VM_WAIT() asm volatile("s_waitcnt vmcnt(0)" ::: "memory")
__device__ __forceinline__ float bf2f(bf16_t v) { return __uint_as_float(((unsigned)v) << 16); }
__device__ __forceinline__ unsigned f2bfu(float f) { unsigned u = __float_as_uint(f); return (u + 0x7fffu + ((u >> 16) & 1u)) >> 16; }
__device__ __forceinline__ bf16_t f2bf(float f) { return (bf16_t)f2bfu(f); }
__device__ __forceinline__ unsigned pk2(float lo, float hi) { return f2bfu(lo) | (f2bfu(hi) << 16); }
__device__ __forceinline__ float bflo(unsigned w) { return __uint_as_float(w << 16); }
__device__ __forceinline__ float bfhi(unsigned w) { return __uint_as_float(w & 0xffff0000u); }
__device__ __forceinline__ float wave_sum(float v) {
#pragma unroll
    for (int o = 1; o < 64; o <<= 1) v += __shfl_xor(v, o);
    return v;
}
__device__ __forceinline__ float gamma_log(int h) { return logf(1.0f - exp2f(-5.0f - (float)h)); }

#define XB_TMO      128
#define XB_XCNT(j)  (256  + 64 * (j))
#define XB_XSUB(j)  (1280 + 64 * (j))
#define XB_XGEN(j)  (2304 + 64 * (j))
#define XB_TOP      3328
#define XB_TOPGEN   3392
#define XCD_BAR_WORDS 3456
#define XB_SPIN_CAP (1u << 18)

__device__ __forceinline__ unsigned xb_ld(unsigned* p)              { return __hip_atomic_load(p, __ATOMIC_RELAXED, __HIP_MEMORY_SCOPE_AGENT); }
__device__ __forceinline__ unsigned xb_add(unsigned* p, unsigned v) { return __hip_atomic_fetch_add(p, v, __ATOMIC_RELAXED, __HIP_MEMORY_SCOPE_AGENT); }
__device__ __forceinline__ unsigned xb_xcc_id() { return (unsigned)__builtin_amdgcn_s_getreg((3 << 11) | 20) & 0xFu; }
#define XB_SPIN(cond, bar) do { unsigned _sp = 0; while (cond) { __builtin_amdgcn_s_sleep(1); \
    if ((++_sp & 255u) == 0u) { if (xb_ld(&(bar)[XB_TMO])) break; if (_sp > XB_SPIN_CAP) { atomicAdd(&(bar)[XB_TMO], 1u); break; } } } } while (0)

struct XcdBarrier {
    unsigned* bar; unsigned x;
    volatile LAS unsigned* st;
};

__device__ __forceinline__ XcdBarrier xcd_barrier_post(unsigned* bar, volatile LAS unsigned* st) {
    XcdBarrier b; b.bar = bar; b.x = xb_xcc_id(); b.st = st;
    if (threadIdx.x == 0) (void)xb_add(&bar[XB_XCNT(b.x)], 1u);
    return b;
}
__device__ __forceinline__ void xcd_barrier_complete(unsigned* bar, unsigned x, unsigned& nloc, unsigned& nx) {
    const unsigned G = gridDim.x * gridDim.y * gridDim.z;
    unsigned sum, cnt, mine, sp = 0u;
    for (;;) {
        sum = 0u; cnt = 0u; mine = 0u;
#pragma unroll
        for (unsigned j = 0; j < 16; ++j) { const unsigned c = xb_ld(&bar[XB_XCNT(j)]); sum += c; cnt += (c > 0u) ? 1u : 0u; mine = (j == x) ? c : mine; }
        if (sum == G) break;
        __builtin_amdgcn_s_sleep(1);
        if ((++sp & 255u) == 0u) { if (xb_ld(&bar[XB_TMO])) break; if (sp > XB_SPIN_CAP) { atomicAdd(&bar[XB_TMO], 1u); break; } }
    }
    nloc = mine > 0u ? mine : 1u; nx = cnt > 0u ? cnt : 1u;
}

__device__ __forceinline__ void xcd_barrier(const XcdBarrier& b) {
    asm volatile("s_waitcnt vmcnt(0)" ::: "memory");
    __syncthreads();
    if (threadIdx.x == 0) {
        unsigned* bar = b.bar;
        __builtin_amdgcn_s_waitcnt(0);
        unsigned nloc = b.st[0], nx = b.st[1];
        if (nloc == 0u) { xcd_barrier_complete(bar, b.x, nloc, nx); b.st[0] = nloc; b.st[1] = nx; }
        const unsigned old = xb_add(&bar[XB_XSUB(b.x)], 1u);
        const unsigned gen = old / nloc;
        if (old + 1u == (gen + 1u) * nloc) {
            __builtin_amdgcn_fence(__ATOMIC_RELEASE, "agent");
            asm volatile("s_waitcnt vmcnt(0)" ::: "memory");
            const unsigned og = xb_add(&bar[XB_TOP], 1u);
            const unsigned tg = og / nx;
            if (og + 1u == (tg + 1u) * nx) xb_add(&bar[XB_TOPGEN], 1u);
            else XB_SPIN(xb_ld(&bar[XB_TOPGEN]) == tg, bar);
            __builtin_amdgcn_fence(__ATOMIC_ACQUIRE, "agent");
            xb_add(&bar[XB_XGEN(b.x)], 1u);
            asm volatile("s_waitcnt vmcnt(0)" ::: "memory");
        } else {
            XB_SPIN(xb_ld(&bar[XB_XGEN(b.x)]) == gen, bar);
            __builtin_amdgcn_fence(__ATOMIC_ACQUIRE, "agent");
            asm volatile("s_waitcnt vmcnt(0)" ::: "memory");
        }
    }
    __syncthreads();
}
struct Frame {
    LAS unsigned char* lds;
    int tid, lane, wave, vcu, G;
};
struct Args { const float* in[15]; float* out; unsigned char* ws; int ph_lo, ph_hi, li, pad; };

template <int CTRL> __device__ __forceinline__ float dppf(float x) { return __builtin_bit_cast(float, __builtin_amdgcn_mov_dpp(__builtin_bit_cast(int, x), CTRL, 0xf, 0xf, true)); }
__device__ __forceinline__ float wave_sum_dpp(float x) {
    x += dppf<0xB1>(x); x += dppf<0x4E>(x); x += dppf<0x141>(x); x += dppf<0x128>(x);
    auto s = __builtin_amdgcn_permlane16_swap(__float_as_uint(x), __float_as_uint(x), false, false);
    x = __uint_as_float(s[0]) + __uint_as_float(s[1]);
    auto t = __builtin_amdgcn_permlane32_swap(__float_as_uint(x), __float_as_uint(x), false, false);
    return __uint_as_float(t[0]) + __uint_as_float(t[1]);
}
__device__ __forceinline__ float wave_max_dpp(float x) {
    x = fmaxf(x, dppf<0xB1>(x)); x = fmaxf(x, dppf<0x4E>(x)); x = fmaxf(x, dppf<0x141>(x)); x = fmaxf(x, dppf<0x128>(x));
    auto s = __builtin_amdgcn_permlane16_swap(__float_as_uint(x), __float_as_uint(x), false, false);
    x = fmaxf(__uint_as_float(s[0]), __uint_as_float(s[1]));
    auto t = __builtin_amdgcn_permlane32_swap(__float_as_uint(x), __float_as_uint(x), false, false);
    return fmaxf(__uint_as_float(t[0]), __uint_as_float(t[1]));
}

__device__ __forceinline__ unsigned fp8x4(float a, float b, float c, float d) {
    a = __builtin_amdgcn_fmed3f(a, -448.f, 448.f); b = __builtin_amdgcn_fmed3f(b, -448.f, 448.f); c = __builtin_amdgcn_fmed3f(c, -448.f, 448.f); d = __builtin_amdgcn_fmed3f(d, -448.f, 448.f);
    int r = __builtin_amdgcn_cvt_pk_fp8_f32(a, b, 0, false); r = __builtin_amdgcn_cvt_pk_fp8_f32(c, d, r, true); return (unsigned)r; }
__device__ __forceinline__ unsigned lds_addr(const LAS unsigned char* p) { return (unsigned)(unsigned long)p; }
__device__ __forceinline__ unsigned tr_lane_off(int lane, int S) { const int h = lane >> 5, blk = (lane >> 4) & 1, q = (lane & 15) >> 2, p = lane & 3; return (unsigned)((8 * h + q) * S + 32 * blk + 8 * p); }
template <int OFF0, int OFF1> __device__ __forceinline__ bf16x8 tr_frag(unsigned base) {
    bf16x4 lo, hi;
    asm volatile("ds_read_b64_tr_b16 %0, %2 offset:%3\n\tds_read_b64_tr_b16 %1, %2 offset:%4\n\ts_waitcnt lgkmcnt(0)" : "=&v"(lo), "=&v"(hi) : "v"(base), "i"(OFF0), "i"(OFF1) : "memory");
    return __builtin_shufflevector(lo, hi, 0, 1, 2, 3, 4, 5, 6, 7);
}
__device__ __forceinline__ bf16x8 row_frag(const LAS unsigned char* tile, int S, int row0, int s, int lane) {
    return *(const LAS bf16x8*)(tile + (row0 + (lane & 31)) * S + 32 * s + 16 * (lane >> 5));
}
template <int W, int S> __device__ __forceinline__ void stage_tile(LAS unsigned char* dst, const bf16_t* src, int tid) {
    constexpr int PPR = W / 8;
#pragma unroll
    for (int i = 0; i < 64 * PPR / 512; ++i) { const int pi = tid + 512 * i, r = pi / PPR, c = pi % PPR;
        const v4u v = *(const GAS v4u*)(src + (size_t)r * NP + c * 8); *(LAS v4u*)(dst + r * S + c * 16) = v; }
}
__device__ __forceinline__ void unit_head(int item, int& bchunk, int& head) { bchunk = item >> 3; head = ((item & 7) + 4 * ((item >> 8) & 1)) & 7; }
constexpr int SV = 576, SK128 = 320, SQ128 = 272, SQ256 = 528, SP = 144, SO = 1040;

constexpr int P2_V = 0, P2_K = 36864, P2_SB = 73728, P2_GLR = 106496, P2_GTOT = 110592;
__device__ __forceinline__ void chunk_u_phase(const Frame& F, const bf16_t* PROJ, const float* wg, const float* bg, float* BC, bf16_t* UT) {
    const int tid = F.tid, lane = F.lane, w = F.wave;
    LAS unsigned char* L = F.lds;
    for (int item = F.vcu; item < BATCH * NCH * 8; item += F.G) {
        int bchunk, head; unit_head(item, bchunk, head);
        const int b = bchunk / NCH, ch = bchunk % NCH, t0 = b * SEQ + ch * CH;
        const bf16_t* prow = PROJ + (size_t)t0 * NP;
        if (head < 4) {
            const int h = head;
            stage_tile<256, SV>(L + P2_V, prow + C_GV + h * 256, tid);
            for (int i = tid; i < 64 * 16; i += 512) ((LAS float*)(L + P2_GLR))[i] = bf2f(prow[(size_t)(i >> 4) * NP + C_GLR + (i & 15)]);
            const int d = tid & 127, cg = tid >> 7;
            float wc[16];
#pragma unroll
            for (int r = 0; r < 16; ++r) wc[r] = wg[r * 512 + h * 128 + d];
            const float bias = bg[h * 128 + d];
            __syncthreads();
            float run = 0.f;
            LAS float* sb = (LAS float*)(L + P2_SB);
#pragma unroll 4
            for (int cc = 0; cc < 16; ++cc) { const int c = cg * 16 + cc; const LAS f32x4* gp = (const LAS f32x4*)(L + P2_GLR + c * 64);
                float z = bias;
#pragma unroll
                for (int r4 = 0; r4 < 4; ++r4) { const f32x4 gv = gp[r4]; z = fmaf(gv[0], wc[4 * r4], z); z = fmaf(gv[1], wc[4 * r4 + 1], z); z = fmaf(gv[2], wc[4 * r4 + 2], z); z = fmaf(gv[3], wc[4 * r4 + 3], z); }
                const float ls = fminf(z, 0.f) - __logf(1.0f + __expf(-fabsf(z)));
                run += ls * (1.0f / 16.0f); sb[c * 128 + d] = run; }
            ((LAS float*)(L + P2_GTOT))[cg * 128 + d] = run;
            __syncthreads();
            float off = 0.f;
#pragma unroll
            for (int g = 0; g < 3; ++g) off += (g < cg) ? ((LAS float*)(L + P2_GTOT))[g * 128 + d] : 0.f;
#pragma unroll 4
            for (int cc = 0; cc < 16; ++cc) { const int c = cg * 16 + cc; const float v = sb[c * 128 + d] + off; sb[c * 128 + d] = v; BC[(size_t)(t0 + c) * 512 + h * 128 + d] = v; }
            __syncthreads();
#pragma unroll
            for (int i = 0; i < 2; ++i) { const int pi = tid + 512 * i, c = pi >> 4, d0 = (pi & 15) * 8;
                const v4u kv = *(const GAS v4u*)(prow + (size_t)c * NP + C_GK + h * 128 + d0);
                const f32x4 b0 = *(const LAS f32x4*)(sb + c * 128 + d0), b1 = *(const LAS f32x4*)(sb + c * 128 + d0 + 4);
                const f32x4 l0 = *(const LAS f32x4*)(sb + 63 * 128 + d0), l1 = *(const LAS f32x4*)(sb + 63 * 128 + d0 + 4);
                v4u o;
                o.x = pk2(bflo(kv.x) * __expf(l0[0] - b0[0]), bfhi(kv.x) * __expf(l0[1] - b0[1])); o.y = pk2(bflo(kv.y) * __expf(l0[2] - b0[2]), bfhi(kv.y) * __expf(l0[3] - b0[3]));
                o.z = pk2(bflo(kv.z) * __expf(l1[0] - b1[0]), bfhi(kv.z) * __expf(l1[1] - b1[1])); o.w = pk2(bflo(kv.w) * __expf(l1[2] - b1[2]), bfhi(kv.w) * __expf(l1[3] - b1[3]));
                *(LAS v4u*)(L + P2_K + c * SK128 + d0 * 2) = o; }
            __syncthreads();
            f32x16 acc[4];
#pragma unroll
            for (int i = 0; i < 4; ++i)
#pragma unroll
                for (int r = 0; r < 16; ++r) acc[i][r] = 0.f;
            const unsigned vb = lds_addr(L + P2_V) + tr_lane_off(lane, SV) + 64 * w, kb = lds_addr(L + P2_K) + tr_lane_off(lane, SK128);
#define P2G_STEP(ks) { const bf16x8 a = tr_frag<16 * (ks) * SV, 16 * (ks) * SV + 4 * SV>(vb); \
                acc[0] = __builtin_amdgcn_mfma_f32_32x32x16_bf16(a, tr_frag<16 * (ks) * SK128 + 0, 16 * (ks) * SK128 + 0 + 4 * SK128>(kb), acc[0], 0, 0, 0); \
                acc[1] = __builtin_amdgcn_mfma_f32_32x32x16_bf16(a, tr_frag<16 * (ks) * SK128 + 64, 16 * (ks) * SK128 + 64 + 4 * SK128>(kb), acc[1], 0, 0, 0); \
                acc[2] = __builtin_amdgcn_mfma_f32_32x32x16_bf16(a, tr_frag<16 * (ks) * SK128 + 128, 16 * (ks) * SK128 + 128 + 4 * SK128>(kb), acc[2], 0, 0, 0); \
                acc[3] = __builtin_amdgcn_mfma_f32_32x32x16_bf16(a, tr_frag<16 * (ks) * SK128 + 192, 16 * (ks) * SK128 + 192 + 4 * SK128>(kb), acc[3], 0, 0, 0); }
            P2G_STEP(0) P2G_STEP(1) P2G_STEP(2) P2G_STEP(3)
#undef P2G_STEP
            bf16_t* o = UT + ((size_t)(b * 4 + h) * NCH + ch) * 256 * 128;
#pragma unroll
            for (int rg = 0; rg < 4; ++rg) { bf16_t* pr = o + (size_t)(32 * w + 8 * rg + 4 * (lane >> 5)) * 128 + (lane & 31);
#pragma unroll
                for (int r3 = 0; r3 < 4; ++r3)
#pragma unroll
                    for (int i = 0; i < 4; ++i) pr[r3 * 128 + 32 * i] = (bf16_t)pg8::cvt_pk_bf16(acc[i][rg * 4 + r3], 0.f);
                asm volatile("" ::: "memory"); }
        } else {
            const int h = head - 4; const float lg2 = gamma_log(h) * 1.4426950408889634f;
            stage_tile<256, SV>(L + P2_V, prow + C_RV + h * 256, tid);
#pragma unroll
            for (int i = 0; i < 4; ++i) { const int pi = tid + 512 * i, c = pi >> 5, d0 = (pi & 31) * 8;
                const v4u kv = *(const GAS v4u*)(prow + (size_t)c * NP + C_RK + h * 256 + d0);
                const float sc = exp2f(lg2 * (float)(63 - c));
                v4u o; o.x = pk2(bflo(kv.x) * sc, bfhi(kv.x) * sc); o.y = pk2(bflo(kv.y) * sc, bfhi(kv.y) * sc); o.z = pk2(bflo(kv.z) * sc, bfhi(kv.z) * sc); o.w = pk2(bflo(kv.w) * sc, bfhi(kv.w) * sc);
                *(LAS v4u*)(L + P2_K + c * SV + d0 * 2) = o; }
            __syncthreads();
            f32x16 acc[8];
#pragma unroll
            for (int i = 0; i < 8; ++i)
#pragma unroll
                for (int r = 0; r < 16; ++r) acc[i][r] = 0.f;
            const unsigned vb = lds_addr(L + P2_V) + tr_lane_off(lane, SV) + 64 * w, kb = lds_addr(L + P2_K) + tr_lane_off(lane, SV);
#define P2R_MM(ks, dt) acc[dt] = __builtin_amdgcn_mfma_f32_32x32x16_bf16(a, tr_frag<16 * (ks) * SV + 64 * (dt), 16 * (ks) * SV + 64 * (dt) + 4 * SV>(kb), acc[dt], 0, 0, 0);
#define P2R_STEP(ks) { const bf16x8 a = tr_frag<16 * (ks) * SV, 16 * (ks) * SV + 4 * SV>(vb); P2R_MM(ks, 0) P2R_MM(ks, 1) P2R_MM(ks, 2) P2R_MM(ks, 3) P2R_MM(ks, 4) P2R_MM(ks, 5) P2R_MM(ks, 6) P2R_MM(ks, 7) }
            P2R_STEP(0) P2R_STEP(1) P2R_STEP(2) P2R_STEP(3)
#undef P2R_STEP
#undef P2R_MM
            bf16_t* o = UT + UT_RET_OFF + ((size_t)(b * 4 + h) * NCH + ch) * 256 * 256;
#pragma unroll
            for (int rg = 0; rg < 4; ++rg) { bf16_t* pr = o + (size_t)(32 * w + 8 * rg + 4 * (lane >> 5)) * 256 + (lane & 31);
#pragma unroll
                for (int r3 = 0; r3 < 4; ++r3)
#pragma unroll
                    for (int i = 0; i < 8; ++i) pr[r3 * 256 + 32 * i] = (bf16_t)pg8::cvt_pk_bf16(acc[i][rg * 4 + r3], 0.f);
                asm volatile("" ::: "memory"); }
        }
        __syncthreads();
    }
}

constexpr int P4_QP = 0, P4_QM = 17408, P4_KP = 34816, P4_KM = 52224, P4_RQ = 0, P4_RK = 33792, P4_V = 69632, P4_P = 106496, P4_O = 0;
__device__ __forceinline__ void chunk_o_phase(const Frame& F, const bf16_t* PROJ, const float* BC, const bf16_t* ST, const float* gla_g, const float* ret_g, bf16_t* O) {
    const int tid = F.tid, lane = F.lane, w = F.wave, hh = lane >> 5;
    LAS unsigned char* L = F.lds;
    v4u pf[12];
#define P4_PREFETCH(item_) do { int bc_, hd_; unit_head((item_), bc_, hd_); const int t0_ = (bc_ / NCH) * SEQ + (bc_ % NCH) * CH, h_ = hd_ & 3; const bf16_t* pr_ = PROJ + (size_t)t0_ * NP; \
        if (hd_ < 4) { _Pragma("unroll") for (int i_ = 0; i_ < 4; ++i_) { const int pi_ = tid + 512 * i_, r_ = pi_ >> 5, c_ = pi_ & 31; pf[i_] = *(const GAS v4u*)(pr_ + (size_t)r_ * NP + C_GV + h_ * 256 + c_ * 8); } \
            _Pragma("unroll") for (int i_ = 0; i_ < 2; ++i_) { const int pi_ = tid + 512 * i_, c_ = pi_ >> 4, d0_ = (pi_ & 15) * 8; \
                pf[4 + i_] = *(const GAS v4u*)(pr_ + (size_t)c_ * NP + C_GQ + h_ * 128 + d0_); pf[6 + i_] = *(const GAS v4u*)(pr_ + (size_t)c_ * NP + C_GK + h_ * 128 + d0_); \
                const GAS v4u* bp_ = (const GAS v4u*)(BC + (size_t)(t0_ + c_) * 512 + h_ * 128 + d0_); pf[8 + 2 * i_] = bp_[0]; pf[9 + 2 * i_] = bp_[1]; } } \
        else { _Pragma("unroll") for (int i_ = 0; i_ < 4; ++i_) { const int pi_ = tid + 512 * i_, r_ = pi_ >> 5, c_ = pi_ & 31; const bf16_t* p_ = pr_ + (size_t)r_ * NP + h_ * 256 + c_ * 8; \
                pf[i_] = *(const GAS v4u*)(p_ + C_RV); pf[4 + i_] = *(const GAS v4u*)(p_ + C_RQ); pf[8 + i_] = *(const GAS v4u*)(p_ + C_RK); } } } while (0)
    if (F.vcu < BATCH * NCH * 8) P4_PREFETCH(F.vcu);
    for (int item = F.vcu; item < BATCH * NCH * 8; item += F.G) {
        int bchunk, head; unit_head(item, bchunk, head);
        const int b = bchunk / NCH, ch = bchunk % NCH, t0 = b * SEQ + ch * CH;
        const bf16_t* prow = PROJ + (size_t)t0 * NP;
        f32x16 acc[2];
#pragma unroll
        for (int i = 0; i < 2; ++i)
#pragma unroll
            for (int r = 0; r < 16; ++r) acc[i][r] = 0.f;
        const bool gla = head < 4; const int h = head & 3;
        if (gla) {
#pragma unroll
            for (int i = 0; i < 4; ++i) { const int pi = tid + 512 * i, r = pi >> 5, c = pi & 31; *(LAS v4u*)(L + P4_V + r * SV + c * 16) = pf[i]; }
#pragma unroll
            for (int i = 0; i < 2; ++i) { const int pi = tid + 512 * i, c = pi >> 4, d0 = (pi & 15) * 8;
                const v4u qv = pf[4 + i], kv = pf[6 + i];
                const f32x4 b0 = __builtin_bit_cast(f32x4, pf[8 + 2 * i]), b1 = __builtin_bit_cast(f32x4, pf[9 + 2 * i]);
                float eb[8], em[8];
#pragma unroll
                for (int j = 0; j < 4; ++j) { eb[j] = __expf(b0[j]); eb[4 + j] = __expf(b1[j]); em[j] = __expf(-b0[j]); em[4 + j] = __expf(-b1[j]); }
                const unsigned qa[4] = {qv.x, qv.y, qv.z, qv.w}, ka[4] = {kv.x, kv.y, kv.z, kv.w};
                v4u qp, qm, kp, km;
#pragma unroll
                for (int j = 0; j < 4; ++j) { const float q0 = bflo(qa[j]), q1 = bfhi(qa[j]), k0 = bflo(ka[j]), k1 = bfhi(ka[j]);
                    qp[j] = pk2(q0 * eb[2 * j], q1 * eb[2 * j + 1]); qm[j] = pk2(q0 * em[2 * j], q1 * em[2 * j + 1]);
                    kp[j] = pk2(k0 * eb[2 * j], k1 * eb[2 * j + 1]); km[j] = pk2(k0 * em[2 * j], k1 * em[2 * j + 1]); }
                const int lo = c * SQ128 + d0 * 2;
                *(LAS v4u*)(L + P4_QP + lo) = qp; *(LAS v4u*)(L + P4_QM + lo) = qm; *(LAS v4u*)(L + P4_KP + lo) = kp; *(LAS v4u*)(L + P4_KM + lo) = km; }
            __syncthreads();
            if (w < 4) {
                const int ti = w >> 1, tj = w & 1;
                f32x16 s1, s2;
#pragma unroll
                for (int r = 0; r < 16; ++r) { s1[r] = 0.f; s2[r] = 0.f; }
                if (ti >= tj) {
#pragma unroll
                    for (int s = 0; s < 8; ++s) s1 = __builtin_amdgcn_mfma_f32_32x32x16_bf16(row_frag(L + P4_QP, SQ128, 32 * ti, s, lane), row_frag(L + P4_KM, SQ128, 32 * tj, s, lane), s1, 0, 0, 0);
                }
                if (ti <= tj) {
#pragma unroll
                    for (int s = 0; s < 8; ++s) s2 = __builtin_amdgcn_mfma_f32_32x32x16_bf16(row_frag(L + P4_QM, SQ128, 32 * ti, s, lane), row_frag(L + P4_KP, SQ128, 32 * tj, s, lane), s2, 0, 0, 0);
                }
                const int m = 32 * tj + (lane & 31);
#pragma unroll
                for (int r = 0; r < 16; ++r) { const int n = 32 * ti + (r & 3) + 8 * (r >> 2) + 4 * hh;
                    *(LAS bf16_t*)(L + P4_P + n * SP + m * 2) = f2bf(n >= m ? s1[r] : s2[r]); }
            }
            {
                const bf16_t* sp = ST + ((size_t)(b * 4 + h) * NCH + ch) * 256 * 128 + (size_t)(32 * w + (lane & 31)) * 128 + 8 * hh;
#pragma unroll
                for (int s = 0; s < 8; ++s) { const bf16x8 bs = *(const GAS bf16x8*)(sp + 16 * s);
                    acc[0] = __builtin_amdgcn_mfma_f32_32x32x16_bf16(row_frag(L + P4_QP, SQ128, 0, s, lane), bs, acc[0], 0, 0, 0);
                    acc[1] = __builtin_amdgcn_mfma_f32_32x32x16_bf16(row_frag(L + P4_QP, SQ128, 32, s, lane), bs, acc[1], 0, 0, 0); }
            }
        } else {
#pragma unroll
            for (int i = 0; i < 4; ++i) { const int pi = tid + 512 * i, r = pi >> 5, c = pi & 31;
                *(LAS v4u*)(L + P4_V + r * SV + c * 16) = pf[i]; *(LAS v4u*)(L + P4_RQ + r * SQ256 + c * 16) = pf[4 + i]; *(LAS v4u*)(L + P4_RK + r * SQ256 + c * 16) = pf[8 + i]; }
            __syncthreads();
            const float lg2 = gamma_log(h) * 1.4426950408889634f;
            if (w < 4) {
                const int ti = w >> 1, tj = w & 1;
                f32x16 s1;
#pragma unroll
                for (int r = 0; r < 16; ++r) s1[r] = 0.f;
#pragma unroll
                for (int s = 0; s < 16; ++s) s1 = __builtin_amdgcn_mfma_f32_32x32x16_bf16(row_frag(L + P4_RQ, SQ256, 32 * ti, s, lane), row_frag(L + P4_RK, SQ256, 32 * tj, s, lane), s1, 0, 0, 0);
                const int m = 32 * tj + (lane & 31);
#pragma unroll
                for (int r = 0; r < 16; ++r) { const int n = 32 * ti + (r & 3) + 8 * (r >> 2) + 4 * hh; const int dn = n > m ? n - m : m - n;
                    *(LAS bf16_t*)(L + P4_P + n * SP + m * 2) = f2bf(s1[r] * exp2f(lg2 * (float)dn)); }
            }
            {
                const bf16_t* sp = ST + UT_RET_OFF + ((size_t)(b * 4 + h) * NCH + ch) * 256 * 256 + (size_t)(32 * w + (lane & 31)) * 256 + 8 * hh;
#pragma unroll 8
                for (int s = 0; s < 16; ++s) { const bf16x8 bs = *(const GAS bf16x8*)(sp + 16 * s);
                    acc[0] = __builtin_amdgcn_mfma_f32_32x32x16_bf16(row_frag(L + P4_RQ, SQ256, 0, s, lane), bs, acc[0], 0, 0, 0);
                    acc[1] = __builtin_amdgcn_mfma_f32_32x32x16_bf16(row_frag(L + P4_RQ, SQ256, 32, s, lane), bs, acc[1], 0, 0, 0); }
#pragma unroll
                for (int i = 0; i < 2; ++i)
#pragma unroll
                    for (int r = 0; r < 16; ++r) { const int n = 32 * i + (r & 3) + 8 * (r >> 2) + 4 * hh; acc[i][r] *= exp2f(lg2 * (float)(n + 1)); }
            }
        }
        __syncthreads();
        if (item + F.G < BATCH * NCH * 8) P4_PREFETCH(item + F.G);
        {
            const unsigned vb = lds_addr(L + P4_V) + tr_lane_off(lane, SV) + 64 * w;
#define P4_STEP(ks) { const bf16x8 bv = tr_frag<16 * (ks) * SV, 16 * (ks) * SV + 4 * SV>(vb); \
                acc[0] = __builtin_amdgcn_mfma_f32_32x32x16_bf16(row_frag(L + P4_P, SP, 0, ks, lane), bv, acc[0], 0, 0, 0); \
                acc[1] = __builtin_amdgcn_mfma_f32_32x32x16_bf16(row_frag(L + P4_P, SP, 32, ks, lane), bv, acc[1], 0, 0, 0); }
            P4_STEP(0) P4_STEP(1) P4_STEP(2) P4_STEP(3)
#undef P4_STEP
        }
        v2u gwall[8];
        {   const int gcol_ = (gla ? C_GR : C_RR) + h * 256 + 4 * lane;
#pragma unroll
            for (int rr = 0; rr < 8; ++rr) gwall[rr] = *(const GAS v2u*)(prow + (size_t)(8 * w + rr) * NP + gcol_); }
        __syncthreads();
#pragma unroll
        for (int i = 0; i < 2; ++i)
#pragma unroll
            for (int r = 0; r < 16; ++r) { const int n = 32 * i + (r & 3) + 8 * (r >> 2) + 4 * hh; *(LAS float*)(L + P4_O + n * SO + (32 * w + (lane & 31)) * 4) = acc[i][r]; }
        __syncthreads();
        {
            const f32x4 gn = *(const GAS f32x4*)((gla ? gla_g : ret_g) + h * 256 + 4 * lane);
            const int gcol = (gla ? C_GR : C_RR) + h * 256 + 4 * lane, ocol = (gla ? 0 : 1024) + h * 256 + 4 * lane;
#pragma unroll
            for (int rr = 0; rr < 8; ++rr) { const int n = 8 * w + rr;
                f32x4 v = *(const LAS f32x4*)(L + P4_O + n * SO + lane * 16);
                if (!gla) { const float mu = wave_sum_dpp((v[0] + v[1]) + (v[2] + v[3])) * (1.0f / 256.0f); v = v - mu; }
                const float ss = wave_sum_dpp((v[0] * v[0] + v[1] * v[1]) + (v[2] * v[2] + v[3] * v[3]));
                const float rs = rsqrtf(ss * (1.0f / 256.0f) + LN_EPS);
                const v2u gw = gwall[rr];
                const float g0 = bflo(gw.x), g1 = bfhi(gw.x), g2 = bflo(gw.y), g3 = bfhi(gw.y);
                const float o0 = v[0] * rs * gn[0] * g0 / (1.0f + __expf(-g0)), o1 = v[1] * rs * gn[1] * g1 / (1.0f + __expf(-g1));
                const float o2 = v[2] * rs * gn[2] * g2 / (1.0f + __expf(-g2)), o3 = v[3] * rs * gn[3] * g3 / (1.0f + __expf(-g3));
                *(GAS unsigned*)((unsigned char*)O + (size_t)(t0 + n) * D + ocol) = fp8x4(o0, o1, o2, o3); }
        }
        __syncthreads();
    }
#undef P4_PREFETCH
}
__device__ __forceinline__ void scan_phase(const Frame& F, bf16_t* UT, const float* BC, const float* cpart, float* cfin) {
    float cf[32]; const bool docf = F.tid < 16 && F.vcu * 8 < D; const int cfn = F.vcu * 8 + (F.tid & 7), cfw = (F.tid >> 3) & 1;
    if (docf) {
#pragma unroll
        for (int kb = 0; kb < 32; ++kb) cf[kb] = cpart[((size_t)kb * 2 + cfw) * D + cfn]; }
    const size_t gtid = (size_t)F.vcu * (NWAVES * 64) + F.tid, gthreads = (size_t)F.G * (NWAVES * 64);
    constexpr size_t NG4 = (size_t)16 * 256 * 128 / 4, NR4 = (size_t)16 * 256 * 256 / 4;
    for (size_t it = gtid; it < NG4 + NR4; it += gthreads) {
        float s0 = 0.f, s1 = 0.f, s2 = 0.f, s3 = 0.f;
        if (it < NG4) {
            const size_t el = it * 4; const int bh = (int)(el >> 15), d = (int)(el & 127), b = bh >> 2, h = bh & 3;
            GAS v2u* p = (GAS v2u*)(UT + (size_t)bh * NCH * 32768 + (el & 32767));
            const GAS f32x4* bp = (const GAS f32x4*)(BC + (size_t)(b * SEQ + 63) * 512 + h * 128 + d);
#pragma unroll 4
            for (int i = 0; i < NCH; ++i) {
                const v2u u = p[(size_t)i * (32768 / 4)]; const f32x4 bl = bp[(size_t)i * (CH * 512 / 4)];
                v2u o; o.x = pk2(s0, s1); o.y = pk2(s2, s3); p[(size_t)i * (32768 / 4)] = o;
                s0 = fmaf(__expf(bl[0]), s0, bflo(u.x)); s1 = fmaf(__expf(bl[1]), s1, bfhi(u.x)); s2 = fmaf(__expf(bl[2]), s2, bflo(u.y)); s3 = fmaf(__expf(bl[3]), s3, bfhi(u.y));
            }
        } else {
            const size_t el = (it - NG4) * 4; const int bh = (int)(el >> 16), h = bh & 3;
            GAS v2u* p = (GAS v2u*)(UT + UT_RET_OFF + (size_t)bh * NCH * 65536 + (el & 65535));
            const float dec = __expf(gamma_log(h) * 64.0f);
#pragma unroll 4
            for (int i = 0; i < NCH; ++i) {
                const v2u u = p[(size_t)i * (65536 / 4)];
                v2u o; o.x = pk2(s0, s1); o.y = pk2(s2, s3); p[(size_t)i * (65536 / 4)] = o;
                s0 = fmaf(dec, s0, bflo(u.x)); s1 = fmaf(dec, s1, bfhi(u.x)); s2 = fmaf(dec, s2, bflo(u.y)); s3 = fmaf(dec, s3, bfhi(u.y));
            }
        }
    }
    if (docf) { float s = 0.f;
#pragma unroll
        for (int kb = 0; kb < 32; ++kb) s += cf[kb];
        cfin[cfw * D + cfn] = s; }
}

template <int N> __device__ __forceinline__ void bitonic_sort_desc(float (&v)[N]) {
#pragma unroll
    for (int k = 2; k <= N; k <<= 1)
#pragma unroll
        for (int j = k >> 1; j > 0; j >>= 1)
#pragma unroll
            for (int i = 0; i < N; ++i) { const int l = i ^ j;
                if (l > i) { const bool desc = (i & k) == 0; const float hi = fmaxf(v[i], v[l]), lo = fminf(v[i], v[l]); v[i] = desc ? hi : lo; v[l] = desc ? lo : hi; } }
}
__device__ __forceinline__ void merge_top16(float (&a)[16], const float (&b)[16]) {
#pragma unroll
    for (int i = 0; i < 16; ++i) a[i] = fmaxf(a[i], b[15 - i]);
#pragma unroll
    for (int j = 8; j > 0; j >>= 1)
#pragma unroll
        for (int i = 0; i < 16; ++i) { const int l = i ^ j; if (l > i) { const float hi = fmaxf(a[i], a[l]), lo = fminf(a[i], a[l]); a[i] = hi; a[l] = lo; } }
}
__device__ __forceinline__ void merge_partner16(float (&a)[16]) {
    float b[16];
#pragma unroll
    for (int i = 0; i < 16; ++i) b[i] = __shfl_xor(a[i], 32);
    merge_top16(a, b);
}
template <int N> __device__ __forceinline__ void topk16_joint(float (&v)[N], float (&out)[16]);
template <> __device__ __forceinline__ void topk16_joint<64>(float (&v)[64], float (&out)[16]) {
    float g[4][16];
#pragma unroll
    for (int q = 0; q < 4; ++q) {
#pragma unroll
        for (int i = 0; i < 16; ++i) g[q][i] = v[16 * q + i];
        bitonic_sort_desc<16>(g[q]); }
    merge_top16(g[0], g[1]); merge_top16(g[2], g[3]); merge_top16(g[0], g[2]);
    merge_partner16(g[0]);
#pragma unroll
    for (int i = 0; i < 16; ++i) out[i] = g[0][i];
}
template <> __device__ __forceinline__ void topk16_joint<25>(float (&v)[25], float (&out)[16]) {
    float w[32];
#pragma unroll
    for (int i = 0; i < 32; ++i) w[i] = i < 25 ? v[i] : -INFINITY;
    bitonic_sort_desc<32>(w);
#pragma unroll
    for (int i = 0; i < 16; ++i) out[i] = w[i];
    merge_partner16(out);
}
struct CandTab { int ci[50], cj[50]; };
constexpr CandTab make_cands() { CandTab t{}; int n = 0; for (int i = 0; i < 16; ++i) for (int j = 0; j < 16; ++j) if ((i + 1) * (j + 1) <= 16) { t.ci[n] = i; t.cj[n] = j; ++n; } return t; }
constexpr CandTab CANDS = make_cands();

template <int S> __device__ __forceinline__ float cand_slot(const float (&la)[16], const float (&lb)[16], int hh) {
    constexpr int i0 = CANDS.ci[2 * S], j0 = CANDS.cj[2 * S], i1 = CANDS.ci[2 * S + 1], j1 = CANDS.cj[2 * S + 1];
    const float sa = __uint_as_float(__float_as_uint(la[i0]) & ~127u) + __uint_as_float(__float_as_uint(lb[j0]) & ~127u);
    const float sb = __uint_as_float(__float_as_uint(la[i1]) & ~127u) + __uint_as_float(__float_as_uint(lb[j1]) & ~127u);
    const unsigned pa = (__float_as_uint(sa) & ~255u) | (unsigned)(i0 * 16 + j0);
    const unsigned pb = (__float_as_uint(sb) & ~255u) | (unsigned)(i1 * 16 + j1);
    return __uint_as_float(hh ? pb : pa);
}
template <int... S> __device__ __forceinline__ void cand_slots(float (&slot)[25], const float (&la)[16], const float (&lb)[16], int hh, std::integer_sequence<int, S...>) {
    ((slot[S] = cand_slot<S>(la, lb, hh)), ...);
}
struct QFromGlobal { const bf16_t* qrow;
    __device__ __forceinline__ bf16x8 operator()(int p, int s) const { return *(const bf16x8*)(qrow + p * 128 + 16 * s); } };
struct QFromLds { const LAS unsigned char* tile; int row, hh;
    __device__ __forceinline__ bf16x8 operator()(int p, int s) const { const int chunk = 16 * p + 2 * s + hh; return *(const LAS bf16x8*)(tile + row * 512 + ((chunk ^ (row & 31)) * 16)); } };
template <class QL> __device__ __forceinline__ void peer_topk_wave(const QL& ql, const bf16_t* skh, int lane, int* eo, float* go) {
    const int tok = lane & 31, hh = lane >> 5;
    float lab[2][16];
#pragma unroll
    for (int p = 0; p < 2; ++p) {
        f32x16 acc[4];
#pragma unroll
        for (int i = 0; i < 4; ++i)
#pragma unroll
            for (int r = 0; r < 16; ++r) acc[i][r] = 0.f;
        const bf16_t* skfrag = skh + (size_t)p * 128 * 128 + 8 * lane;
#pragma unroll 2
        for (int s = 0; s < 8; ++s) {
            const bf16x8 bq = ql(p, s);
#pragma unroll
            for (int i = 0; i < 4; ++i) { const bf16x8 ak = *(const bf16x8*)(skfrag + (size_t)(i * 8 + s) * 512);
                acc[i] = __builtin_amdgcn_mfma_f32_32x32x16_bf16(ak, bq, acc[i], 0, 0, 0); }
        }
        float v[64];
#pragma unroll
        for (int i = 0; i < 4; ++i)
#pragma unroll
            for (int r = 0; r < 16; ++r) { const unsigned kb = 32u * i + (r & 3) + 8u * (r >> 2);
                v[i * 16 + r] = __uint_as_float((__float_as_uint(acc[i][r]) & ~127u) | kb | ((unsigned)hh << 2)); }
        topk16_joint<64>(v, lab[p]);
    }
    float slot[25];
    cand_slots(slot, lab[0], lab[1], hh, std::make_integer_sequence<int, 25>{});
    float win[16];
    topk16_joint<25>(slot, win);
    float ex[16], esum = 0.f;
#pragma unroll
    for (int r = 0; r < 16; ++r) { ex[r] = __expf(win[r] - win[0]); esum += ex[r]; }
    const float inv = 1.0f / esum;
    int eid[8]; float gt[8];
    const unsigned hm = 0u - (unsigned)hh;
#pragma unroll
    for (int r = 0; r < 8; ++r) {
        const unsigned wb = (__float_as_uint(win[r]) & ~hm) | (__float_as_uint(win[r + 8]) & hm);
        const int ci = (wb >> 4) & 15, cj = wb & 15;
        unsigned ia = 0, ib = 0;
#pragma unroll
        for (int i = 0; i < 16; ++i) { ia = (ci == i) ? (__float_as_uint(lab[0][i]) & 127u) : ia; ib = (cj == i) ? (__float_as_uint(lab[1][i]) & 127u) : ib; }
        eid[r] = (int)(ia * 128u + ib);
        gt[r] = __uint_as_float((__float_as_uint(ex[r]) & ~hm) | (__float_as_uint(ex[r + 8]) & hm)) * inv;
    }
    *(GAS v4u*)(eo) = (v4u){(unsigned)eid[0], (unsigned)eid[1], (unsigned)eid[2], (unsigned)eid[3]};
    *(GAS v4u*)(eo + 4) = (v4u){(unsigned)eid[4], (unsigned)eid[5], (unsigned)eid[6], (unsigned)eid[7]};
    *(GAS f32x4*)(go) = (f32x4){gt[0], gt[1], gt[2], gt[3]};
    *(GAS f32x4*)(go + 4) = (f32x4){gt[4], gt[5], gt[6], gt[7]};
}
__device__ __forceinline__ void peer_topk_phase(const Frame& F, const bf16_t* Q, const bf16_t* SKB, int* EXP, float* GATE) {
    const int lane = F.lane, tok = lane & 31, hh = lane >> 5, h = F.wave;
    for (int blk = F.vcu; blk < T / 32; blk += F.G) {
        const int t0 = blk * 32; const size_t o = (size_t)(t0 + tok) * 128 + h * 16 + hh * 8;
        peer_topk_wave(QFromGlobal{Q + (size_t)(t0 + tok) * D + h * 256 + 8 * hh}, SKB + (size_t)h * 2 * 128 * 128, lane, EXP + o, GATE + o);
    }
}

typedef float f32x2 __attribute__((ext_vector_type(2)));
typedef unsigned v6u __attribute__((ext_vector_type(6)));
typedef unsigned v3u __attribute__((ext_vector_type(3)));
typedef float v32f __attribute__((ext_vector_type(32)));
typedef float v16f __attribute__((ext_vector_type(16)));
__device__ __forceinline__ unsigned fp6_code(float x) {
    const float a = fminf(fabsf(x), 7.5f); const unsigned b = __float_as_uint(a);
    const unsigned norm = ((b + 0x7FFFFu + ((b >> 20) & 1u)) >> 20) - 1008u;
    const unsigned code = (a < 1.0f) ? (unsigned)__builtin_rintf(a * 8.0f) : (norm > 31u ? 31u : norm);
    return code | ((__float_as_uint(x) >> 26) & 32u);
}
template <bool ISU>
__device__ __forceinline__ void p0_fp8_rows(const float* src, unsigned char* dst, float* inv_scale, float* s1q, float* s0, const float* g1, const float* b1, int row_lo, int row_hi, int step, int lane) {
    f32x4 gl[2][4], bl[2][4];
    if (ISU) {
#pragma unroll
        for (int j = 0; j < 2; ++j)
#pragma unroll
            for (int c = 0; c < 4; ++c) { gl[j][c] = ((const GAS f32x4*)g1)[4 * lane + 256 * j + c]; bl[j][c] = ((const GAS f32x4*)b1)[4 * lane + 256 * j + c]; }
    }
    constexpr int NR = 2;
    for (int row = row_lo; row < row_hi; row += NR * step) {
        f32x4 v[NR][2][4];
#pragma unroll
        for (int r = 0; r < NR; ++r) { const int rr = (row + r * step < row_hi) ? row + r * step : row; const GAS f32x4* sp = (const GAS f32x4*)(src + (size_t)rr * D) + 4 * lane;
#pragma unroll
            for (int j = 0; j < 2; ++j)
#pragma unroll
                for (int c = 0; c < 4; ++c) v[r][j][c] = sp[256 * j + c]; }
#pragma unroll
        for (int r = 0; r < NR; ++r) { const int rr = row + r * step; float mx = 0.f, sb = 0.f;
#pragma unroll
            for (int j = 0; j < 2; ++j)
#pragma unroll
                for (int c = 0; c < 4; ++c) {
                    if (ISU) { const f32x4 gg = gl[j][c], bb = bl[j][c];
                        sb += (v[r][j][c][0] * bb[0] + v[r][j][c][1] * bb[1]) + (v[r][j][c][2] * bb[2] + v[r][j][c][3] * bb[3]); v[r][j][c] = v[r][j][c] * gg; }
                    mx = fmaxf(fmaxf(mx, fmaxf(fabsf(v[r][j][c][0]), fabsf(v[r][j][c][1]))), fmaxf(fabsf(v[r][j][c][2]), fabsf(v[r][j][c][3]))); }
            mx = wave_max_dpp(mx);
            const bool ok = mx > 1e-30f && mx < 1e30f;
            const float sc = ok ? 7.5f / mx : 1.f, isc = ok ? mx * (1.0f / 7.5f) : 1.f;
            float sq = 0.f;
#pragma unroll
            for (int j = 0; j < 2; ++j) {
                v16f ea, eb;
#pragma unroll
                for (int i = 0; i < 8; ++i) { const int e0 = 2 * i, e1 = 2 * i + 1; ea[i] = v[r][j][e0 >> 2][e0 & 3] * sc; eb[i] = v[r][j][e1 >> 2][e1 & 3] * sc; ea[8 + i] = 0.f; eb[8 + i] = 0.f; }
                const v6u pk = __builtin_amdgcn_cvt_scalef32_2xpk16_fp6_f32(ea, eb, 1.0f);
                v3u o; o.x = pk[0]; o.y = pk[1]; o.z = pk[2];
                if (ISU) { const v32f dq = __builtin_amdgcn_cvt_scalef32_pk32_f32_fp6((v6u){o.x, o.y, o.z, 0u, 0u, 0u}, 1.0f);
#pragma unroll
                    for (int i = 0; i < 16; ++i) sq += dq[i]; }
                if (rr < row_hi) { unsigned char* q = dst + ((size_t)((lane >> 4) + 4 * j) * 16384 + rr) * 192 + 24 * ((lane & 15) >> 1) + 12 * (lane & 1);
                    *(GAS unsigned*)q = o.x; *(GAS unsigned*)(q + 4) = o.y; *(GAS unsigned*)(q + 8) = o.z; } }
            if (ISU) { sq = wave_sum_dpp(sq); sb = wave_sum_dpp(sb); }
            if (lane == 0 && rr < row_hi) { inv_scale[rr] = isc; if (ISU) { s1q[rr] = sq; s0[rr] = sb; } } }
    }
}
constexpr int PG_GB = 4;
struct PgBatch { v6u w[PG_GB]; };
__device__ __forceinline__ void pg_issue(PgBatch& b, const unsigned char* tslice, const LAS unsigned* sid, int ib, int g8) {
    __builtin_amdgcn_s_setprio(1);
#pragma unroll
    for (int q = 0; q < PG_GB; ++q) { const unsigned e = sid[8 * (ib + q) + g8]; const GAS v2u* p = (const GAS v2u*)(tslice + (size_t)e * 192); const v2u p0 = p[0], p1 = p[1], p2 = p[2]; b.w[q] = (v6u){p0.x, p0.y, p1.x, p1.y, p2.x, p2.y}; }
    __builtin_amdgcn_s_setprio(0);
}
__device__ __forceinline__ v32f pg_unpack(const PgBatch& b, int q) { return __builtin_amdgcn_cvt_scalef32_pk32_f32_fp6(b.w[q], 1.0f); }
struct PgHead { unsigned id0, id1; v4u y[4]; float w0, w1; };
template <bool DOTS> __device__ __forceinline__ void pg_head_load(PgHead& h, const bf16_t* Y, const int* EXP, const float* W, int t, int lane, int col0) {
    { const v2u ids = ((const GAS v2u*)EXP)[(size_t)t * 64 + lane]; h.id0 = ids.x; h.id1 = ids.y; }
    if (DOTS) {
#pragma unroll
        for (int i = 0; i < 4; ++i) h.y[i] = *(const GAS v4u*)(Y + (size_t)t * D + col0 + 8 * i);
    } else { const f32x2 ww = ((const GAS f32x2*)W)[(size_t)t * 64 + lane]; h.w0 = ww.x; h.w1 = ww.y; }
}
template <int IB> __device__ __forceinline__ void pg_dots(const PgBatch& b, const f32x2 (&xs)[16], float (&dp)[16]) {
#pragma unroll
    for (int q = 0; q < PG_GB; ++q) { const v32f u = pg_unpack(b, q); f32x2 a0 = {0.f, 0.f}, a1 = {0.f, 0.f};
#pragma unroll
        for (int j = 0; j < 16; j += 2) { a0 = (f32x2){u[2 * j], u[2 * j + 1]} * xs[j] + a0; a1 = (f32x2){u[2 * j + 2], u[2 * j + 3]} * xs[j + 1] + a1; }
        dp[IB + q] = (a0.x + a0.y) + (a1.x + a1.y);
        if (q & 1) __builtin_amdgcn_sched_barrier(0); }
}
typedef __bf16 pg_v32bf __attribute__((ext_vector_type(32)));
typedef __bf16 pg_v2bf __attribute__((ext_vector_type(2)));
template <int IB> __device__ __forceinline__ void pg_dots2(const PgBatch& b, const unsigned (&yv)[16], float (&dp)[16]) {
#pragma unroll
    for (int q = 0; q < PG_GB; ++q) { const pg_v32bf u = __builtin_amdgcn_cvt_scalef32_pk32_bf16_fp6(b.w[q], 1.0f); float a0 = 0.f, a1 = 0.f;
#pragma unroll
        for (int j = 0; j < 16; j += 2) { a0 = __builtin_amdgcn_fdot2_f32_bf16((pg_v2bf){u[2 * j], u[2 * j + 1]}, __builtin_bit_cast(pg_v2bf, yv[j]), a0, false);
            a1 = __builtin_amdgcn_fdot2_f32_bf16((pg_v2bf){u[2 * j + 2], u[2 * j + 3]}, __builtin_bit_cast(pg_v2bf, yv[j + 1]), a1, false); }
        dp[IB + q] = a0 + a1;
        if (q & 1) __builtin_amdgcn_sched_barrier(0); }
}
__device__ __forceinline__ void peer_dots_phase(const Frame& F, const bf16_t* Y, const unsigned char* TU, const int* EXP, float* PD) {
    const int lane = F.lane, g8 = lane >> 3, c8 = lane & 7;
    const int cls = (int)(blockIdx.x & 7), gwc = (int)(blockIdx.x >> 3) * NWAVES + F.wave, NW = (F.G >> 3) * NWAVES, col0 = cls * 256 + 32 * c8;
    LAS unsigned* sidb = (LAS unsigned*)(F.lds + F.wave * 2048);
    LAS float* red = (LAS float*)(F.lds + 16384 + F.wave * 4096);
    const unsigned char* tslice = TU + (size_t)cls * 16384 * 192 + 24 * c8;
    if (gwc >= T) return;
    v2u hyc; v2u ids2;
    LAS unsigned char* ybuf = F.lds + F.wave * 2048 + 1024;
    {   const v2u i0 = ((const GAS v2u*)EXP)[(size_t)gwc * 64 + lane]; const int t1 = (gwc + NW < T) ? gwc + NW : gwc; const v2u i1 = ((const GAS v2u*)EXP)[(size_t)t1 * 64 + lane];
        *(LAS v2u*)(sidb + 2 * lane) = i0; *(LAS v2u*)(sidb + 128 + 2 * lane) = i1;
        hyc = *(const GAS v2u*)(Y + (size_t)gwc * D + cls * 256 + 4 * lane); }
    PgBatch W0, W1, W2, W3;
    pg_issue(W0, tslice, sidb, 0, g8); pg_issue(W1, tslice, sidb, 4, g8); pg_issue(W2, tslice, sidb, 8, g8); pg_issue(W3, tslice, sidb, 12, g8);
    int par = 0;
    for (int t = gwc; t < T; t += NW, par ^= 1) {
        unsigned xs[16];
        *(LAS v2u*)(ybuf + 8 * lane) = hyc;
        {   const LAS v4u* yq = (const LAS v4u*)(ybuf + 64 * c8);
#pragma unroll
            for (int i = 0; i < 4; ++i) { const v4u q4 = yq[i]; xs[4 * i] = q4.x; xs[4 * i + 1] = q4.y; xs[4 * i + 2] = q4.z; xs[4 * i + 3] = q4.w; } }
        const int tn = (t + NW < T) ? t + NW : t, tnn = (t + 2 * NW < T) ? t + 2 * NW : t;
        hyc = *(const GAS v2u*)(Y + (size_t)tn * D + cls * 256 + 4 * lane);
        ids2 = ((const GAS v2u*)EXP)[(size_t)tnn * 64 + lane];
        const LAS unsigned* sn = sidb + 128 * (par ^ 1);
        float dp[16];
        pg_dots2<0>(W0, xs, dp); pg_issue(W0, tslice, sn, 0, g8);
        pg_dots2<4>(W1, xs, dp); pg_issue(W1, tslice, sn, 4, g8);
        pg_dots2<8>(W2, xs, dp); pg_issue(W2, tslice, sn, 8, g8);
        pg_dots2<12>(W3, xs, dp); pg_issue(W3, tslice, sn, 12, g8);
#pragma unroll
        for (int i = 0; i < 16; ++i) red[i * 64 + lane] = dp[i];
        float d[2];
#pragma unroll
        for (int h = 0; h < 2; ++h) { const int k = 64 * h + lane; const LAS f32x4* p = (const LAS f32x4*)(red + (k >> 3) * 64 + (k & 7) * 8); const f32x4 a = p[0], b = p[1];
            d[h] = ((a[0] + a[1]) + (a[2] + a[3])) + ((b[0] + b[1]) + (b[2] + b[3])); }
        ((GAS unsigned*)PD)[((size_t)cls * T + t) * 64 + lane] = pk2(d[0], d[1]);
        *(LAS v2u*)(sidb + 128 * par + 2 * lane) = ids2;
    }
}
__device__ __forceinline__ void peer_w_phase(const Frame& F, const float* PD, const float* MURS, const int* EXP, const float* GATE, const float* USC, const float* US1, const float* US0, const float* VSC, float* W) {
    const int lane = F.lane, gw = F.vcu * NWAVES + F.wave, NGW = F.G * NWAVES;
    for (int t = gw; t < T; t += NGW) {
        float d0 = 0.f, d1 = 0.f;
#pragma unroll
        for (int x = 0; x < 8; ++x) { const unsigned pw = ((const GAS unsigned*)PD)[((size_t)x * T + t) * 64 + lane]; d0 += bflo(pw); d1 += bfhi(pw); }
        const f32x2 murs = *(const GAS f32x2*)(MURS + (size_t)t * 2);
        const unsigned i0 = ((const GAS unsigned*)EXP)[(size_t)t * 128 + lane], i1 = ((const GAS unsigned*)EXP)[(size_t)t * 128 + 64 + lane];
        const float gt0 = ((const GAS float*)GATE)[(size_t)t * 128 + lane], gt1 = ((const GAS float*)GATE)[(size_t)t * 128 + 64 + lane];
        const float us0 = ((const GAS float*)USC)[i0], us1 = ((const GAS float*)USC)[i1], vs0 = ((const GAS float*)VSC)[i0], vs1 = ((const GAS float*)VSC)[i1];
        const float q0 = ((const GAS float*)US1)[i0], q1 = ((const GAS float*)US1)[i1], c0 = ((const GAS float*)US0)[i0], c1 = ((const GAS float*)US0)[i1];
        d0 = murs.y * us0 * (d0 - murs.x * q0) + c0; d1 = murs.y * us1 * (d1 - murs.x * q1) + c1;
        W[(size_t)t * 128 + lane] = gt0 * 0.5f * d0 * (1.0f + erff(d0 * 0.7071067811865476f)) * vs0;
        W[(size_t)t * 128 + 64 + lane] = gt1 * 0.5f * d1 * (1.0f + erff(d1 * 0.7071067811865476f)) * vs1;
    }
}
__device__ __forceinline__ void pg_axpy(const PgBatch& b, f32x2 (&acc)[16], const LAS float* sw, int ib, int g8) {
#pragma unroll
    for (int q = 0; q < PG_GB; ++q) { const float wk = sw[8 * (ib + q) + g8]; const f32x2 wk2 = {wk, wk}; const v32f u = pg_unpack(b, q);
#pragma unroll
        for (int j = 0; j < 16; ++j) acc[j] = (f32x2){u[2 * j], u[2 * j + 1]} * wk2 + acc[j];
        if (q & 1) __builtin_amdgcn_sched_barrier(0); }
}
__device__ __forceinline__ float xgrp_sum(float x) {
    x += dppf<0x128>(x);
    auto s = __builtin_amdgcn_permlane16_swap(__float_as_uint(x), __float_as_uint(x), false, false);
    x = __uint_as_float(s[0]) + __uint_as_float(s[1]);
    auto t = __builtin_amdgcn_permlane32_swap(__float_as_uint(x), __float_as_uint(x), false, false);
    return __uint_as_float(t[0]) + __uint_as_float(t[1]);
}
__device__ __forceinline__ void peer_mix_phase(const Frame& F, const unsigned char* TV, const int* EXP, const float* W, bf16_t* FFN) {
    const int lane = F.lane, g8 = lane >> 3, c8 = lane & 7;
    const int cls = (int)(blockIdx.x & 7), gwc = (int)(blockIdx.x >> 3) * NWAVES + F.wave, NW = (F.G >> 3) * NWAVES;
    LAS unsigned* sidb = (LAS unsigned*)(F.lds + F.wave * 2048);
    LAS float* swb = (LAS float*)(F.lds + F.wave * 2048 + 1024);
    const unsigned char* tslice = TV + (size_t)cls * 16384 * 192 + 24 * c8;
    if (gwc >= T) return;
    {   const int t1 = (gwc + NW < T) ? gwc + NW : gwc;
        const v2u i0 = ((const GAS v2u*)EXP)[(size_t)gwc * 64 + lane], i1 = ((const GAS v2u*)EXP)[(size_t)t1 * 64 + lane];
        const f32x2 w0 = ((const GAS f32x2*)W)[(size_t)gwc * 64 + lane], w1 = ((const GAS f32x2*)W)[(size_t)t1 * 64 + lane];
        *(LAS v2u*)(sidb + 2 * lane) = i0; *(LAS v2u*)(sidb + 128 + 2 * lane) = i1; *(LAS f32x2*)(swb + 2 * lane) = w0; *(LAS f32x2*)(swb + 128 + 2 * lane) = w1; }
    PgBatch W0, W1, W2, W3;
    pg_issue(W0, tslice, sidb, 0, g8); pg_issue(W1, tslice, sidb, 4, g8); pg_issue(W2, tslice, sidb, 8, g8); pg_issue(W3, tslice, sidb, 12, g8);
    int par = 0;
    for (int t = gwc; t < T; t += NW, par ^= 1) {
        const int tnn = (t + 2 * NW < T) ? t + 2 * NW : t;
        const v2u ids2 = ((const GAS v2u*)EXP)[(size_t)tnn * 64 + lane]; const f32x2 w2 = ((const GAS f32x2*)W)[(size_t)tnn * 64 + lane];
        const LAS unsigned* sn = sidb + 128 * (par ^ 1); const LAS float* swc = swb + 128 * par;
        f32x2 acc[16];
#pragma unroll
        for (int j = 0; j < 16; ++j) acc[j] = (f32x2){0.f, 0.f};
        pg_axpy(W0, acc, swc, 0, g8); pg_issue(W0, tslice, sn, 0, g8);
        pg_axpy(W1, acc, swc, 4, g8); pg_issue(W1, tslice, sn, 4, g8);
        pg_axpy(W2, acc, swc, 8, g8); pg_issue(W2, tslice, sn, 8, g8);
        pg_axpy(W3, acc, swc, 12, g8); pg_issue(W3, tslice, sn, 12, g8);
        {   LAS unsigned char* red = F.lds + 16384 + F.wave * 9216;
#pragma unroll
            for (int i = 0; i < 8; ++i) *(LAS f32x4*)(red + g8 * 1152 + c8 * 144 + 16 * i) = (f32x4){acc[2 * i].x, acc[2 * i].y, acc[2 * i + 1].x, acc[2 * i + 1].y};
            f32x4 tot = *(const LAS f32x4*)(red + (lane >> 3) * 144 + (lane & 7) * 16);
#pragma unroll
            for (int g = 1; g < 8; ++g) tot = tot + *(const LAS f32x4*)(red + g * 1152 + (lane >> 3) * 144 + (lane & 7) * 16);
            *(GAS v2u*)(FFN + (size_t)t * D + cls * 256 + 4 * lane) = (v2u){pk2(tot[0], tot[1]), pk2(tot[2], tot[3])};
        }
        *(LAS v2u*)(sidb + 128 * par + 2 * lane) = ids2; *(LAS f32x2*)(swb + 128 * par + 2 * lane) = w2;
    }
}
__device__ __forceinline__ void ln2_phase(const Frame& F, const bf16_t* Y, const bf16_t* FFN, const float* MURS, const float* g1, const float* b1, const float* g2, const float* b2, float* out) {
    const int gw = F.vcu * NWAVES + F.wave, NGW = F.G * NWAVES, lane = F.lane;
    f32x4 G1[8], B1[8], G2[8], B2[8];
#pragma unroll
    for (int j = 0; j < 8; ++j) { G1[j] = ((const GAS f32x4*)g1)[64 * j + lane]; B1[j] = ((const GAS f32x4*)b1)[64 * j + lane]; G2[j] = ((const GAS f32x4*)g2)[64 * j + lane]; B2[j] = ((const GAS f32x4*)b2)[64 * j + lane]; }
    for (int row0 = gw; row0 < T; row0 += 2 * NGW) {
        v2u yw[2][8], fw[2][8]; f32x2 murs[2];
#pragma unroll
        for (int k = 0; k < 2; ++k) { const int row = (row0 + k * NGW < T) ? row0 + k * NGW : row0;
            const GAS v2u* yr = (const GAS v2u*)(Y + (size_t)row * D) + lane; const GAS v2u* fr = (const GAS v2u*)(FFN + (size_t)row * D) + lane;
            murs[k] = *(const GAS f32x2*)(MURS + (size_t)row * 2);
#pragma unroll
            for (int j = 0; j < 8; ++j) { yw[k][j] = yr[64 * j]; fw[k][j] = fr[64 * j]; } }
#pragma unroll
        for (int k = 0; k < 2; ++k) { const int row = row0 + k * NGW;
            f32x4 v[8]; float s = 0.f;
#pragma unroll
            for (int j = 0; j < 8; ++j) { const f32x4 y = {bflo(yw[k][j].x), bfhi(yw[k][j].x), bflo(yw[k][j].y), bfhi(yw[k][j].y)}, f = {bflo(fw[k][j].x), bfhi(fw[k][j].x), bflo(fw[k][j].y), bfhi(fw[k][j].y)}, gg = G1[j], bb = B1[j];
                v[j] = ((y - murs[k].x) * murs[k].y * gg + bb) * ALPHA + f; s += (v[j][0] + v[j][1]) + (v[j][2] + v[j][3]); }
            const float mean = wave_sum_dpp(s) * (1.0f / D); float s2 = 0.f;
#pragma unroll
            for (int j = 0; j < 8; ++j) { v[j] = v[j] - mean; s2 += (v[j][0] * v[j][0] + v[j][1] * v[j][1]) + (v[j][2] * v[j][2] + v[j][3] * v[j][3]); }
            const float rstd = 1.0f / sqrtf(wave_sum_dpp(s2) * (1.0f / D) + LN_EPS);
            if (row < T) { GAS f32x4* orow = (GAS f32x4*)(out + (size_t)row * D) + lane;
#pragma unroll
                for (int j = 0; j < 8; ++j) orow[64 * j] = v[j] * rstd * G2[j] + B2[j]; } }
    }
}

constexpr float W8_SCALE = 2048.f, WO8_SCALE = 4096.f;
template <int MODE>
__device__ __forceinline__ void p0_transpose_item(const float* W, int K, int N, int nblk, bf16_t* WT, LAS float* scr, int item, int lane, const float* g, const float* beta, float* cpart) {
    const int kb = item / nblk, nb = item % nblk, k0 = 64 * kb, n0 = 32 * nb;
    const int n = n0 + (lane & 31);
    int src = n; float sc = 1.f; bool ok = true;
    if (MODE == 1) {
        ok = n < NPROJ;
        src = (n < 3072) ? n : (n < 7168 ? n + 16 : n - 7168 + 3072);
        sc = (n < 512) ? 0.08838834764831845f : ((n >= C_RK && n < C_RV) ? 0.0625f : 1.f);
    }
#pragma unroll
    for (int i = 0; i < 32; ++i) { const int kk = 2 * i + (lane >> 5); scr[kk * 33 + (lane & 31)] = ok ? W[(size_t)(k0 + kk) * N + src] * sc : 0.f; }
    LDS_WAIT(); asm volatile("" ::: "memory");
    LAS float* cg = scr + 64 * 33;
    if (MODE == 2) {
        cg[lane] = g[k0 + lane]; cg[64 + lane] = beta[k0 + lane];
        LDS_WAIT(); asm volatile("" ::: "memory");
        float s = 0.f, s1 = 0.f, s2 = 0.f, s3 = 0.f; const bool isg = lane < 32; const LAS float* coef = cg + (isg ? 0 : 64); const int col = lane & 31;
#pragma unroll 4
        for (int kk = 0; kk < 64; kk += 4) { float v0 = scr[kk * 33 + col] * coef[kk], v1 = scr[(kk + 1) * 33 + col] * coef[kk + 1], v2 = scr[(kk + 2) * 33 + col] * coef[kk + 2], v3 = scr[(kk + 3) * 33 + col] * coef[kk + 3];
            if (isg) { v0 = bf2f(f2bf(v0)); v1 = bf2f(f2bf(v1)); v2 = bf2f(f2bf(v2)); v3 = bf2f(f2bf(v3)); }
            s += v0; s1 += v1; s2 += v2; s3 += v3; }
        cpart[((size_t)kb * 2 + (isg ? 0 : 1)) * N + n0 + col] = (s + s1) + (s2 + s3);
    }
    const int c = lane & 7;
    float gs[8];
#pragma unroll
    for (int i = 0; i < 8; ++i) gs[i] = (MODE == 2) ? cg[8 * c + i] : 1.f;
#pragma unroll
    for (int j = 0; j < 4; ++j) { const int nn = (lane >> 3) + 8 * j; const LAS float* s = scr + (8 * c) * 33 + nn;
        if (MODE == 1 || MODE == 3) { constexpr float W8S = (MODE == 1) ? W8_SCALE : WO8_SCALE; v2u o8; o8.x = fp8x4(s[0 * 33] * W8S, s[1 * 33] * W8S, s[2 * 33] * W8S, s[3 * 33] * W8S); o8.y = fp8x4(s[4 * 33] * W8S, s[5 * 33] * W8S, s[6 * 33] * W8S, s[7 * 33] * W8S);
            *(GAS v2u*)((unsigned char*)WT + (size_t)(n0 + nn) * K + k0 + 8 * c) = o8; continue; }
        v4u o; o.x = pk2(s[0 * 33] * gs[0], s[1 * 33] * gs[1]); o.y = pk2(s[2 * 33] * gs[2], s[3 * 33] * gs[3]); o.z = pk2(s[4 * 33] * gs[4], s[5 * 33] * gs[5]); o.w = pk2(s[6 * 33] * gs[6], s[7 * 33] * gs[7]);
        *(GAS v4u*)(WT + (size_t)(n0 + nn) * K + k0 + 8 * c) = o; }
    LDS_WAIT(); asm volatile("" ::: "memory");
}
template <bool F8 = false>
__device__ __forceinline__ void p0_cvt(const float* src, bf16_t* dst, size_t n8, size_t gtid, size_t gthreads, unsigned char* dst8 = nullptr) {
    size_t i = gtid;
    for (; i + 3 * gthreads < n8; i += 4 * gthreads) {
        f32x4 a[4], b[4];
#pragma unroll
        for (int q = 0; q < 4; ++q) { a[q] = __builtin_nontemporal_load((const GAS f32x4*)src + 2 * (i + q * gthreads)); b[q] = __builtin_nontemporal_load((const GAS f32x4*)src + 2 * (i + q * gthreads) + 1); }
#pragma unroll
        for (int q = 0; q < 4; ++q) { v4u o; o.x = pk2(a[q][0], a[q][1]); o.y = pk2(a[q][2], a[q][3]); o.z = pk2(b[q][0], b[q][1]); o.w = pk2(b[q][2], b[q][3]); if (!F8) ((GAS v4u*)dst)[i + q * gthreads] = o;
            if (F8) { v2u o8; o8.x = fp8x4(a[q][0], a[q][1], a[q][2], a[q][3]); o8.y = fp8x4(b[q][0], b[q][1], b[q][2], b[q][3]); ((GAS v2u*)dst8)[i + q * gthreads] = o8; } }
    }
    for (; i < n8; i += gthreads) {
        const f32x4 a = ((const GAS f32x4*)src)[2 * i], b = ((const GAS f32x4*)src)[2 * i + 1];
        v4u o; o.x = pk2(a[0], a[1]); o.y = pk2(a[2], a[3]); o.z = pk2(b[0], b[1]); o.w = pk2(b[2], b[3]);
        if (!F8) ((GAS v4u*)dst)[i] = o;
        if (F8) { v2u o8; o8.x = fp8x4(a[0], a[1], a[2], a[3]); o8.y = fp8x4(b[0], b[1], b[2], b[3]); ((GAS v2u*)dst8)[i] = o8; }
    }
}
__device__ __forceinline__ void p0_prologue(const Frame& F, const Args& a) {
    unsigned char* ws = a.ws;
    LAS float* scr = (LAS float*)(F.lds + F.wave * 16384);
    const int gw = F.vcu * NWAVES + F.wave, NGW = F.G * NWAVES;
    constexpr int I_IN = (D / 64) * (NP / 32);
    for (int it = gw; it < I_IN; it += NGW) p0_transpose_item<1>(a.in[1], D, NPROJ, NP / 32, (bf16_t*)(ws + WS_WIN), scr, it, F.lane, nullptr, nullptr, nullptr);
    const size_t gtid = (size_t)F.vcu * (NWAVES * 64) + F.tid, gthreads = (size_t)F.G * (NWAVES * 64);
    p0_cvt<true>(a.in[0], (bf16_t*)(ws + WS_XB), (size_t)T * D / 8, gtid, gthreads, ws + WS_X8);
    float* rope = (float*)(ws + WS_ROPE);
    for (size_t idx = gtid; idx < (size_t)SEQ * 128; idx += gthreads) {
        const int pos = (int)(idx >> 7), i = (int)(idx & 127);
        const float inv = powf(10000.0f, -(float)i / 128.0f);
        const float ang = (float)pos * inv;
        const float n = rintf(ang * 0.15915494309189535f);
        float r = fmaf(-n, 6.28125f, ang); r = fmaf(-n, 0.0019353071795864769f, r);
        rope[2 * idx] = cosf(r); rope[2 * idx + 1] = sinf(r);
    }
}
__device__ __forceinline__ void ln_rows_phase(const Frame& F, float* Y, const float* g, const float* bta, bf16_t* Hb) {
    const int gw = F.vcu * NWAVES + F.wave, NGW = F.G * NWAVES;
    for (int row = gw; row < T; row += NGW) {
        GAS f32x4* yr = (GAS f32x4*)(Y + (size_t)row * D) + F.lane;
        f32x4 v[8]; float s = 0.f;
#pragma unroll
        for (int j = 0; j < 8; ++j) { v[j] = yr[64 * j]; s += (v[j][0] + v[j][1]) + (v[j][2] + v[j][3]); }
        const float mean = wave_sum(s) * (1.f / D); float s2 = 0.f;
#pragma unroll
        for (int j = 0; j < 8; ++j) { v[j] = v[j] - mean; s2 += (v[j][0] * v[j][0] + v[j][1] * v[j][1]) + (v[j][2] * v[j][2] + v[j][3] * v[j][3]); }
        const float rstd = 1.f / sqrtf(wave_sum(s2) * (1.f / D) + LN_EPS);
        GAS v2u* o8 = (GAS v2u*)(Hb + (size_t)row * D) + F.lane;
#pragma unroll
        for (int j = 0; j < 8; ++j) { const f32x4 gg = ((const GAS f32x4*)g)[64 * j + F.lane], bb = ((const GAS f32x4*)bta)[64 * j + F.lane];
            const f32x4 o = v[j] * rstd * gg + bb; yr[64 * j] = o; v2u w; w.x = pk2(o[0], o[1]); w.y = pk2(o[2], o[3]); o8[64 * j] = w; }
    }
}


constexpr int QWAVES = 4;
constexpr int CW_QUEUE = 2048;
constexpr int BGQ_TAB = 512, BGQ_TR = 256, BGQ_SK = 64, BGQ_N = BGQ_TAB + 2 * BGQ_TR;
__device__ __forceinline__ void bg_queue_drain(const Frame& F, const Args& a, gu32* ctl) {
    unsigned char* ws = a.ws;
    LAS float* scr = (LAS float*)(F.lds + F.wave * 16384);
    const bool trw = F.wave >= QWAVES;
    const int shard = (int)(blockIdx.x & 7);
    gu32* ctr = ctl + CW_QUEUE + 64 * (shard + (trw ? 8 : 0));
    const unsigned lim = trw ? (unsigned)(2 * BGQ_TR + BGQ_SK) : (unsigned)BGQ_TAB;
    unsigned nxt = 0;
    if (F.lane == 0) nxt = __hip_atomic_fetch_add(ctr, 1u, __ATOMIC_RELAXED, __HIP_MEMORY_SCOPE_AGENT);
    for (;;) {
        const unsigned it = __builtin_amdgcn_readfirstlane(nxt);
        if (it >= lim) break;
        if (F.lane == 0) nxt = __hip_atomic_fetch_add(ctr, 1u, __ATOMIC_RELAXED, __HIP_MEMORY_SCOPE_AGENT);
        if (!trw) {
            const int grp = (int)it * 8 + shard;
            const bool isv = grp >= 2048; const int r0 = (grp & 2047) * 8;
            if (isv) p0_fp8_rows<false>(a.in[12], ws + WS_VB, (float*)(ws + WS_VSC), nullptr, nullptr, nullptr, nullptr, r0, r0 + 8, 1, F.lane);
            else p0_fp8_rows<true>(a.in[11], ws + WS_UB, (float*)(ws + WS_USC), (float*)(ws + WS_US1), (float*)(ws + WS_US0), a.in[7], a.in[8], r0, r0 + 8, 1, F.lane);
        } else {
            if (it >= (unsigned)(2 * BGQ_TR)) {
                const size_t idx = (size_t)(((int)it - 2 * BGQ_TR) * 8 + shard) * 64 + F.lane;
                const int d8 = (int)(idx & 15), key = (int)((idx >> 4) & 127), hp = (int)(idx >> 11);
                const f32x4 va = ((const GAS f32x4*)a.in[10])[2 * idx], vb = ((const GAS f32x4*)a.in[10])[2 * idx + 1];
                v4u o; o.x = pk2(va[0], va[1]); o.y = pk2(va[2], va[3]); o.z = pk2(vb[0], vb[1]); o.w = pk2(vb[2], vb[3]);
                ((GAS v4u*)(ws + WS_SKB))[(size_t)hp * 2048 + (size_t)((key >> 5) * 8 + (d8 >> 1)) * 64 + (key & 31) + 32 * (d8 & 1)] = o;
                continue; }
            const int j = (int)it; const bool isq = j >= BGQ_TR; const int item = (isq ? j - BGQ_TR : j) * 8 + shard;
            if (isq) p0_transpose_item<2>(a.in[9], D, D, D / 32, (bf16_t*)(ws + WS_WQ), scr, item, F.lane, a.in[7], a.in[8], (float*)(ws + WS_CPART));
            else p0_transpose_item<3>(a.in[6], D, D, D / 32, (bf16_t*)(ws + WS_WOUT), scr, item, F.lane, nullptr, nullptr, nullptr);
        }
    }
}

struct EpiLnTopk {
    static constexpr bool PERM = true, AFTER_DRAIN = true;
    const float* c1; const float* c0; const LAS float* stat; const bf16_t* SKB; int* EXP; float* GATE;
    __device__ __forceinline__ void fused(pg8::f32x4 (&acc)[2][2][4][2], const pg8::Unit& u, int wr, int wc, int fr, int fq, LAS unsigned char* lds, int wid, int lane) const {
        const int colw = wc * 32 + 8 * fq;
        f32x4 k1[2][2], k0[2][2];
#pragma unroll
        for (int bj = 0; bj < 2; ++bj)
#pragma unroll
            for (int n = 0; n < 2; ++n) { k1[bj][n] = *(const f32x4*)(c1 + u.pn * 256 + colw + bj * 128 + 4 * n); k0[bj][n] = *(const f32x4*)(c0 + u.pn * 256 + colw + bj * 128 + 4 * n); }
#pragma unroll
        for (int ai = 0; ai < 2; ++ai)
#pragma unroll
            for (int m = 0; m < 4; ++m) { const int rl = wr * 64 + fr + ai * 128 + m * 16; const float mu = stat[2 * rl], rs = stat[2 * rl + 1];
#pragma unroll
                for (int bj = 0; bj < 2; ++bj) { const f32x4 a = (acc[ai][bj][m][0] - k1[bj][0] * mu) * rs + k0[bj][0], b = (acc[ai][bj][m][1] - k1[bj][1] * mu) * rs + k0[bj][1];
                    v4u w; w.x = pg8::cvt_pk_bf16(a[0], a[1]); w.y = pg8::cvt_pk_bf16(a[2], a[3]); w.z = pg8::cvt_pk_bf16(b[0], b[1]); w.w = pg8::cvt_pk_bf16(b[2], b[3]);
                    const int chunk = wc * 4 + fq + 16 * bj;
                    *(LAS v4u*)(lds + rl * 512 + ((chunk ^ (rl & 31)) * 16)) = w; } }
        asm volatile("s_waitcnt lgkmcnt(0)" ::: "memory"); __builtin_amdgcn_s_barrier(); asm volatile("" ::: "memory");
        const int tok = lane & 31, hh = lane >> 5, h = u.pn, row = 32 * wid + tok;
        const size_t o = (size_t)(u.pm * 256 + row) * 128 + h * 16 + hh * 8;
        peer_topk_wave(QFromLds{lds, row, hh}, SKB + (size_t)h * 2 * 128 * 128, lane, EXP + o, GATE + o);
    }
};
constexpr int N_PHASES = 13;
#ifndef REPMASK
#define REPMASK 0
#endif
#ifndef TSA
#define TSA -1
#define TSB -1
#endif
#define REP(k) for (int rep_ = 0; rep_ < (((REPMASK) >> (k)) & 1) + 1; ++rep_)
__global__ void __launch_bounds__(NWAVES * 64, 2) mega_fwd(Args args) {
    extern __shared__ __attribute__((aligned(16))) unsigned char lds[];
    Frame F;
    F.lds = (LAS unsigned char*)lds;
    volatile LAS unsigned* MISC = (volatile LAS unsigned*)(F.lds + MISC_OFF);
    F.tid = threadIdx.x; F.lane = F.tid & 63; F.wave = __builtin_amdgcn_readfirstlane(F.tid >> 6);
    F.G = gridDim.x; { const int bx = blockIdx.x; F.vcu = (F.G % 8 == 0) ? (bx % 8) * (F.G / 8) + bx / 8 : bx; }
    unsigned char* ws = args.ws;
    gu32* ctl = (gu32*)(ws + WS_CTL);
    for (int u = F.tid; u < (LDS_BYTES - LDSCTL_OFF) / 4; u += NWAVES * 64) ((LAS unsigned*)(F.lds + LDSCTL_OFF))[u] = 0u;
    __syncthreads();
    const int lo = args.ph_lo, hi = args.ph_hi;
    unsigned long long ts_a = 0, ts_b = 0;
#define STAMP(k) do { if (TSA >= 0) { if ((k) == TSA) ts_a = __builtin_amdgcn_s_memrealtime(); if ((k) == TSB) ts_b = __builtin_amdgcn_s_memrealtime(); } } while (0)
    STAMP(0);
    XcdBarrier bar; bar.bar = (unsigned*)(ctl + CW_BAR) + args.li * XCD_BAR_WORDS; bar.x = 0; bar.st = nullptr;
    if (hi - lo > 1) bar = xcd_barrier_post((unsigned*)(ctl + CW_BAR) + args.li * XCD_BAR_WORDS, MISC + 8);
#define IN(k) (lo <= (k) && (k) < hi)
#define BOTH(k) (IN(k) && IN((k) == 5 ? 7 : (k) + 1))
#define SEAM(k) do { if (BOTH(k)) xcd_barrier(bar); STAMP((k) + 1); } while (0)
    bf16_t* WIN = (bf16_t*)(ws + WS_WIN); bf16_t* WOUT = (bf16_t*)(ws + WS_WOUT); bf16_t* WQ = (bf16_t*)(ws + WS_WQ);
    bf16_t* XB = (bf16_t*)(ws + WS_XB); bf16_t* PROJ = (bf16_t*)(ws + WS_PROJ); bf16_t* OB = (bf16_t*)(ws + WS_O);
    float* Y = (float*)(ws + WS_Y); bf16_t* H1B = (bf16_t*)(ws + WS_H1B); bf16_t* QB = (bf16_t*)(ws + WS_Q);
    const float* ROPE = (const float*)(ws + WS_ROPE);

    if (IN(0)) { REP(0) p0_prologue(F, args); SEAM(0); }
    if (IN(1)) {
        pg8::Gemm g{(const bf16_t*)(ws + WS_X8), WIN, T, NP, D}; pg8::StaticOrder S; S.init(T, NP, F.G, (int)blockIdx.x);
        pg8::EpiBf16 E{PROJ, NP, ROPE, 12, 20, 1.0f / W8_SCALE};
        REP(1) pg8::gemm_phase<pg8::EpiBf16, pg8::StaticOrder, true, true, true>(F.lds, g, S, E);
        STAMP(7);
        bg_queue_drain(F, args, ctl);
        SEAM(1);
    }
    if (IN(2)) { REP(2) chunk_u_phase(F, PROJ, args.in[2], args.in[3], (float*)(ws + WS_BC), (bf16_t*)(ws + WS_UT)); SEAM(2); }
    if (IN(3)) { scan_phase(F, (bf16_t*)(ws + WS_UT), (const float*)(ws + WS_BC), (const float*)(ws + WS_CPART), (float*)(ws + WS_CFIN)); SEAM(3); }
    if (IN(4)) { REP(4) chunk_o_phase(F, PROJ, (const float*)(ws + WS_BC), (const bf16_t*)(ws + WS_UT), args.in[4], args.in[5], OB); SEAM(4); }
    if (IN(5)) {
        pg8::Gemm g{OB, WOUT, T, D, D}; pg8::StaticOrder S; S.init(T, D, F.G, (int)blockIdx.x);
        pg8::EpiResStats E{H1B, args.in[0], (float*)(ws + WS_PSTAT), D, ALPHA, 1.0f / WO8_SCALE};
        REP(5) pg8::gemm_phase<pg8::EpiResStats, pg8::StaticOrder, true, true, true>(F.lds, g, S, E);
        SEAM(5);
    }
    if (IN(7)) {
        pg8::Gemm g{H1B, WQ, T, D, D}; pg8::StaticOrder S; S.init(T, D, F.G, (int)blockIdx.x);
        pg8::Unit u0; const bool has = S.next(0, u0);
        LAS float* stat = (LAS float*)(F.lds + LDSCTL_OFF + 1024);
        if (has && F.tid < 256) { const GAS f32x4* ps4 = (const GAS f32x4*)((const float*)(ws + WS_PSTAT) + (size_t)(u0.pm * 256 + F.tid) * 64); float s = 0.f, q = 0.f;
            f32x4 pv[16];
#pragma unroll
            for (int i = 0; i < 16; ++i) pv[i] = ps4[i];
#pragma unroll
            for (int i = 0; i < 16; ++i) { s += pv[i][0]; q += pv[i][1]; s += pv[i][2]; q += pv[i][3]; }
            const float mu = s * (1.0f / D), rs = 1.0f / sqrtf(q * (1.0f / D) - mu * mu + LN_EPS); stat[2 * F.tid] = mu; stat[2 * F.tid + 1] = rs;
            if (u0.pn == 0) *(GAS f32x2*)((float*)(ws + WS_MURS) + (size_t)(u0.pm * 256 + F.tid) * 2) = (f32x2){mu, rs}; }
        __syncthreads();
        if (F.G == 256) {
            EpiLnTopk E{(const float*)(ws + WS_CFIN), (const float*)(ws + WS_CFIN) + D, stat, (const bf16_t*)(ws + WS_SKB), (int*)(ws + WS_EXP), (float*)(ws + WS_GATE)};
            pg8::gemm_phase<EpiLnTopk, pg8::StaticOrder, true, true>(F.lds, g, S, E);
        } else {
            pg8::EpiLnBf16 E{QB, D, (const float*)(ws + WS_CFIN), (const float*)(ws + WS_CFIN) + D, stat, has ? u0.pm : -1, (const float*)(ws + WS_PSTAT), LN_EPS, D};
            pg8::gemm_phase<pg8::EpiLnBf16, pg8::StaticOrder, true, true>(F.lds, g, S, E);
        }
        if (IN(8)) xcd_barrier(bar);
        STAMP(8);
    }
    if (IN(8) && F.G != 256) { REP(8) peer_topk_phase(F, QB, (const bf16_t*)(ws + WS_SKB), (int*)(ws + WS_EXP), (float*)(ws + WS_GATE)); if (IN(9)) xcd_barrier(bar); }
    STAMP(9);
    if (IN(9)) { peer_dots_phase(F, H1B, ws + WS_UB, (const int*)(ws + WS_EXP), (float*)(ws + WS_PD)); SEAM(9); }
    if (IN(10)) { peer_w_phase(F, (const float*)(ws + WS_PD), (const float*)(ws + WS_MURS), (const int*)(ws + WS_EXP), (const float*)(ws + WS_GATE), (const float*)(ws + WS_USC), (const float*)(ws + WS_US1), (const float*)(ws + WS_US0), (const float*)(ws + WS_VSC), (float*)(ws + WS_W)); SEAM(10); }
    if (IN(11)) { peer_mix_phase(F, ws + WS_VB, (const int*)(ws + WS_EXP), (const float*)(ws + WS_W), (bf16_t*)(ws + WS_FFN)); SEAM(11); }
    if (IN(12)) ln2_phase(F, H1B, (const bf16_t*)(ws + WS_FFN), (const float*)(ws + WS_MURS), args.in[7], args.in[8], args.in[13], args.in[14], args.out);
    STAMP(13);
    if (TSA >= 0) { const unsigned long long t_end = __builtin_amdgcn_s_memrealtime(), dt = ts_b - ts_a; while (__builtin_amdgcn_s_memrealtime() - t_end < dt) __builtin_amdgcn_s_sleep(8); }
#undef IN
#undef BOTH
#undef SEAM
}

extern "C" void kernel_launch(void* const* d_in, const int* in_sizes, int n_in, void* d_out, int out_size, void* d_ws, size_t ws_size, hipStream_t stream) {
    static int grid = 0;
    if (grid == 0) {
        if (n_in != 15 || in_sizes[0] != T * D || out_size != T * D || ws_size < WS_END) { fprintf(stderr, "kernel_launch: unexpected shapes / workspace (n_in %d, ws %zu)\n", n_in, ws_size); grid = -1; return; }
        int dev = 0, cus = 0, per_cu = 0;
        if (hipGetDevice(&dev) != hipSuccess || hipDeviceGetAttribute(&cus, hipDeviceAttributeMultiprocessorCount, dev) != hipSuccess) { grid = -1; return; }
        if (hipFuncSetAttribute((const void*)mega_fwd, hipFuncAttributeMaxDynamicSharedMemorySize, LDS_BYTES) != hipSuccess) { fprintf(stderr, "kernel_launch: hipFuncSetAttribute failed\n"); grid = -1; return; }
        if (hipOccupancyMaxActiveBlocksPerMultiprocessor(&per_cu, (const void*)mega_fwd, NWAVES * 64, LDS_BYTES) != hipSuccess || per_cu < 1)
            fprintf(stderr, "kernel_launch: occupancy query reports %d workgroups per CU\n", per_cu);
        (void)hipGetLastError();
        grid = cus & ~7;
    }
    if (grid < 0) return;
    (void)hipMemsetAsync((char*)d_ws + WS_CTL, 0, CTL_ZERO_BYTES, stream);
    Args a{};
    for (int i = 0; i < 15; ++i) a.in[i] = (const float*)d_in[i];
    a.out = (float*)d_out; a.ws = (unsigned char*)d_ws;
    a.ph_lo = 0; a.ph_hi = N_PHASES; a.li = 0;
    hipLaunchKernelGGL(mega_fwd, dim3(grid), dim3(NWAVES * 64), LDS_BYTES, stream, a);
}
```
